# Optimizing an MI355X kernel written in HIP

```python
import math
import jax, jax.numpy as jnp
from jax import lax
import numpy as np

D_MODEL = 2048
BATCH = 1
SEQ = 8192
DEPTH = 4

GRID_W = 64
CTX_LEN = 256
BRANCH_W = 512
N_BRANCH = 4
N_SECTIONS = 10
RET_HEADS = 4
RET_DK = BRANCH_W // RET_HEADS
RET_CHUNK = 128
ROPE_BASE = 10000.0
S5_GROUP = 16
S5_GROUPS = BRANCH_W // S5_GROUP
S5_STATE = 64
CONV_W = 3
CMLP_CHUNK = 128
CMLP_GROUPS = 4
CMLP_GW = BRANCH_W // CMLP_GROUPS
D_FF = ((8 * D_MODEL + 3 * 256 - 1) // (3 * 256)) * 256
EPS = 1e-6

kernel_name = 'hybrid_parallel_flow_block'

F32 = jnp.float32


def rms_norm(x, g):
    xf = x.astype(F32)
    y = xf * lax.rsqrt(jnp.mean(xf * xf, axis=-1, keepdims=True) + EPS)
    return (y * g.astype(F32)).astype(x.dtype)


def layer_norm(x, g, b):
    xf = x.astype(F32)
    mu = jnp.mean(xf, axis=-1, keepdims=True)
    var = jnp.mean(jnp.square(xf - mu), axis=-1, keepdims=True)
    return ((xf - mu) * lax.rsqrt(var + EPS) * g.astype(F32) + b.astype(F32)).astype(x.dtype)


def modulate(x, g, shift, scale):
    return rms_norm(x, g) * (1 + scale) + shift


def swiglu(h, w1, w3, w2):
    return (jax.nn.silu(h @ w1) * (h @ w3)) @ w2


def rope_tables(rows):
    row = jnp.broadcast_to(jnp.arange(rows)[:, None], (rows, GRID_W)).reshape(-1).astype(F32)
    col = jnp.broadcast_to(jnp.arange(GRID_W)[None, :], (rows, GRID_W)).reshape(-1).astype(F32)
    nf = RET_DK // 4
    freqs = ROPE_BASE ** (-jnp.arange(nf, dtype=F32) / nf)
    ang = jnp.concatenate([row[:, None] * freqs, col[:, None] * freqs], axis=-1)
    return jnp.cos(ang), jnp.sin(ang)


def rope(t, cos, sin):
    t1, t2 = t[..., :RET_DK // 2], t[..., RET_DK // 2:]
    return jnp.concatenate([t1 * cos - t2 * sin, t1 * sin + t2 * cos], axis=-1)


def retention_scan(q, k, v, log_gamma, s0, include_diag):
    b, h, n, d = k.shape
    nc = n // RET_CHUNK
    pos = jnp.arange(RET_CHUNK, dtype=F32)
    lg = log_gamma[:, None]
    kc = k.reshape(b, h, nc, RET_CHUNK, d)
    vc = v.reshape(b, h, nc, RET_CHUNK, d)
    k_decay = jnp.exp(lg * (RET_CHUNK - 1 - pos))
    chunk_kv = jnp.einsum('bhncd,bhnce->bhnde', kc * k_decay[None, :, None, :, None], vc)
    g_chunk = jnp.exp(log_gamma * RET_CHUNK)[None, :, None, None]

    def step(s, u):
        return g_chunk * s + u, s

    s_final, s_start = lax.scan(step, s0, jnp.moveaxis(chunk_kv, 2, 0))
    if q is None:
        return None, s_final
    s_start = jnp.moveaxis(s_start, 0, 2)
    qc = q.reshape(b, h, nc, RET_CHUNK, d)
    q_decay = jnp.exp(lg * (pos + 1.0))
    cross = jnp.einsum('bhncd,bhnde->bhnce', qc * q_decay[None, :, None, :, None], s_start)
    diff = pos[:, None] - pos[None, :]
    mask = diff >= 0 if include_diag else diff > 0
    dmat = jnp.where(mask, jnp.exp(lg[:, :, None] * jnp.maximum(diff, 0.0)), 0.0)
    scores = jnp.einsum('bhnid,bhnjd->bhnij', qc, kc) * dmat[None, :, None]
    intra = jnp.einsum('bhnij,bhnje->bhnie', scores, vc)
    return (intra + cross).reshape(b, h, n, d), s_final


def _heads(t):
    if t is None:
        return None
    b, n, _ = t.shape
    return t.reshape(b, n, RET_HEADS, RET_DK).transpose(0, 2, 1, 3).astype(F32)


def _flip(t):
    return None if t is None else t[:, :, ::-1]


def _retention_out(o, g):
    mu = jnp.mean(o, axis=-1, keepdims=True)
    var = jnp.mean(jnp.square(o - mu), axis=-1, keepdims=True)
    o = (o - mu) * lax.rsqrt(var + EPS)
    b, h, n, d = o.shape
    o = o.transpose(0, 2, 1, 3).reshape(b, n, h * d)
    return (o * jax.nn.silu(g.astype(F32))).astype(g.dtype)


def retention_mixer(q, k, v, g, qc, kc, vc, gc, decay_logit, cos, sin):
    lg = jax.nn.log_sigmoid(decay_logit.astype(F32))
    scale = RET_DK ** -0.5
    q = rope(_heads(q), cos, sin) * scale
    k = rope(_heads(k), cos, sin)
    v = _heads(v)
    qc = None if qc is None else _heads(qc) * scale
    kc, vc = _heads(kc), _heads(vc)
    s0 = jnp.zeros((k.shape[0], RET_HEADS, RET_DK, RET_DK), F32)
    oc_f, sc_f = retention_scan(qc, kc, vc, lg[0], s0, True)
    oc_b, sc_b = retention_scan(_flip(qc), _flip(kc), _flip(vc), lg[1], s0, False)
    ox_f, _ = retention_scan(q, k, v, lg[0], sc_f, True)
    ox_b, _ = retention_scan(_flip(q), _flip(k), _flip(v), lg[1], sc_b, False)
    y = _retention_out(ox_f + _flip(ox_b), g)
    yc = None if qc is None else _retention_out(oc_f + _flip(oc_b), gc)
    return y, yc


def s5_discretize(a_re, a_im, b_re, b_im, log_dt):
    dt = jnp.exp(log_dt)[:, None]
    mag = jnp.exp(dt * a_re)
    ang = dt * a_im
    ab_re, ab_im = mag * jnp.cos(ang), mag * jnp.sin(ang)
    nr, ni = ab_re - 1.0, ab_im
    den = a_re * a_re + a_im * a_im
    f_re = (nr * a_re + ni * a_im) / den
    f_im = (ni * a_re - nr * a_im) / den
    bb_re = f_re[..., None] * b_re - f_im[..., None] * b_im
    bb_im = f_re[..., None] * b_im + f_im[..., None] * b_re
    return ab_re, ab_im, bb_re, bb_im


def s5_scan(ug, ab_re, ab_im, bb_re, bb_im, s0_re, s0_im):
    bu_re = jnp.einsum('bngc,gpc->bngp', ug, bb_re)
    bu_im = jnp.einsum('bngc,gpc->bngp', ug, bb_im)
    bu_re = bu_re.at[:, 0].add(ab_re * s0_re - ab_im * s0_im)
    bu_im = bu_im.at[:, 0].add(ab_re * s0_im + ab_im * s0_re)
    a_re = jnp.broadcast_to(ab_re, bu_re.shape)
    a_im = jnp.broadcast_to(ab_im, bu_im.shape)

    def combine(e1, e2):
        a1r, a1i, b1r, b1i = e1
        a2r, a2i, b2r, b2i = e2
        return (a2r * a1r - a2i * a1i, a2r * a1i + a2i * a1r,
                a2r * b1r - a2i * b1i + b2r, a2r * b1i + a2i * b1r + b2i)

    _, _, x_re, x_im = lax.associative_scan(combine, (a_re, a_im, bu_re, bu_im), axis=1)
    return x_re, x_im


def s5_readout(x_re, x_im, ug, c_re, c_im, d, w_glu):
    b, n = ug.shape[:2]
    y = (jnp.einsum('bngp,gcp->bngc', x_re, c_re.astype(F32))
         - jnp.einsum('bngp,gcp->bngc', x_im, c_im.astype(F32))
         + d.astype(F32).reshape(S5_GROUPS, S5_GROUP) * ug)
    y = jax.nn.gelu(y.reshape(b, n, BRANCH_W))
    return y * jax.nn.sigmoid(y @ w_glu.astype(F32))


def s5_mixer(u, uc, a_re, a_im, b_re, b_im, c_re, c_im, d, log_dt, w_glu, need_ctx):
    b, n, _ = u.shape
    ug = u.astype(F32).reshape(b, n, S5_GROUPS, S5_GROUP)
    ucg = uc.astype(F32).reshape(b, uc.shape[1], S5_GROUPS, S5_GROUP)
    a_re, a_im = a_re.astype(F32), a_im.astype(F32)
    disc = [s5_discretize(a_re, a_im, b_re[i].astype(F32), b_im[i].astype(F32),
                          log_dt[i].astype(F32)) for i in range(2)]
    s0 = jnp.zeros((b, S5_GROUPS, S5_STATE), F32)
    cf_re, cf_im = s5_scan(ucg, *disc[0], s0, s0)
    cb_re, cb_im = s5_scan(ucg[:, ::-1], *disc[1], s0, s0)
    xf_re, xf_im = s5_scan(ug, *disc[0], cf_re[:, -1], cf_im[:, -1])
    xb_re, xb_im = s5_scan(ug[:, ::-1], *disc[1], cb_re[:, -1], cb_im[:, -1])
    y = s5_readout(xf_re + xb_re[:, ::-1], xf_im + xb_im[:, ::-1], ug,
                   c_re, c_im, d, w_glu).astype(u.dtype)
    if not need_ctx:
        return y, None
    yc = s5_readout(cf_re + cb_re[:, ::-1], cf_im + cb_im[:, ::-1], ucg,
                    c_re, c_im, d, w_glu).astype(uc.dtype)
    return y, yc


def conv_mixer(xin, bg, cg, conv_w):
    z = cg * xin
    y = lax.conv_general_dilated(z, conv_w[:, None, :], window_strides=(1,),
                                 padding=((CONV_W // 2, CONV_W // 2),),
                                 dimension_numbers=('NWC', 'WIO', 'NWC'),
                                 feature_group_count=BRANCH_W)
    return bg * y


def chunk_mlp_mixer(gu, gv, ln_g, ln_b, w_s, b_s):
    u = jax.nn.gelu(gu)
    v = layer_norm(jax.nn.gelu(gv), ln_g, ln_b)
    b, n, _ = v.shape
    vg = v.reshape(b, n // CMLP_CHUNK, CMLP_CHUNK, CMLP_GROUPS, CMLP_GW)
    mixed = jnp.einsum('bnpgc,gqp->bnqgc', vg, w_s) + b_s.T[None, None, :, :, None]
    return u * mixed.reshape(b, n, BRANCH_W)


def merge_branches(h, outs, w_branch, w_merge, b_merge, w_out):
    o = jnp.stack(outs, axis=2)
    ybr = jnp.einsum('bnke,ked->bnkd', o, w_branch)
    b, n, _ = h.shape
    gates = jax.nn.sigmoid(h @ w_merge + b_merge).reshape(b, n, N_BRANCH, D_MODEL)
    return jnp.sum(gates * ybr, axis=2) @ w_out


def mixing_sublayer(h, hc, cos, sin, need_ctx, w_in, ret_decay_logit, s5_a_re, s5_a_im,
                    s5_b_re, s5_b_im, s5_c_re, s5_c_im, s5_d, s5_log_dt, s5_w_glu, conv_w,
                    cmlp_ln_g, cmlp_ln_b, cmlp_ws, cmlp_bs, w_branch, w_merge, b_merge, w_out):
    q, k, v, g, u, cx, cb, cc, gu, gv = jnp.split(h @ w_in, N_SECTIONS, axis=-1)
    if need_ctx:
        qc, kc, vc, gc, uc, cxc, cbc, ccc, guc, gvc = jnp.split(hc @ w_in, N_SECTIONS, axis=-1)
    else:
        qc = gc = None
        kc, vc = jnp.split(hc @ w_in[:, 1 * BRANCH_W:3 * BRANCH_W], 2, axis=-1)
        uc = hc @ w_in[:, 4 * BRANCH_W:5 * BRANCH_W]
    y_ret, yc_ret = retention_mixer(q, k, v, g, qc, kc, vc, gc, ret_decay_logit, cos, sin)
    y_s5, yc_s5 = s5_mixer(u, uc, s5_a_re, s5_a_im, s5_b_re, s5_b_im, s5_c_re, s5_c_im,
                           s5_d, s5_log_dt, s5_w_glu, need_ctx)
    y = merge_branches(h, [y_ret, y_s5, conv_mixer(cx, cb, cc, conv_w),
                           chunk_mlp_mixer(gu, gv, cmlp_ln_g, cmlp_ln_b, cmlp_ws, cmlp_bs)],
                       w_branch, w_merge, b_merge, w_out)
    if not need_ctx:
        return y, None
    yc = merge_branches(hc, [yc_ret, yc_s5, conv_mixer(cxc, cbc, ccc, conv_w),
                             chunk_mlp_mixer(guc, gvc, cmlp_ln_g, cmlp_ln_b, cmlp_ws, cmlp_bs)],
                        w_branch, w_merge, b_merge, w_out)
    return y, yc


def setup_inputs(seed: int = 0) -> dict:
    key = jax.random.key(seed)
    ks = jax.random.split(key, 32)
    L, D, BW, F = DEPTH, D_MODEL, BRANCH_W, D_FF
    G, P, GC = S5_GROUPS, S5_STATE, S5_GROUP

    def nrm(i, shape, scale):
        return jax.random.normal(ks[i], shape, F32) * scale

    hh = np.arange(RET_HEADS, dtype=np.float32)
    gamma0 = 1.0 - 2.0 ** (-5.0 - hh)
    logit0 = jnp.asarray(np.log(gamma0 / (1.0 - gamma0)), F32)
    return {
        'x': nrm(0, (BATCH, SEQ, D), 1.0),
        'c': nrm(1, (BATCH, D), 1.0),
        'ctx': nrm(2, (BATCH, CTX_LEN, D), 1.0),
        'c_ctx': nrm(3, (D,), 1.0),
        'ada_w': nrm(4, (L, D, 6 * D), 0.5 * D ** -0.5),
        'ada_b': nrm(5, (L, 6 * D), 0.02),
        'norm1_g': 1.0 + nrm(6, (L, D), 0.02),
        'norm2_g': 1.0 + nrm(7, (L, D), 0.02),
        'w_in': nrm(8, (L, D, N_SECTIONS * BW), D ** -0.5),
        'ret_decay_logit': logit0 + nrm(9, (L, 2, RET_HEADS), 0.05),
        's5_a_re': -0.5 + nrm(10, (L, G, P), 0.01),
        's5_a_im': jnp.pi * jnp.arange(P, dtype=F32) + nrm(11, (L, G, P), 0.01),
        's5_b_re': nrm(12, (L, 2, G, P, GC), (2.0 * GC) ** -0.5),
        's5_b_im': nrm(13, (L, 2, G, P, GC), (2.0 * GC) ** -0.5),
        's5_c_re': nrm(14, (L, G, GC, P), (2.0 * P) ** -0.5),
        's5_c_im': nrm(15, (L, G, GC, P), (2.0 * P) ** -0.5),
        's5_d': nrm(16, (L, BW), 1.0),
        's5_log_dt': jax.random.uniform(ks[17], (L, 2, G), F32,
                                        minval=math.log(1e-3), maxval=math.log(1e-1)),
        's5_w_glu': nrm(18, (L, BW, BW), BW ** -0.5),
        'conv_w': nrm(19, (L, CONV_W, BW), CONV_W ** -0.5),
        'cmlp_ln_g': 1.0 + nrm(20, (L, BW), 0.02),
        'cmlp_ln_b': nrm(21, (L, BW), 0.02),
        'cmlp_ws': nrm(22, (L, CMLP_GROUPS, CMLP_CHUNK, CMLP_CHUNK), CMLP_CHUNK ** -0.5),
        'cmlp_bs': 1.0 + nrm(23, (L, CMLP_GROUPS, CMLP_CHUNK), 0.1),
        'w_branch': nrm(24, (L, N_BRANCH, BW, D), BW ** -0.5),
        'w_merge': nrm(25, (L, D, N_BRANCH * D), D ** -0.5),
        'b_merge': nrm(26, (L, N_BRANCH * D), 0.02),
        'w_out': nrm(27, (L, D, D), D ** -0.5),
        'ffn_w1': nrm(28, (L, D, F), D ** -0.5),
        'ffn_w3': nrm(29, (L, D, F), D ** -0.5),
        'ffn_w2': nrm(30, (L, F, D), F ** -0.5),
        'final_norm_g': 1.0 + nrm(31, (D,), 0.02),
    }


def reference(x, c, ctx, c_ctx, ada_w, ada_b, norm1_g, norm2_g, w_in, ret_decay_logit,
              s5_a_re, s5_a_im, s5_b_re, s5_b_im, s5_c_re, s5_c_im, s5_d, s5_log_dt,
              s5_w_glu, conv_w, cmlp_ln_g, cmlp_ln_b, cmlp_ws, cmlp_bs, w_branch, w_merge,
              b_merge, w_out, ffn_w1, ffn_w3, ffn_w2, final_norm_g):
    rows = x.shape[1] // GRID_W
    cos, sin = rope_tables(rows)
    silu_c = jax.nn.silu(c)
    silu_cc = jax.nn.silu(c_ctx)
    xc = ctx
    for l in range(DEPTH):
        need_ctx = l < DEPTH - 1
        mod = silu_c @ ada_w[l] + ada_b[l]
        modc = silu_cc @ ada_w[l] + ada_b[l]
        sh1, sc1, g1, sh2, sc2, g2 = [m[:, None, :] for m in jnp.split(mod, 6, axis=-1)]
        sh1c, sc1c, g1c, sh2c, sc2c, g2c = jnp.split(modc, 6, axis=-1)
        h = modulate(x, norm1_g[l], sh1, sc1)
        hc = modulate(xc, norm1_g[l], sh1c, sc1c)
        y, yc = mixing_sublayer(h, hc, cos, sin, need_ctx, w_in[l], ret_decay_logit[l],
                                s5_a_re[l], s5_a_im[l], s5_b_re[l], s5_b_im[l], s5_c_re[l],
                                s5_c_im[l], s5_d[l], s5_log_dt[l], s5_w_glu[l], conv_w[l],
                                cmlp_ln_g[l], cmlp_ln_b[l], cmlp_ws[l], cmlp_bs[l],
                                w_branch[l], w_merge[l], b_merge[l], w_out[l])
        x = x + g1 * y
        x = x + g2 * swiglu(modulate(x, norm2_g[l], sh2, sc2), ffn_w1[l], ffn_w3[l], ffn_w2[l])
        if need_ctx:
            xc = xc + g1c * yc
            xc = xc + g2c * swiglu(modulate(xc, norm2_g[l], sh2c, sc2c),
                                   ffn_w1[l], ffn_w3[l], ffn_w2[l])
    return rms_norm(x, final_norm_g)
```

```cpp
#include <hip/hip_runtime.h>
#include <cstdio>
#include <cstdint>
#define LAS __attribute__((address_space(3)))
namespace pg8 {
#define PG8_LAS __attribute__((address_space(3)))
typedef unsigned short bf16_t;
typedef short bf16x8 __attribute__((ext_vector_type(8)));
typedef float f32x4 __attribute__((ext_vector_type(4)));
typedef unsigned u32x4 __attribute__((ext_vector_type(4)));
constexpr int BM = 256, BK = 64, HALF = 128, HTB = HALF * BK * 2  , STAGE_BYTES = 8 * HTB, NXCD = 8, WGM = 3;

__host__ __device__ __forceinline__ int lds_byte(int r, int c) { const int st = (r >> 4) * 2 + (c >> 5), rr = r & 15, cc = c & 31, ob = rr * 64 + cc * 2; return st * 1024 + (ob ^ (((ob >> 9) & 1) << 5)); }
__host__ __device__ __forceinline__ void stage_rc(int b, int& R, int& C) { const int st = b / 1024, sb = b % 1024, swz = sb ^ (((sb >> 9) & 1) << 5); R = (st >> 1) * 16 + swz / 64; C = (st & 1) * 32 + (swz % 64) / 2; }
__host__ __device__ __forceinline__ int perm32(int rho) { const int n = rho >> 4, i = rho & 15; return 8 * (i >> 2) + 4 * n + (i & 3); }

struct Unit { int pm, pn, k0, nt; };
struct Gemm { const bf16_t* A; const bf16_t* Bt; int M, N, K; };

struct StaticOrder {
    int nM, nN, nwg, G, c, nt;
    __host__ __device__ void init(int M, int N, int K, int G_, int c_) { nM = M / BM; nN = N / BM; nwg = nM * nN; G = G_; c = c_; nt = K / BK; }
    __host__ __device__ bool next(int i, Unit& u) const {
        const long L = (long)i * G + c; if (L >= nwg) return false;
        int wgid = (int)L; { const int q = nwg / NXCD, r = nwg % NXCD, xcd = wgid % NXCD, off = wgid / NXCD; wgid = (xcd < r ? xcd * (q + 1) : r * (q + 1) + (xcd - r) * q) + off; }
        const int nig = WGM * nN, gid = wgid / nig, fm = gid * WGM, gsz = (nM - fm) < WGM ? (nM - fm) : WGM;
        u.pm = fm + ((wgid % nig) % gsz); u.pn = (wgid % nig) / gsz; u.k0 = 0; u.nt = nt; return true;
    }
    __device__ __forceinline__ void a_ready(const Unit&) const {}
    __device__ __forceinline__ void done(const Unit&) const {}
};

typedef float f32x2_cv __attribute__((ext_vector_type(2))); typedef __bf16 bf16x2_cv __attribute__((ext_vector_type(2)));
__device__ __forceinline__ unsigned cvt_pk_bf16(float lo, float hi) { f32x2_cv v = {lo, hi}; bf16x2_cv b = __builtin_convertvector(v, bf16x2_cv); return __builtin_bit_cast(unsigned, b); }
typedef float f32x2 __attribute__((ext_vector_type(2)));
template <class Epi, class Sched, bool ALIGN_EPI = false, bool SP2 = false>
__device__ __forceinline__ void gemm_phase(PG8_LAS unsigned char* lds, const Gemm g, const Sched& S, const Epi& E, const int tid_in) {
    int tid_l = tid_in; asm volatile("" : "+v"(tid_l));
    const int tid = tid_l, wid = __builtin_amdgcn_readfirstlane(tid >> 6), lane = tid & 63, wr = wid >> 2, wc = wid & 3, fr = lane & 15, fq = lane >> 4;
    const int K = g.K;
    unsigned voffA[2], voffB[2];
#pragma unroll
    for (int i = 0; i < 2; ++i) { int R, C; stage_rc(tid * 16 + i * 8192, R, C); const int Rb = Epi::PERM ? ((R & ~31) + perm32(R & 31)) : R;
        voffA[i] = (unsigned)(R * K + C) * 2u; voffB[i] = (unsigned)(Rb * K + C) * 2u; }
    const size_t kstep = (size_t)(BK * 2);
    const size_t hstep = (size_t)HALF * K * 2;
    const size_t tstep = 2 * hstep;
    const unsigned ldsw = (unsigned)wid * 1024u;
    const int aoff = lds_byte(wr * 64 + fr, fq * 8), boff = lds_byte(wc * 32 + fr, fq * 8);
#define PG8_SA(b, h) (((b) * 2 + (h)) * HTB)
#define PG8_SB(b, h) ((4 + (b) * 2 + (h)) * HTB)
#define PG8_STAGE(bufoff, gbase, voff) do { _Pragma("unroll") for (int _i = 0; _i < 2; ++_i) \
        __builtin_amdgcn_global_load_lds((const unsigned*)((const char*)(gbase) + (voff)[_i]), (PG8_LAS unsigned*)(lds + (bufoff) + ldsw + _i * 8192), 16, 0, 0); } while (0)
#define PG8_LDA(dst, b, h) do { _Pragma("unroll") for (int m = 0; m < 4; ++m) _Pragma("unroll") for (int k = 0; k < 2; ++k) dst[m][k] = *(const PG8_LAS bf16x8*)(lds + PG8_SA(b, h) + aoff + m * 2048 + k * 1024); } while (0)
#define PG8_LDB(dst, b, h) do { _Pragma("unroll") for (int n = 0; n < 2; ++n) _Pragma("unroll") for (int k = 0; k < 2; ++k) dst[n][k] = *(const PG8_LAS bf16x8*)(lds + PG8_SB(b, h) + boff + n * 2048 + k * 1024); } while (0)
#define PG8_MMA(ai, bj, At, Bt) do { __builtin_amdgcn_s_setprio(1); _Pragma("unroll") for (int m = 0; m < 4; ++m) _Pragma("unroll") for (int n = 0; n < 2; ++n) _Pragma("unroll") for (int k = 0; k < 2; ++k) \
        acc[ai][bj][m][n] = __builtin_amdgcn_mfma_f32_16x16x32_bf16(Bt[n][k], At[m][k], acc[ai][bj][m][n], 0, 0, 0); __builtin_amdgcn_s_setprio(0); } while (0)
#define PG8_WAIT_V(n) asm volatile("s_waitcnt vmcnt(" #n ")" ::: "memory")
#define PG8_WAIT_L(n) asm volatile("s_waitcnt lgkmcnt(" #n ")" ::: "memory")
#define PG8_BAR __builtin_amdgcn_s_barrier()
#define PG8_SCHED __builtin_amdgcn_sched_barrier(0)
    Unit cur, nxt; int ui = 0;
    if (!S.next(0, cur)) return;
    f32x4 acc[2][2][4][2];
#pragma unroll
    for (int a = 0; a < 2; ++a)
#pragma unroll
        for (int b = 0; b < 2; ++b)
#pragma unroll
            for (int m = 0; m < 4; ++m)
#pragma unroll
                for (int n = 0; n < 2; ++n) acc[a][b][m][n] = (f32x4){0.f, 0.f, 0.f, 0.f};
    bf16x8 At[4][2], B0[2][2], B1[2][2];
    const char* cA = (const char*)g.A + (size_t)cur.pm * tstep + (size_t)cur.k0 * 2; const char* cB = (const char*)g.Bt + (size_t)cur.pn * tstep + (size_t)cur.k0 * 2;
    S.a_ready(cur);
    if constexpr (SP2) {
        PG8_STAGE(PG8_SB(0, 0), cB, voffB); PG8_STAGE(PG8_SB(0, 1), cB + hstep, voffB); PG8_STAGE(PG8_SA(0, 0), cA, voffA); PG8_STAGE(PG8_SA(0, 1), cA + hstep, voffA);
        if (wr == 1) PG8_BAR;
        PG8_WAIT_V(2); PG8_BAR;
        PG8_STAGE(PG8_SB(1, 0), cB + kstep, voffB); PG8_STAGE(PG8_SA(1, 0), cA + kstep, voffA); PG8_STAGE(PG8_SB(1, 1), cB + hstep + kstep, voffB);
        PG8_WAIT_V(6); PG8_BAR;
    } else {
        PG8_STAGE(PG8_SB(0, 0), cB, voffB); PG8_STAGE(PG8_SA(0, 0), cA, voffA); PG8_STAGE(PG8_SB(0, 1), cB + hstep, voffB); PG8_STAGE(PG8_SA(0, 1), cA + hstep, voffA);
        if (wr == 1) PG8_BAR;
        PG8_WAIT_V(4); PG8_BAR;
        PG8_STAGE(PG8_SB(1, 0), cB + kstep, voffB); PG8_STAGE(PG8_SA(1, 0), cA + kstep, voffA); PG8_STAGE(PG8_SB(1, 1), cB + hstep + kstep, voffB);
        PG8_WAIT_V(6); PG8_BAR;
    }
    for (;;) {
        const bool has_next = S.next(ui + 1, nxt);
        const char* nA = has_next ? (const char*)g.A + (size_t)nxt.pm * tstep + (size_t)nxt.k0 * 2 : cA; const char* nB = has_next ? (const char*)g.Bt + (size_t)nxt.pn * tstep + (size_t)nxt.k0 * 2 : cB;
        const int nt = cur.nt;
        for (int t = 0; t < nt; t += 2) {
            const bool last = (t == nt - 2);
            const char* a1 = cA + (size_t)(t + 1) * kstep;
            const char* a2 = last ? nA : cA + (size_t)(t + 2) * kstep; const char* b2 = last ? nB : cB + (size_t)(t + 2) * kstep;
            const char* a3 = a2 + kstep; const char* b3 = b2 + kstep;
            if (last && has_next) S.a_ready(nxt);
            if constexpr (SP2) {
            PG8_LDB(B0, 0, 0); PG8_LDB(B1, 0, 1); PG8_SCHED; PG8_LDA(At, 0, 0); PG8_STAGE(PG8_SA(1, 1), a1 + hstep, voffA);
            PG8_WAIT_V(8); PG8_WAIT_L(0); PG8_BAR; PG8_MMA(0, 0, At, B0); PG8_MMA(0, 1, At, B1); PG8_BAR; PG8_SCHED;
            PG8_LDA(At, 0, 1); PG8_STAGE(PG8_SB(0, 0), b2, voffB); PG8_STAGE(PG8_SB(0, 1), b2 + hstep, voffB); PG8_STAGE(PG8_SA(0, 0), a2, voffA);
            PG8_WAIT_V(8); PG8_WAIT_L(0); PG8_BAR; PG8_MMA(1, 0, At, B0); PG8_MMA(1, 1, At, B1); PG8_BAR; PG8_SCHED;
            PG8_LDB(B0, 1, 0); PG8_LDB(B1, 1, 1); PG8_SCHED; PG8_LDA(At, 1, 0); PG8_STAGE(PG8_SA(0, 1), a2 + hstep, voffA);
            PG8_WAIT_V(8); PG8_WAIT_L(0); PG8_BAR; PG8_MMA(0, 0, At, B0); PG8_MMA(0, 1, At, B1); PG8_BAR; PG8_SCHED;
            PG8_LDA(At, 1, 1); PG8_STAGE(PG8_SB(1, 0), b3, voffB); PG8_STAGE(PG8_SB(1, 1), b3 + hstep, voffB); PG8_STAGE(PG8_SA(1, 0), a3, voffA);
            PG8_WAIT_V(8); PG8_WAIT_L(0); PG8_BAR; PG8_MMA(1, 0, At, B0); PG8_MMA(1, 1, At, B1); PG8_BAR; PG8_SCHED;
            } else {
            PG8_LDB(B0, 0, 0); PG8_SCHED; PG8_LDA(At, 0, 0); PG8_STAGE(PG8_SA(1, 1), a1 + hstep, voffA);
            PG8_WAIT_L(8); PG8_BAR; PG8_WAIT_L(0); PG8_MMA(0, 0, At, B0); PG8_BAR; PG8_SCHED;
            PG8_LDB(B1, 0, 1); PG8_STAGE(PG8_SB(0, 0), b2, voffB);
            PG8_BAR; PG8_WAIT_L(0); PG8_MMA(0, 1, At, B1); PG8_BAR;
            PG8_LDA(At, 0, 1); PG8_STAGE(PG8_SA(0, 0), a2, voffA);
            PG8_BAR; PG8_WAIT_L(0); PG8_MMA(1, 0, At, B0); PG8_BAR; PG8_SCHED;
            PG8_STAGE(PG8_SB(0, 1), b2 + hstep, voffB);
            PG8_WAIT_V(6); PG8_BAR; PG8_MMA(1, 1, At, B1); PG8_BAR;
            PG8_LDB(B0, 1, 0); PG8_SCHED; PG8_LDA(At, 1, 0); PG8_STAGE(PG8_SA(0, 1), a2 + hstep, voffA);
            PG8_WAIT_L(8); PG8_BAR; PG8_WAIT_L(0); PG8_MMA(0, 0, At, B0); PG8_BAR; PG8_SCHED;
            PG8_LDB(B1, 1, 1); PG8_STAGE(PG8_SB(1, 0), b3, voffB);
            PG8_BAR; PG8_WAIT_L(0); PG8_MMA(0, 1, At, B1); PG8_BAR;
            PG8_LDA(At, 1, 1); PG8_STAGE(PG8_SA(1, 0), a3, voffA);
            PG8_BAR; PG8_WAIT_L(0); PG8_MMA(1, 0, At, B0); PG8_BAR; PG8_SCHED;
            PG8_STAGE(PG8_SB(1, 1), b3 + hstep, voffB);
            PG8_WAIT_V(6); PG8_BAR; PG8_MMA(1, 1, At, B1); PG8_BAR;
            }
        }
        if constexpr (ALIGN_EPI) { if (wr == 0) PG8_BAR; }
        if constexpr (!Epi::AFTER_DRAIN) { E(acc, cur, wr, wc, fr, fq); S.done(cur); }
        if (!has_next) break;
#pragma unroll
        for (int a = 0; a < 2; ++a)
#pragma unroll
            for (int b = 0; b < 2; ++b)
#pragma unroll
                for (int m = 0; m < 4; ++m)
#pragma unroll
                    for (int n = 0; n < 2; ++n) acc[a][b][m][n] = (f32x4){0.f, 0.f, 0.f, 0.f};
        cur = nxt; cA = nA; cB = nB; ++ui;
        if constexpr (ALIGN_EPI) { if (wr == 1) PG8_BAR; }
    }
    PG8_WAIT_V(0);
    if constexpr (!ALIGN_EPI) { if (wr == 0) PG8_BAR; }
    PG8_BAR;
    if constexpr (Epi::AFTER_DRAIN) { E.fused(acc, cur, wr, wc, fr, fq, lds, wid, lane); S.done(cur); }
#undef PG8_SA
#undef PG8_SB
#undef PG8_STAGE
#undef PG8_LDA
#undef PG8_LDB
#undef PG8_MMA
#undef PG8_WAIT_V
#undef PG8_WAIT_L
#undef PG8_BAR
#undef PG8_SCHED
}
}
#define XB_TMO      128
#define XB_XCNT(j)  (256  + 64 * (j))
#define XB_XSUB(j)  (1280 + 64 * (j))
#define XB_XGEN(j)  (2304 + 64 * (j))
#define XB_TOP      3328
#define XB_TOPGEN   3392
#define XCD_BAR_WORDS 3456
#define XB_SPIN_CAP (1u << 18)

__device__ __forceinline__ unsigned xb_ld(unsigned* p)              { return __hip_atomic_load(p, __ATOMIC_RELAXED, __HIP_MEMORY_SCOPE_AGENT); }
__device__ __forceinline__ unsigned xb_add(unsigned* p, unsigned v) { return __hip_atomic_fetch_add(p, v, __ATOMIC_RELAXED, __HIP_MEMORY_SCOPE_AGENT); }
__device__ __forceinline__ unsigned xb_xcc_id() { return (unsigned)__builtin_amdgcn_s_getreg((3 << 11) | 20) & 0xFu; }
#define XB_SPIN(cond, bar) do { unsigned _sp = 0; while (cond) { __builtin_amdgcn_s_sleep(1); \
    if ((++_sp & 255u) == 0u) { if (xb_ld(&(bar)[XB_TMO])) break; if (_sp > XB_SPIN_CAP) { atomicAdd(&(bar)[XB_TMO], 1u); break; } } } } while (0)

struct XcdBarrier {
    unsigned* bar; unsigned x; unsigned w;
    volatile LAS unsigned* st;
};

__device__ __forceinline__ XcdBarrier xcd_barrier_post(unsigned* bar, volatile LAS unsigned* st) {
    XcdBarrier b; b.bar = bar; b.x = xb_xcc_id(); b.st = st; b.w = (unsigned)__builtin_amdgcn_readfirstlane((int)(threadIdx.x >> 6));
    if (threadIdx.x == 0) (void)xb_add(&bar[XB_XCNT(b.x)], 1u);
    return b;
}
__device__ __forceinline__ void xcd_barrier_complete(unsigned* bar, unsigned x, unsigned& nloc, unsigned& nx) {
    const unsigned G = gridDim.x * gridDim.y * gridDim.z;
    unsigned sum, cnt, mine, sp = 0u;
    for (;;) {
        sum = 0u; cnt = 0u; mine = 0u;
#pragma unroll
        for (unsigned j = 0; j < 16; ++j) { const unsigned c = xb_ld(&bar[XB_XCNT(j)]); sum += c; cnt += (c > 0u) ? 1u : 0u; mine = (j == x) ? c : mine; }
        if (sum == G) break;
        __builtin_amdgcn_s_sleep(1);
        if ((++sp & 255u) == 0u) { if (xb_ld(&bar[XB_TMO])) break; if (sp > XB_SPIN_CAP) { atomicAdd(&bar[XB_TMO], 1u); break; } }
    }
    nloc = mine > 0u ? mine : 1u; nx = cnt > 0u ? cnt : 1u;
}

__device__ __forceinline__ void xcd_barrier(const XcdBarrier& b) {
    asm volatile("s_waitcnt vmcnt(0)" ::: "memory");
    __syncthreads();
    if (b.w == 0u && __builtin_amdgcn_mbcnt_hi(~0u, __builtin_amdgcn_mbcnt_lo(~0u, 0u)) == 0u) {
        unsigned* bar = b.bar;
        __builtin_amdgcn_s_waitcnt(0);
        unsigned nloc = b.st[0], nx = b.st[1];
        if (nloc == 0u) { xcd_barrier_complete(bar, b.x, nloc, nx); b.st[0] = nloc; b.st[1] = nx; }
        const unsigned old = xb_add(&bar[XB_XSUB(b.x)], 1u);
        const unsigned gen = old / nloc;
        if (old + 1u == (gen + 1u) * nloc) {
            __builtin_amdgcn_fence(__ATOMIC_RELEASE, "agent");
            asm volatile("s_waitcnt vmcnt(0)" ::: "memory");
            const unsigned og = xb_add(&bar[XB_TOP], 1u);
            const unsigned tg = og / nx;
            if (og + 1u == (tg + 1u) * nx) xb_add(&bar[XB_TOPGEN], 1u);
            else XB_SPIN(xb_ld(&bar[XB_TOPGEN]) == tg, bar);
            __builtin_amdgcn_fence(__ATOMIC_ACQUIRE, "agent");
            xb_add(&bar[XB_XGEN(b.x)], 1u);
            asm volatile("s_waitcnt vmcnt(0)" ::: "memory");
        } else {
            XB_SPIN(xb_ld(&bar[XB_XGEN(b.x)]) == gen, bar);
            __builtin_amdgcn_fence(__ATOMIC_ACQUIRE, "agent");
            asm volatile("s_waitcnt vmcnt(0)" ::: "memory");
        }
    }
    __syncthreads();
}

typedef unsigned short bf16;
typedef short bf16x8 __attribute__((ext_vector_type(8)));
typedef float f32x4 __attribute__((ext_vector_type(4)));
typedef unsigned u32x4 __attribute__((ext_vector_type(4)));
typedef unsigned u32x2 __attribute__((ext_vector_type(2)));
typedef float f32x2 __attribute__((ext_vector_type(2)));

constexpr int DM = 2048, SEQ = 8192, CTXL = 256, NR = SEQ + CTXL, DEPTH = 4, BW = 512, PROJW = 5120, DFF = 5632;
constexpr int NCH = NR / 128;
constexpr float EPS = 1e-6f;
constexpr int NWAVES = 8, NTHR = 512;
constexpr int LDT = 136;

constexpr size_t WS_CTL = 0, CTL_BYTES = 1u << 20, CTL_ZERO = 32768;
constexpr size_t LW_WIN = 0;
constexpr size_t LW_WM  = LW_WIN + (size_t)PROJW * DM * 2;
constexpr size_t LW_WB  = LW_WM + (size_t)8192 * DM * 2;
constexpr size_t LW_WO  = LW_WB + (size_t)4 * DM * BW * 2;
constexpr size_t LW_W13 = LW_WO + (size_t)DM * DM * 2;
constexpr size_t LW_W2  = LW_W13 + (size_t)2 * DFF * DM * 2;
constexpr size_t LW_WGLU = LW_W2 + (size_t)DM * DFF * 2;
constexpr size_t LW_WS  = LW_WGLU + (size_t)BW * BW * 2;
constexpr size_t LW_STRIDE = LW_WS + (size_t)4 * 128 * 128 * 2;
constexpr size_t WS_W = CTL_BYTES;
constexpr size_t WS_X = WS_W + DEPTH * LW_STRIDE;
constexpr size_t WS_H = WS_X + (size_t)NR * DM * 4;
constexpr size_t WS_PROJ = WS_H + (size_t)NR * DM * 2;
constexpr size_t WS_O = WS_PROJ + (size_t)NR * PROJW * 2;
constexpr size_t WS_YP = WS_O + (size_t)4 * NR * BW * 2;
constexpr size_t WS_T = WS_YP;
constexpr size_t WS_G = WS_YP + (size_t)NR * 8192 * 2;
constexpr size_t WS_MRG = WS_G + (size_t)NR * 8192 * 2;
constexpr size_t WS_PART = WS_MRG + (size_t)NR * DM * 2;
constexpr size_t WS_S5Y = WS_PART + (size_t)11 * 256 * DM * 4;
constexpr size_t WS_KVT = WS_S5Y + (size_t)NR * BW * 2;
constexpr size_t WS_ST = WS_KVT + (size_t)2 * NCH * 4 * 16384 * 4;
constexpr size_t WS_S5E = WS_ST + (size_t)2 * NCH * 4 * 16384 * 2;
constexpr size_t WS_S5XS = WS_S5E + (size_t)2 * NCH * 32 * 64 * 8;
constexpr size_t WS_MODP = WS_S5XS + (size_t)2 * NCH * 32 * 64 * 8;
constexpr size_t WS_MOD = WS_MODP + (size_t)32 * 4 * 2 * 12288 * 4;
constexpr size_t WS_COS = WS_MOD + (size_t)4 * 2 * 12288 * 4;
constexpr size_t WS_SIN = WS_COS + (size_t)SEQ * 64 * 4;
constexpr size_t WS_S5AB = WS_SIN + (size_t)SEQ * 64 * 4;
constexpr size_t WS_S5AL = WS_S5AB + (size_t)4 * 2 * 32 * 64 * 8;
constexpr size_t WS_S5BW = WS_S5AL + (size_t)4 * 2 * 32 * 64 * 8;
constexpr size_t WS_S5CW = WS_S5BW + (size_t)4 * 2 * 32 * 128 * 32 * 2;
constexpr size_t WS_S5BB = WS_S5CW + (size_t)4 * 32 * 16 * 128 * 2;
constexpr size_t WS_GST = WS_S5BB + (size_t)4 * 2 * 32 * 64 * 16 * 8;
constexpr size_t WS_END = WS_GST + (size_t)NR * 8 * 8;

constexpr int MISC_OFF = 143360, LDS_BYTES = 147456;

enum { I_X = 0, I_C, I_CTX, I_CCTX, I_ADAW, I_ADAB, I_N1G, I_N2G, I_WIN, I_DECAY, I_S5ARE, I_S5AIM, I_S5BRE, I_S5BIM, I_S5CRE, I_S5CIM, I_S5D, I_S5LDT,
       I_WGLU, I_CONVW, I_LNG, I_LNB, I_CWS, I_CBS, I_WBR, I_WMERGE, I_BMERGE, I_WOUT, I_W1, I_W3, I_W2, I_FNG, N_IN };

struct Args { const float* in[N_IN]; float* out; unsigned char* ws; int ph_lo, ph_hi; };

struct Frame { LAS unsigned char* lds; int tid, lane, wave, G, gw, NGW, bid, z; };
__device__ __forceinline__ int lane_id() { return (int)__builtin_amdgcn_mbcnt_hi(~0u, __builtin_amdgcn_mbcnt_lo(~0u, 0u)); }
__device__ __forceinline__ Frame relaunder(const Frame& F0) { Frame F = F0; int w = F0.wave, z = 0, b = F0.bid, g = F0.G; asm volatile("" : "+s"(w), "+s"(z), "+s"(b), "+s"(g)); int ln = lane_id(); asm volatile("" : "+v"(ln)); F.wave = w; F.lane = ln; F.tid = w * 64 + ln; F.z = z; F.bid = b; F.G = g; F.gw = b * 8 + w; F.NGW = g * 8; return F; }

#define LDS_WAIT() asm volatile("s_waitcnt lgkmcnt(0)" ::: "memory")

__device__ __forceinline__ unsigned f2bf(float f) { unsigned u = __builtin_bit_cast(unsigned, f); return (u + 0x7fffu + ((u >> 16) & 1u)) >> 16; }
__device__ __forceinline__ unsigned pk2(float lo, float hi) { return pg8::cvt_pk_bf16(lo, hi); }
__device__ __forceinline__ float bflo(unsigned w) { return __builtin_bit_cast(float, w << 16); }
__device__ __forceinline__ float bfhi(unsigned w) { return __builtin_bit_cast(float, w & 0xffff0000u); }
__device__ __forceinline__ float bf2f(bf16 b) { return __builtin_bit_cast(float, (unsigned)b << 16); }
__device__ __forceinline__ void unpack8(const u32x4 w, float (&f)[8]) {
    f[0] = bflo(w.x); f[1] = bfhi(w.x); f[2] = bflo(w.y); f[3] = bfhi(w.y); f[4] = bflo(w.z); f[5] = bfhi(w.z); f[6] = bflo(w.w); f[7] = bfhi(w.w); }
__device__ __forceinline__ u32x4 pack8(const float (&f)[8]) { u32x4 w; w.x = pk2(f[0], f[1]); w.y = pk2(f[2], f[3]); w.z = pk2(f[4], f[5]); w.w = pk2(f[6], f[7]); return w; }
__device__ __forceinline__ float wave_sum(float v) {
#pragma unroll
    for (int o = 1; o < 64; o <<= 1) v += __shfl_xor(v, o);
    return v;
}
__device__ __forceinline__ float sigmoid_fast(float x) { return __builtin_amdgcn_rcpf(1.f + __builtin_amdgcn_exp2f(-1.4426950408889634f * x)); }
__device__ __forceinline__ float silu_fast(float x) { return x * sigmoid_fast(x); }
__device__ __forceinline__ f32x4 sig4_t(const f32x4 t) { f32x4 e; e[0] = __builtin_amdgcn_exp2f(t[0]); e[1] = __builtin_amdgcn_exp2f(t[1]); e[2] = __builtin_amdgcn_exp2f(t[2]); e[3] = __builtin_amdgcn_exp2f(t[3]);
    const f32x4 d = e + 1.f; f32x4 r; r[0] = __builtin_amdgcn_rcpf(d[0]); r[1] = __builtin_amdgcn_rcpf(d[1]); r[2] = __builtin_amdgcn_rcpf(d[2]); r[3] = __builtin_amdgcn_rcpf(d[3]); return r; }
__device__ __forceinline__ float gelu_tanh(float x) { const float t = x * (x * x * -0.10294324f + -2.3022082f); return x * __builtin_amdgcn_rcpf(1.f + __builtin_amdgcn_exp2f(t)); }
__device__ __forceinline__ float silu_acc(float x) { return x / (1.f + expf(-x)); }

template <int NT>
__device__ __forceinline__ void mma_nt(f32x4 (&acc)[NT], const LAS bf16* A, int lda, const LAS bf16* Bt, int ldb, int K, int lane) {
    const int fr = lane & 15, fq = lane >> 4;
    const LAS bf16* ap = A + fr * lda + 8 * fq;
    const LAS bf16* bp = Bt + fr * ldb + 8 * fq;
    for (int k0 = 0; k0 < K; k0 += 32) {
        const bf16x8 a = *(const LAS bf16x8*)(ap + k0);
#pragma unroll
        for (int n = 0; n < NT; ++n) {
            const bf16x8 b = *(const LAS bf16x8*)(bp + n * 16 * ldb + k0);
            acc[n] = __builtin_amdgcn_mfma_f32_16x16x32_bf16(b, a, acc[n], 0, 0, 0);
        }
    }
}

#ifndef PROBE_KIND
#define PROBE_KIND -1
#endif
#define PREPS(k) ((PROBE_KIND == (k)) ? 2 : 1)
struct RowId { __device__ __forceinline__ int operator()(int n) const { return n; } };
template <int M> struct RowW13 { __device__ __forceinline__ int operator()(int n) const { const int pn = n >> 7, o = n & 127; const int wc = o >> 5, fq = (o >> 3) & 3, bj = (o >> 2) & 1, i = o & 3;
    return 256 * pn + 128 * bj + 32 * wc + 16 * M + 4 * fq + i; } };
template <class RowMap>
__device__ __forceinline__ void transpose2(const Frame& F, const float* src, size_t ldsrc, int K, int N, bf16* dst, int ld_dst, const RowMap rm, int lo, int hi, int wid, int nw) {
    LAS bf16* t = (LAS bf16*)(F.lds + F.wave * 16384);
    const int nblk = N / 64, lane = F.lane, q = lane >> 4, n4 = 4 * (lane & 15);
    for (int it = lo + wid; it < hi; it += nw) {
        const int kb = it / nblk, nb = it % nblk, k0 = 64 * kb, n0 = 64 * nb;
        const float* sp = src + (size_t)(k0 + 16 * q) * ldsrc + n0 + n4;
        f32x4 v[16];
#pragma unroll
        for (int r = 0; r < 16; ++r) v[r] = *(const f32x4*)(sp + (size_t)r * ldsrc);
#pragma unroll
        for (int rq = 0; rq < 4; ++rq)
#pragma unroll
            for (int j = 0; j < 4; ++j) { u32x2 w; w.x = pk2(v[4 * rq][j], v[4 * rq + 1][j]); w.y = pk2(v[4 * rq + 2][j], v[4 * rq + 3][j]);
                *(LAS u32x2*)(t + (n4 + j) * 72 + 16 * q + 4 * rq) = w; }
        LDS_WAIT();
#pragma unroll
        for (int j = 0; j < 8; ++j) { const int n = (lane >> 3) + 8 * j, c = lane & 7;
            *(u32x4*)(dst + (size_t)rm(n0 + n) * ld_dst + k0 + 8 * c) = *(const LAS u32x4*)(t + n * 72 + 8 * c); }
        LDS_WAIT();
    }
}

constexpr int CT_WB = 0, CT_WO = CT_WB + 4 * 8 * 32, CT_W1 = CT_WO + 32 * 32, CT_W3 = CT_W1 + 32 * 88, CT_W2 = CT_W3 + 32 * 88, CT_WIN = CT_W2 + 88 * 32, CT_WM = CT_WIN + 32 * 80, CT_WG = CT_WM + 32 * 128, CT_END = CT_WG + 64;
__device__ __forceinline__ void convert_tiles(const Frame& F, const Args& P, int l, int a, int b, int wid, int nw) {
#define CT_SEG(off, cnt, call) do { const int lo_ = (a > (off) ? a : (off)) - (off), hi_ = (b < (off) + (cnt) ? b : (off) + (cnt)) - (off); if (lo_ < hi_) { const int lo = lo_, hi = hi_; call; } } while (0)
    if (l >= 0 && a < CT_WIN) {
        unsigned char* lw = (P.ws + F.z) + WS_W + (size_t)l * LW_STRIDE;
#pragma unroll 1
        for (int k = 0; k < 4; ++k)
            CT_SEG(CT_WB + k * 256, 256, transpose2(F, P.in[I_WBR + F.z] + ((size_t)l * 4 + k) * BW * DM, DM, BW, DM, (bf16*)(lw + LW_WB) + (size_t)k * DM * BW, BW, RowId{}, lo, hi, wid, nw));
        CT_SEG(CT_WO, 32 * 32, transpose2(F, P.in[I_WOUT + F.z] + (size_t)l * DM * DM, DM, DM, DM, (bf16*)(lw + LW_WO), DM, RowId{}, lo, hi, wid, nw));
        CT_SEG(CT_W1, 32 * 88, transpose2(F, P.in[I_W1 + F.z] + (size_t)l * DM * DFF, DFF, DM, DFF, (bf16*)(lw + LW_W13), DM, RowW13<0>{}, lo, hi, wid, nw));
        CT_SEG(CT_W3, 32 * 88, transpose2(F, P.in[I_W3 + F.z] + (size_t)l * DM * DFF, DFF, DM, DFF, (bf16*)(lw + LW_W13), DM, RowW13<1>{}, lo, hi, wid, nw));
        CT_SEG(CT_W2, 88 * 32, transpose2(F, P.in[I_W2 + F.z] + (size_t)l * DFF * DM, DM, DFF, DM, (bf16*)(lw + LW_W2), DFF, RowId{}, lo, hi, wid, nw));
    }
    if (l + 1 < DEPTH && b > CT_WIN) {
        const int l1 = l + 1; unsigned char* lw = (P.ws + F.z) + WS_W + (size_t)l1 * LW_STRIDE;
        CT_SEG(CT_WIN, 32 * 80, transpose2(F, P.in[I_WIN + F.z] + (size_t)l1 * DM * PROJW, PROJW, DM, PROJW, (bf16*)(lw + LW_WIN), DM, RowId{}, lo, hi, wid, nw));
        CT_SEG(CT_WM, 32 * 128, transpose2(F, P.in[I_WMERGE + F.z] + (size_t)l1 * DM * 8192, 8192, DM, 8192, (bf16*)(lw + LW_WM), DM, RowId{}, lo, hi, wid, nw));
        CT_SEG(CT_WG, 64, transpose2(F, P.in[I_WGLU + F.z] + (size_t)l1 * BW * BW, BW, BW, BW, (bf16*)(lw + LW_WGLU), BW, RowId{}, lo, hi, wid, nw));
    }
#undef CT_SEG
}
#ifndef CT_G1P
#define CT_G1P 4816
#endif
#ifndef CT_GLU
#define CT_GLU 2200
#endif
#ifndef CT_YP
#define CT_YP 1800
#endif
#ifndef CT_WOP
#define CT_WOP 2600
#endif
#ifndef CT_F1P
#define CT_F1P 3800
#endif
#ifndef CT_F2P
#define CT_F2P 2000
#endif
constexpr int CT_R0 = CT_G1P, CT_R1 = CT_R0 + CT_GLU, CT_R2 = CT_R1 + CT_YP, CT_R3 = CT_R2 + CT_WOP, CT_R4 = CT_R3 + CT_F1P, CT_C = CT_R4 + CT_F2P;
static_assert(CT_C <= CT_END, "shadow conversion ranges exceed a layer's tile list");
#define SHADOW(first, lo, hi) do { if (F.G == 256 && F.bid >= (first)) { const Frame Fc = relaunder(F0); convert_tiles(Fc, P, l, (lo), (hi), (Fc.bid - (first)) * NWAVES + Fc.wave, (Fc.G - (first)) * NWAVES); } } while (0)
constexpr int CT_L3A = CT_W2 - 1800, CT_L3B = CT_W2;
static_assert(CT_L3B <= CT_W2 && CT_R0 >= CT_W1 && CT_R3 >= CT_W2 && CT_R4 >= CT_WIN, "conversion deadlines");

__device__ __forceinline__ void prologue_a(const Frame& F, const Args& P) {
    unsigned char* ws = (P.ws + F.z);
    for (int l = 0; l < DEPTH; ++l) {
        if (l == 0) convert_tiles(F, P, -1, CT_WIN, CT_END, F.gw, F.NGW);
        if (F.G != 256) convert_tiles(F, P, l, 0, CT_END, F.gw, F.NGW);
        unsigned char* lw = ws + WS_W + (size_t)l * LW_STRIDE;
        { const float* s = P.in[I_CWS + F.z] + (size_t)l * 4 * 128 * 128; bf16* d = (bf16*)(lw + LW_WS);
          for (int i = F.bid * NTHR + F.tid; i < 4 * 128 * 128; i += F.G * NTHR) d[i] = (bf16)f2bf(s[i]); }
    }
    __syncthreads();
    {
        LAS float* sl = (LAS float*)F.lds; LAS float* sc = sl + DM;
        for (int i = F.tid; i < DM; i += NTHR) { sl[i] = silu_acc(P.in[I_C + F.z][i]); sc[i] = silu_acc(P.in[I_CCTX + F.z][i]); }
        __syncthreads();
        float* MODP = (float*)(ws + WS_MODP);
        for (int rr = 0; rr < PREPS(31); ++rr)
        for (int it = F.bid; it < 4 * 6 * 32; it += F.G) {
            const int l = it / 192, r = it % 192, jb = r >> 5, sli = r & 31, j = jb * 2048 + 4 * F.tid, i0 = sli * 64;
            const float* w = P.in[I_ADAW + F.z] + ((size_t)l * DM + i0) * 12288 + j;
            f32x4 a0 = (f32x4){0.f, 0.f, 0.f, 0.f}, a1 = a0;
#pragma unroll 32
            for (int i = 0; i < 64; ++i) { const f32x4 wv = *(const f32x4*)(w + (size_t)i * 12288); a0 = a0 + wv * sl[i0 + i]; a1 = a1 + wv * sc[i0 + i]; }
            *(f32x4*)(MODP + ((size_t)(sli * 4 + l) * 2 + 0) * 12288 + j) = a0; *(f32x4*)(MODP + ((size_t)(sli * 4 + l) * 2 + 1) * 12288 + j) = a1;
        }
    }
    const int gt = F.bid * NTHR + F.tid, GT = F.G * NTHR;
    for (int rr = 0; rr < PREPS(32); ++rr)
    for (int idx = gt; idx < 4 * 2 * 32 * 128; idx += GT) {
        const int n = idx & 127, p = n >> 1, ri = n & 1, g = (idx >> 7) & 31, dir = (idx >> 12) & 1, l = idx >> 13;
        const float a_re = P.in[I_S5ARE + F.z][(l * 32 + g) * 64 + p], a_im = P.in[I_S5AIM + F.z][(l * 32 + g) * 64 + p];
        const float dt = expf(P.in[I_S5LDT + F.z][(l * 2 + dir) * 32 + g]);
        const float mag = expf(dt * a_re), ang = dt * a_im, abr = mag * cosf(ang), abi = mag * sinf(ang);
        const float nr = abr - 1.f, ni = abi, den = a_re * a_re + a_im * a_im;
        const float fre = (nr * a_re + ni * a_im) / den, fim = (ni * a_re - nr * a_im) / den;
        const size_t bi = ((size_t)((l * 2 + dir) * 32 + g) * 64 + p) * 16;
        const float* bre = P.in[I_S5BRE + F.z] + bi; const float* bim = P.in[I_S5BIM + F.z] + bi;
        bf16* bw = (bf16*)(ws + WS_S5BW) + (size_t)idx * 32;
        float* bbf = (float*)(ws + WS_S5BB) + ((size_t)(((l * 2 + dir) * 32 + g) * 64 + p) * 16) * 2 + ri;
        f32x4 brv[4], biv[4];
#pragma unroll
        for (int c4 = 0; c4 < 4; ++c4) { brv[c4] = *(const f32x4*)(bre + 4 * c4); biv[c4] = *(const f32x4*)(bim + 4 * c4); }
#pragma unroll
        for (int c = 0; c < 16; ++c) { const float br_ = brv[c >> 2][c & 3], bi_ = biv[c >> 2][c & 3]; const float v = ri ? (fre * bi_ + fim * br_) : (fre * br_ - fim * bi_);
            bbf[2 * c] = v;
            const unsigned hi = f2bf(v); const float hf = __builtin_bit_cast(float, hi << 16); bw[c] = (bf16)hi; bw[16 + c] = (bf16)f2bf(v - hf); }
        if (ri == 0) { const int i2 = ((l * 2 + dir) * 32 + g) * 64 + p;
            ((float2*)(ws + WS_S5AB))[i2] = make_float2(abr, abi);
            float pr = abr, pi = abi;
            for (int s2 = 0; s2 < 7; ++s2) { const float t = pr * pr - pi * pi; pi = 2.f * pr * pi; pr = t; }
            ((float2*)(ws + WS_S5AL))[i2] = make_float2(pr, pi); }
    }
    for (int rr = 0; rr < PREPS(32); ++rr)
    for (int idx = gt; idx < 4 * 32 * 16 * 128; idx += GT) {
        const int n = idx & 127, p = n >> 1, ch = (idx >> 7) & 15, lg = idx >> 11;
        const size_t ci = ((size_t)lg * 16 + ch) * 64 + p;
        ((bf16*)(ws + WS_S5CW))[idx] = (bf16)f2bf((n & 1) ? -P.in[I_S5CIM + F.z][ci] : P.in[I_S5CRE + F.z][ci]);
    }
    {
        float* COS = (float*)(ws + WS_COS); float* SIN = (float*)(ws + WS_SIN);
        for (int idx = gt; idx < 192 * 32; idx += GT) {
            const int r = idx >> 5, j = idx & 31;
            const float fr = expf(-((float)j / 32.f) * 9.210340371976184f);
            const float ang = (float)(r < 128 ? r : r - 128) * fr;
            COS[idx] = cosf(ang); SIN[idx] = sinf(ang);
        }
    }
}
__device__ __forceinline__ void prologue_b(const Frame& F, const Args& P) {
    const float* MODP = (const float*)((P.ws + F.z) + WS_MODP); float* MOD = (float*)((P.ws + F.z) + WS_MOD);
    for (int idx = F.bid * NTHR + F.tid; idx < 4 * 2 * 12288; idx += F.G * NTHR) {
        const int l = idx / 24576, j = idx % 12288;
        float s = P.in[I_ADAB + F.z][l * 12288 + j];
        float pv[32];
#pragma unroll
        for (int k = 0; k < 32; ++k) pv[k] = MODP[(size_t)k * 98304 + idx];
#pragma unroll
        for (int k = 0; k < 32; ++k) s += pv[k];
        MOD[idx] = s;
    }
}

__device__ __forceinline__ void load_row(f32x4 (&v)[8], const void* base, int f32src, size_t row, int lane) {
    if (f32src) {
#pragma unroll
        for (int j = 0; j < 8; ++j) v[j] = *((const f32x4*)((const float*)base + row * DM) + lane + 64 * j);
    } else {
        u32x2 w[8];
#pragma unroll
        for (int j = 0; j < 8; ++j) w[j] = *((const u32x2*)((const bf16*)base + row * DM) + lane + 64 * j);
#pragma unroll
        for (int j = 0; j < 8; ++j) { v[j].x = __uint_as_float(w[j].x << 16); v[j].y = __uint_as_float(w[j].x & 0xffff0000u); v[j].z = __uint_as_float(w[j].y << 16); v[j].w = __uint_as_float(w[j].y & 0xffff0000u); }
    }
}
__device__ __forceinline__ void norm_phase(const Frame& F, const Args& P, int l, const float* gvec, int ish, int isc, int npart, const float* gate_ctx, const void* rd_lat, int lat_f32, const void* rd_ctx, int ctx_f32) {
    LAS float* ga = (LAS float*)F.lds; LAS float* sh = ga + 2 * DM;
    LAS float* gc = sh + 2 * DM;
    f32x4 vn[8];
    if (F.gw < NR) { if (F.gw < CTXL) load_row(vn, rd_ctx, ctx_f32, F.gw, F.lane); else load_row(vn, rd_lat, lat_f32, F.gw, F.lane); }
    if (npart > 0) for (int i = F.tid; i < DM; i += NTHR) gc[i] = gate_ctx[i];
    const float* MOD = (const float*)((P.ws + F.z) + WS_MOD) + (size_t)l * 2 * 12288;
    for (int i = F.tid; i < 2 * DM; i += NTHR) { const int s = i / DM, c = i % DM; ga[i] = gvec[c] * (1.f + MOD[s * 12288 + isc * DM + c]); sh[i] = MOD[s * 12288 + ish * DM + c]; }
    __syncthreads();
    bf16* X = (bf16*)((P.ws + F.z) + WS_X); bf16* H = (bf16*)((P.ws + F.z) + WS_H); const float* PART = (const float*)((P.ws + F.z) + WS_PART);
    for (int row = F.gw; row < NR; row += F.NGW) {
        const int s = row < CTXL ? 1 : 0;
        f32x4 v[8]; float ss = 0.f;
#pragma unroll
        for (int j = 0; j < 8; ++j) v[j] = vn[j];
        if (row + F.NGW < NR) load_row(vn, rd_lat, lat_f32, row + F.NGW, F.lane);
        if (row < CTXL && npart > 0) {
            u32x2* xr = (u32x2*)(X + (size_t)row * DM) + F.lane;
#pragma unroll
            for (int j = 0; j < 8; ++j) { f32x4 pv[11];
#pragma unroll
                for (int q = 0; q < 11; ++q) pv[q] = q < npart ? *((const f32x4*)(PART + ((size_t)q * 256 + row) * DM) + F.lane + 64 * j) : (f32x4){0.f, 0.f, 0.f, 0.f};
                f32x4 a = pv[0];
#pragma unroll
                for (int q = 1; q < 11; ++q) a = a + pv[q];
                v[j] = v[j] + a * *(const LAS f32x4*)(gc + 4 * F.lane + 256 * j); u32x2 w; w.x = pk2(v[j].x, v[j].y); w.y = pk2(v[j].z, v[j].w); xr[64 * j] = w; }
        }
#pragma unroll
        for (int j = 0; j < 8; ++j) { ss += (v[j].x * v[j].x + v[j].y * v[j].y) + (v[j].z * v[j].z + v[j].w * v[j].w); }
        const float rstd = 1.f / sqrtf(wave_sum(ss) * (1.f / DM) + EPS);
        u32x2* o = (u32x2*)(H + (size_t)row * DM) + F.lane;
#pragma unroll
        for (int j = 0; j < 8; ++j) { const f32x4 g4 = *(const LAS f32x4*)(ga + s * DM + 4 * F.lane + 256 * j), s4 = *(const LAS f32x4*)(sh + s * DM + 4 * F.lane + 256 * j);
            u32x2 w; w.x = pk2(v[j].x * rstd * g4.x + s4.x, v[j].y * rstd * g4.y + s4.y); w.y = pk2(v[j].z * rstd * g4.z + s4.z, v[j].w * rstd * g4.w + s4.w); o[64 * j] = w; }
    }
}
__device__ __forceinline__ void final_norm(const Frame& F, const Args& P) {
    const bf16* X = (const bf16*)((P.ws + F.z) + WS_X); const float* g = P.in[I_FNG + F.z];
    f32x4 vn[8];
    if (CTXL + F.gw < NR) load_row(vn, X, 0, CTXL + F.gw, F.lane);
    for (int row = CTXL + F.gw; row < NR; row += F.NGW) {
        f32x4 v[8]; float ss = 0.f;
#pragma unroll
        for (int j = 0; j < 8; ++j) v[j] = vn[j];
        if (row + F.NGW < NR) load_row(vn, X, 0, row + F.NGW, F.lane);
#pragma unroll
        for (int j = 0; j < 8; ++j) ss += (v[j].x * v[j].x + v[j].y * v[j].y) + (v[j].z * v[j].z + v[j].w * v[j].w);
        const float rstd = 1.f / sqrtf(wave_sum(ss) * (1.f / DM) + EPS);
        f32x4* o = (f32x4*)(P.out + (size_t)(row - CTXL) * DM) + F.lane;
#pragma unroll
        for (int j = 0; j < 8; ++j) { const f32x4 g4 = *((const f32x4*)g + F.lane + 64 * j); o[64 * j] = v[j] * rstd * g4; }
    }
}

using pg8::Unit;
__device__ __forceinline__ unsigned q8(float g) { return (unsigned)(g * 255.f + 0.5f); }
struct EpiG1 {
    static constexpr bool PERM = true, AFTER_DRAIN = false;
    bf16* PROJ; bf16* G; const float* bias; int pn_off; float* GST;
    __device__ __forceinline__ void operator()(const f32x4 (&acc)[2][2][4][2], const Unit& u0, int wr, int wc, int fr, int fq) const {
        Unit u = u0; u.pn += pn_off;
        const int row0 = u.pm * 256 + wr * 64 + fr;
        if (u.pn < 20) {
            const int col0 = u.pn * 256 + wc * 32 + 8 * fq;
#pragma unroll
            for (int ai = 0; ai < 2; ++ai)
#pragma unroll
                for (int m = 0; m < 4; ++m) { bf16* rowp = PROJ + (size_t)(row0 + ai * 128 + m * 16) * PROJW + col0;
#pragma unroll
                    for (int bj = 0; bj < 2; ++bj) { const f32x4 v0 = acc[ai][bj][m][0], v1 = acc[ai][bj][m][1];
                        u32x4 w; w.x = pg8::cvt_pk_bf16(v0[0], v0[1]); w.y = pg8::cvt_pk_bf16(v0[2], v0[3]); w.z = pg8::cvt_pk_bf16(v1[0], v1[1]); w.w = pg8::cvt_pk_bf16(v1[2], v1[3]);
                        *(u32x4*)(rowp + bj * 128) = w; } }
            if (u.pn == 18 || u.pn == 19) {
#pragma unroll
                for (int ai = 0; ai < 2; ++ai)
#pragma unroll
                    for (int m = 0; m < 4; ++m) { float s = 0.f, s2 = 0.f;
#pragma unroll
                        for (int bj = 0; bj < 2; ++bj)
#pragma unroll
                            for (int n = 0; n < 2; ++n)
#pragma unroll
                                for (int i = 0; i < 4; i += 2) { const unsigned pw = pg8::cvt_pk_bf16(acc[ai][bj][m][n][i], acc[ai][bj][m][n][i + 1]); const float g0 = gelu_tanh(bflo(pw)), g1 = gelu_tanh(bfhi(pw)); s += g0 + g1; s2 += g0 * g0 + g1 * g1; }
                        s += __shfl_xor(s, 16); s += __shfl_xor(s, 32); s2 += __shfl_xor(s2, 16); s2 += __shfl_xor(s2, 32);
                        if (fq == 0) *(f32x2*)(GST + ((size_t)(row0 + ai * 128 + m * 16) * 8 + (u.pn - 18) * 4 + wc) * 2) = (f32x2){s, s2}; }
            }
        } else {
            const int col0 = (u.pn - 20) * 256 + wc * 32 + 8 * fq;
            f32x4 bv[2][2];
#pragma unroll
            for (int bj = 0; bj < 2; ++bj)
#pragma unroll
                for (int n = 0; n < 2; ++n) bv[bj][n] = *(const f32x4*)(bias + col0 + bj * 128 + 4 * n) * -1.4426950408889634f;
#pragma unroll
            for (int ai = 0; ai < 2; ++ai)
#pragma unroll
                for (int m = 0; m < 4; ++m) { unsigned char* rowp = (unsigned char*)G + (size_t)(row0 + ai * 128 + m * 16) * 8192 + col0;
#pragma unroll
                    for (int bj = 0; bj < 2; ++bj) { const f32x4 g0 = sig4_t(acc[ai][bj][m][0] * -1.4426950408889634f + bv[bj][0]) * 255.f + 0.5f, g1 = sig4_t(acc[ai][bj][m][1] * -1.4426950408889634f + bv[bj][1]) * 255.f + 0.5f;
                        u32x2 w; w.x = (unsigned)g0[0] | ((unsigned)g0[1] << 8) | ((unsigned)g0[2] << 16) | ((unsigned)g0[3] << 24);
                        w.y = (unsigned)g1[0] | ((unsigned)g1[1] << 8) | ((unsigned)g1[2] << 16) | ((unsigned)g1[3] << 24);
                        *(u32x2*)(rowp + bj * 128) = w; } }
        }
    }
};
struct EpiY {
    static constexpr bool PERM = true, AFTER_DRAIN = false;
    bf16* Y;
    __device__ __forceinline__ void operator()(const f32x4 (&acc)[2][2][4][2], const Unit& u, int wr, int wc, int fr, int fq) const {
        const int k = u.pn >> 3; const int row0 = (u.pm - 33 * k) * 256 + wr * 64 + fr, col0 = u.pn * 256 + wc * 32 + 8 * fq;
#pragma unroll
        for (int ai = 0; ai < 2; ++ai)
#pragma unroll
            for (int m = 0; m < 4; ++m) { bf16* rowp = Y + (size_t)(row0 + ai * 128 + m * 16) * 8192 + col0;
#pragma unroll
                for (int bj = 0; bj < 2; ++bj) { const f32x4 v0 = acc[ai][bj][m][0], v1 = acc[ai][bj][m][1];
                    u32x4 w; w.x = pg8::cvt_pk_bf16(v0[0], v0[1]); w.y = pg8::cvt_pk_bf16(v0[2], v0[3]); w.z = pg8::cvt_pk_bf16(v1[0], v1[1]); w.w = pg8::cvt_pk_bf16(v1[2], v1[3]);
                    *(u32x4*)(rowp + bj * 128) = w; } }
    }
};
struct EpiGlu {
    static constexpr bool PERM = true, AFTER_DRAIN = false;
    const bf16* S5Y; bf16* O1;
    __device__ __forceinline__ void operator()(const f32x4 (&acc)[2][2][4][2], const Unit& u, int wr, int wc, int fr, int fq) const {
        const int row0 = u.pm * 256 + wr * 64 + fr, col0 = u.pn * 256 + wc * 32 + 8 * fq;
#pragma unroll
        for (int ai = 0; ai < 2; ++ai)
#pragma unroll
            for (int m = 0; m < 4; ++m) { const size_t ro = (size_t)(row0 + ai * 128 + m * 16) * BW + col0;
#pragma unroll
                for (int bj = 0; bj < 2; ++bj) { const f32x4 v0 = acc[ai][bj][m][0], v1 = acc[ai][bj][m][1];
                    const u32x4 yw = *(const u32x4*)(S5Y + ro + bj * 128); float y[8]; unpack8(yw, y);
                    float o[8];
#pragma unroll
                    for (int i = 0; i < 4; ++i) { o[i] = sigmoid_fast(v0[i]) * y[i]; o[4 + i] = sigmoid_fast(v1[i]) * y[4 + i]; }
                    u32x4 w; w.x = pg8::cvt_pk_bf16(o[0], o[1]); w.y = pg8::cvt_pk_bf16(o[2], o[3]); w.z = pg8::cvt_pk_bf16(o[4], o[5]); w.w = pg8::cvt_pk_bf16(o[6], o[7]);
                    *(u32x4*)(O1 + ro + bj * 128) = w; } }
    }
};
struct EpiRes {
    static constexpr bool PERM = true, AFTER_DRAIN = false;
    bf16* X; const float* g_lat; float* PART; int dry; const void* Xr; int xr_f32;
    template <bool F32>
    __device__ __forceinline__ void latent(const f32x4 (&acc)[2][2][4][2], int row0, int col0) const {
        f32x4 gv[2][2];
#pragma unroll
        for (int bj = 0; bj < 2; ++bj)
#pragma unroll
            for (int n = 0; n < 2; ++n) gv[bj][n] = *(const f32x4*)(g_lat + col0 + bj * 128 + n * 4);
#pragma unroll
        for (int ai = 0; ai < 2; ++ai)
#pragma unroll
            for (int m = 0; m < 4; ++m) { const size_t off = (size_t)(row0 + ai * 128 + m * 16) * DM + col0;
#pragma unroll
                for (int bj = 0; bj < 2; ++bj) { f32x4 x0, x1;
                    if (F32) { const float* p = (const float*)Xr + off + bj * 128; x0 = *(const f32x4*)p; x1 = *(const f32x4*)(p + 4); }
                    else { const u32x4 r = *(const u32x4*)((const bf16*)Xr + off + bj * 128); float a[8]; unpack8(r, a); x0 = (f32x4){a[0], a[1], a[2], a[3]}; x1 = (f32x4){a[4], a[5], a[6], a[7]}; }
                    x0 = x0 + gv[bj][0] * acc[ai][bj][m][0]; x1 = x1 + gv[bj][1] * acc[ai][bj][m][1];
                    u32x4 w; w.x = pg8::cvt_pk_bf16(x0[0], x0[1]); w.y = pg8::cvt_pk_bf16(x0[2], x0[3]); w.z = pg8::cvt_pk_bf16(x1[0], x1[1]); w.w = pg8::cvt_pk_bf16(x1[2], x1[3]);
                    *(u32x4*)(X + off + bj * 128) = w; } }
    }
    __device__ __forceinline__ void operator()(const f32x4 (&acc)[2][2][4][2], const Unit& u, int wr, int wc, int fr, int fq) const {
        const int row0 = u.pm * 256 + wr * 64 + fr, col0 = u.pn * 256 + wc * 32 + 8 * fq;
        if (dry) return;
#ifdef EXP_NOSPLIT
        if (false) {
#else
        if (u.pm == 0) {
#endif
            float* base = PART + (size_t)(u.k0 / (u.nt * 64)) * 256 * DM;
#pragma unroll
            for (int ai = 0; ai < 2; ++ai)
#pragma unroll
                for (int m = 0; m < 4; ++m) { float* rowp = base + (size_t)(row0 + ai * 128 + m * 16) * DM + col0;
#pragma unroll
                    for (int bj = 0; bj < 2; ++bj)
#pragma unroll
                        for (int n = 0; n < 2; ++n) *(f32x4*)(rowp + bj * 128 + n * 4) = acc[ai][bj][m][n]; }
        } else {
            if (xr_f32) latent<true>(acc, row0, col0); else latent<false>(acc, row0, col0);
        }
    }
};
struct EpiFfn1 {
    static constexpr bool PERM = false, AFTER_DRAIN = false;
    bf16* T;
    __device__ __forceinline__ void operator()(const f32x4 (&acc)[2][2][4][2], const Unit& u, int wr, int wc, int fr, int fq) const {
        const int row0 = u.pm * 256 + wr * 64 + fr, col0 = u.pn * 128 + wc * 32 + 8 * fq;
#pragma unroll
        for (int ai = 0; ai < 2; ++ai)
#pragma unroll
            for (int m = 0; m < 4; ++m) { bf16* rowp = T + (size_t)(row0 + ai * 128 + m * 16) * DFF + col0;
                float o[8];
#pragma unroll
                for (int bj = 0; bj < 2; ++bj)
#pragma unroll
                    for (int i = 0; i < 4; ++i) o[4 * bj + i] = 0.f;
#pragma unroll
                for (int bj = 0; bj < 2; ++bj) { const f32x4 a = acc[ai][bj][m][0]; const f32x4 r = (a * acc[ai][bj][m][1]) * sig4_t(a * -1.4426950408889634f); o[4 * bj] = r[0]; o[4 * bj + 1] = r[1]; o[4 * bj + 2] = r[2]; o[4 * bj + 3] = r[3]; }
                u32x4 w; w.x = pg8::cvt_pk_bf16(o[0], o[1]); w.y = pg8::cvt_pk_bf16(o[2], o[3]); w.z = pg8::cvt_pk_bf16(o[4], o[5]); w.w = pg8::cvt_pk_bf16(o[6], o[7]);
                *(u32x4*)rowp = w; }
    }
};
struct YOrder {
    pg8::StaticOrder S; int rows;
    __device__ void init(int G, int c, int rows_) { rows = rows_; S.init(4 * rows_ * 256, DM, BW, G, c); }
    __device__ bool next(int i, Unit& u) const { if (!S.next(i, u)) return false; const int k = u.pm / rows, r = u.pm - k * rows; u.pm = k * 33 + (33 - rows) + r; u.pn += k * 8; return true; }
    __device__ __forceinline__ void a_ready(const Unit&) const {}
    __device__ __forceinline__ void done(const Unit&) const {}
};

struct SplitOrder {
    int G, c, nt_full, nsl, nt_sl, ctx;
    __device__ bool next(int i, Unit& u) const {
        const long L = (long)i * G + c;
        if (L < 256) { const int w = (int)L, x = w & 7, o = w >> 3;
            u.pm = 1 + x * 4 + (o & 3); u.pn = o >> 2; u.k0 = 0; u.nt = nt_full; return true; }
        const int j = (int)(L - 256);
#ifdef EXP_NOSPLIT
        if (ctx && j < 8) { u.pm = 0; u.pn = j; u.k0 = 0; u.nt = nt_full; return true; }
#else
        if (ctx && j < 8 * nsl) { u.pm = 0; u.pn = j & 7; u.k0 = (j >> 3) * nt_sl * 64; u.nt = nt_sl; return true; }
#endif
        return false;
    }
    __device__ __forceinline__ void a_ready(const Unit&) const {}
    __device__ __forceinline__ void done(const Unit&) const {}
};

__device__ __forceinline__ float log2_sigmoid(float x) { return -log1pf(expf(-x)) * 1.4426950408889634f; }
__device__ __forceinline__ float dec_lg(const Frame& F, const Args& P, int l, int dir, int h) { return log2_sigmoid(P.in[I_DECAY + F.z][(l * 2 + dir) * 4 + h]); }

__device__ __forceinline__ int rope_idx(int pos, int j0) { return ((j0 < 32) ? (pos >> 6) : 128 + (pos & 63)) * 32 + (j0 & 31); }
template <bool TRANS>
__device__ __forceinline__ void stage_qk(const Frame& F, const Args& P, LAS bf16* dst, int row0, int sec, int h, float scale) {
    const bf16* PROJ = (const bf16*)((P.ws + F.z) + WS_PROJ); const float* COS = (const float*)((P.ws + F.z) + WS_COS); const float* SIN = (const float*)((P.ws + F.z) + WS_SIN);
    const bool lat = row0 >= CTXL;
    if (!TRANS) {
#pragma unroll
        for (int rep = 0; rep < 2; ++rep) {
            const int w = F.tid + NTHR * rep, t = w >> 3, j0 = (w & 7) * 8;
            const bf16* kp = PROJ + (size_t)(row0 + t) * PROJW + sec * BW + h * 128;
            float a[8], b[8]; unpack8(*(const u32x4*)(kp + j0), a); unpack8(*(const u32x4*)(kp + 64 + j0), b);
            float o1[8], o2[8];
            if (lat) {
                const int pos = row0 + t - CTXL; const int ri = rope_idx(pos, j0); const float* cp = COS + ri; const float* sp = SIN + ri;
#pragma unroll
                for (int e = 0; e < 8; ++e) { const float c = cp[e], s = sp[e]; o1[e] = (a[e] * c - b[e] * s) * scale; o2[e] = (a[e] * s + b[e] * c) * scale; }
            } else {
#pragma unroll
                for (int e = 0; e < 8; ++e) { o1[e] = a[e] * scale; o2[e] = b[e] * scale; }
            }
            *(LAS u32x4*)(dst + t * LDT + j0) = pack8(o1); *(LAS u32x4*)(dst + t * LDT + 64 + j0) = pack8(o2);
        }
    } else {
        const int tp = F.tid >> 3, j0 = (F.tid & 7) * 8, t = 2 * tp;
        const bf16* kp = PROJ + (size_t)(row0 + t) * PROJW + sec * BW + h * 128;
        float a0[8], b0[8], a1[8], b1[8];
        unpack8(*(const u32x4*)(kp + j0), a0); unpack8(*(const u32x4*)(kp + 64 + j0), b0); unpack8(*(const u32x4*)(kp + PROJW + j0), a1); unpack8(*(const u32x4*)(kp + PROJW + 64 + j0), b1);
        if (lat) {
            const int pos = row0 + t - CTXL; const int ri = rope_idx(pos, j0), d1 = rope_idx(pos + 1, j0) - ri; const float* cp = COS + ri; const float* sp = SIN + ri;
#pragma unroll
            for (int e = 0; e < 8; ++e) { const float c0 = cp[e], s0 = sp[e], c1 = cp[d1 + e], s1 = sp[d1 + e];
                const float x0 = a0[e] * c0 - b0[e] * s0, y0 = a0[e] * s0 + b0[e] * c0, x1 = a1[e] * c1 - b1[e] * s1, y1 = a1[e] * s1 + b1[e] * c1;
                a0[e] = x0; b0[e] = y0; a1[e] = x1; b1[e] = y1; }
        }
#pragma unroll
        for (int e = 0; e < 8; ++e) { *(LAS unsigned*)(dst + (j0 + e) * LDT + t) = pk2(a0[e] * scale, a1[e] * scale); *(LAS unsigned*)(dst + (64 + j0 + e) * LDT + t) = pk2(b0[e] * scale, b1[e] * scale); }
    }
}
template <int MODE>
__device__ __forceinline__ void stage_vt(const Frame& F, const Args& P, LAS bf16* dst, LAS bf16* dst2, int row0, int h, float lg, float lg2) {
    const bf16* PROJ = (const bf16*)((P.ws + F.z) + WS_PROJ);
#pragma unroll
    for (int rep = 0; rep < 2; ++rep) {
        const int w = F.tid + NTHR * rep, tp = w >> 4, d0 = (w & 15) * 8, t = 2 * tp;
        const bf16* vp = PROJ + (size_t)(row0 + t) * PROJW + 2 * BW + h * 128 + d0;
        float v0[8], v1[8]; unpack8(*(const u32x4*)vp, v0); unpack8(*(const u32x4*)(vp + PROJW), v1);
        if (MODE == 0) {
#pragma unroll
            for (int e = 0; e < 8; ++e) *(LAS unsigned*)(dst + (d0 + e) * LDT + t) = pk2(v0[e], v1[e]);
        } else {
            const float f0 = exp2f(lg * (float)(127 - t)), f1 = exp2f(lg * (float)(126 - t)), b0 = exp2f(lg2 * (float)t), b1 = exp2f(lg2 * (float)(t + 1));
#pragma unroll
            for (int e = 0; e < 8; ++e) { *(LAS unsigned*)(dst + (d0 + e) * LDT + t) = pk2(v0[e] * f0, v1[e] * f1); *(LAS unsigned*)(dst2 + (d0 + e) * LDT + t) = pk2(v0[e] * b0, v1[e] * b1); }
        }
    }
}

__device__ __forceinline__ void ret_kv_phase(const Frame& F, const Args& P, int l, const int it) {
    LAS bf16* KT = (LAS bf16*)F.lds; LAS bf16* VF = KT + 128 * LDT; LAS bf16* VB = VF + 128 * LDT;
    float* KVT = (float*)((P.ws + F.z) + WS_KVT);
    const int fr = F.lane & 15, fq = F.lane >> 4;
    {
        const int c = it >> 2, h = it & 3, row0 = c * 128;
        __syncthreads();
        stage_qk<true>(F, P, KT, row0, 1, h, 1.f);
        stage_vt<1>(F, P, VF, VB, row0, h, dec_lg(F, P, l, 0, h), dec_lg(F, P, l, 1, h));
        __syncthreads();
        f32x4 af[8], ab[8];
#pragma unroll
        for (int n = 0; n < 8; ++n) { af[n] = (f32x4){0.f, 0.f, 0.f, 0.f}; ab[n] = (f32x4){0.f, 0.f, 0.f, 0.f}; }
        mma_nt<8>(af, VF + 16 * F.wave * LDT, LDT, KT, LDT, 128, F.lane);
        mma_nt<8>(ab, VB + 16 * F.wave * LDT, LDT, KT, LDT, 128, F.lane);
        float* of = KVT + ((((size_t)0 * NCH + c) * 4 + h) * 128 + 16 * F.wave + fr) * 128 + 4 * fq;
        float* ob = KVT + ((((size_t)1 * NCH + c) * 4 + h) * 128 + 16 * F.wave + fr) * 128 + 4 * fq;
#pragma unroll
        for (int n = 0; n < 8; ++n) { *(f32x4*)(of + 16 * n) = af[n]; *(f32x4*)(ob + 16 * n) = ab[n]; }
    }
}
__device__ __forceinline__ int bwd_chunk(int step) { return step < 2 ? 1 - step : NCH + 1 - step; }

__device__ __forceinline__ void s5_pass1(const Frame& F, const Args& P, int l) {
    LAS float* U = (LAS float*)(F.lds + F.wave * 17408);
    const bf16* PROJ = (const bf16*)((P.ws + F.z) + WS_PROJ);
    float2* E = (float2*)((P.ws + F.z) + WS_S5E);
    for (int it = F.gw; it < NCH * 32 * 2; it += F.NGW) {
        const int dir = it & 1, g = (it >> 1) & 31, c = it >> 6;
#pragma unroll
        for (int rr = 0; rr < 2; ++rr) { const int t = F.lane + 64 * rr; const bf16* up = PROJ + (size_t)(c * 128 + t) * PROJW + 4 * BW + g * 16;
            float a[8], b[8]; unpack8(*(const u32x4*)up, a); unpack8(*(const u32x4*)(up + 8), b);
#pragma unroll
            for (int e = 0; e < 8; ++e) { U[t * 16 + e] = a[e]; U[t * 16 + 8 + e] = b[e]; } }
        LDS_WAIT();
        const int idx = ((l * 2 + dir) * 32 + g) * 64 + F.lane;
        const float2 ab = ((const float2*)((P.ws + F.z) + WS_S5AB))[idx];
        float2 bb[16];
#pragma unroll
        for (int k = 0; k < 16; ++k) bb[k] = ((const float2*)((P.ws + F.z) + WS_S5BB))[(size_t)idx * 16 + k];
        float xr = 0.f, xi = 0.f;
        for (int s = 0; s < 128; ++s) {
            const int t = dir ? 127 - s : s;
            float u[16];
#pragma unroll
            for (int q = 0; q < 4; ++q) { const f32x4 uu = *(const LAS f32x4*)(U + t * 16 + 4 * q); u[4 * q] = uu.x; u[4 * q + 1] = uu.y; u[4 * q + 2] = uu.z; u[4 * q + 3] = uu.w; }
            float bur = 0.f, bui = 0.f;
#pragma unroll
            for (int k = 0; k < 16; ++k) { bur += bb[k].x * u[k]; bui += bb[k].y * u[k]; }
            const float nr = ab.x * xr - ab.y * xi + bur, ni = ab.x * xi + ab.y * xr + bui; xr = nr; xi = ni;
        }
        E[((size_t)(dir * NCH + c) * 32 + g) * 64 + F.lane] = make_float2(xr, xi);
        LDS_WAIT();
    }
}
constexpr int S5_LDS = 13312, S5_BUS = 132, S5_XS = 136;
__device__ __forceinline__ void conv_phase(const Frame& F, const Args& P, int l, int rank, int nblk) {
    const bf16* PROJ = (const bf16*)((P.ws + F.z) + WS_PROJ); bf16* O2 = (bf16*)((P.ws + F.z) + WS_O) + (size_t)2 * NR * BW;
    const float* cw = P.in[I_CONVW + F.z] + (size_t)l * 3 * BW;
    for (int idx = rank * NTHR + F.tid; idx < NR * 64; idx += nblk * NTHR) {
        const int row = idx >> 6, ch0 = (idx & 63) * 8;
        const int lo = row < CTXL ? 0 : CTXL, hi = row < CTXL ? CTXL : NR;
        float y[8];
#pragma unroll
        for (int e = 0; e < 8; ++e) y[e] = 0.f;
#pragma unroll
        for (int w = 0; w < 3; ++w) { const int r = row + w - 1;
            if (r >= lo && r < hi) { const bf16* pr = PROJ + (size_t)r * PROJW + ch0; float cx[8], cc[8]; unpack8(*(const u32x4*)(pr + 5 * BW), cx); unpack8(*(const u32x4*)(pr + 7 * BW), cc);
#pragma unroll
                for (int e = 0; e < 8; ++e) y[e] += cw[w * BW + ch0 + e] * (cc[e] * cx[e]); } }
        float cb[8]; unpack8(*(const u32x4*)(PROJ + (size_t)row * PROJW + 6 * BW + ch0), cb);
#pragma unroll
        for (int e = 0; e < 8; ++e) y[e] *= cb[e];
        *(u32x4*)(O2 + (size_t)row * BW + ch0) = pack8(y);
    }
}
__device__ __forceinline__ void gmlp_phase(const Frame& F, const Args& P, int l, const int it) {
    LAS bf16* VT = (LAS bf16*)F.lds; LAS bf16* WSL = VT + 128 * LDT; LAS float* mean = (LAS float*)(F.lds + 2 * 128 * LDT * 2); LAS float* rstd = mean + 128;
    const bf16* PROJ = (const bf16*)((P.ws + F.z) + WS_PROJ); bf16* O3 = (bf16*)((P.ws + F.z) + WS_O) + (size_t)3 * NR * BW;
    const float* lng = P.in[I_LNG + F.z] + (size_t)l * BW; const float* lnb = P.in[I_LNB + F.z] + (size_t)l * BW;
    const int fr = F.lane & 15, fq = F.lane >> 4;
    {
        const int c = it >> 2, g = it & 3, row0 = c * 128;
        __syncthreads();
        if (F.tid < 128) {
            const f32x4* gs = (const f32x4*)((const float*)((P.ws + F.z) + WS_GST) + (size_t)(row0 + F.tid) * 16);
            const f32x4 p0 = gs[0], p1 = gs[1], p2 = gs[2], p3 = gs[3];
            const float s = ((p0[0] + p0[2]) + (p1[0] + p1[2])) + ((p2[0] + p2[2]) + (p3[0] + p3[2])), s2 = ((p0[1] + p0[3]) + (p1[1] + p1[3])) + ((p2[1] + p2[3]) + (p3[1] + p3[3]));
            const float mu = s * (1.f / BW), var = fmaxf(s2 * (1.f / BW) - mu * mu, 0.f);
            mean[F.tid] = mu; rstd[F.tid] = 1.f / sqrtf(var + EPS);
        }
        __syncthreads();
#pragma unroll
        for (int rep = 0; rep < 2; ++rep) { const int w = F.tid + NTHR * rep, tp = w >> 4, ch0 = (w & 15) * 8, t = 2 * tp;
            const bf16* gp = PROJ + (size_t)(row0 + t) * PROJW + 9 * BW + g * 128 + ch0;
            float a0[8], a1[8]; unpack8(*(const u32x4*)gp, a0); unpack8(*(const u32x4*)(gp + PROJW), a1);
            const float mu0 = mean[t], rs0 = rstd[t], mu1 = mean[t + 1], rs1 = rstd[t + 1];
#pragma unroll
            for (int e = 0; e < 8; ++e) { const float lg_ = lng[g * 128 + ch0 + e], lb_ = lnb[g * 128 + ch0 + e];
                *(LAS unsigned*)(VT + (ch0 + e) * LDT + t) = pk2((gelu_tanh(a0[e]) - mu0) * rs0 * lg_ + lb_, (gelu_tanh(a1[e]) - mu1) * rs1 * lg_ + lb_); } }
#pragma unroll
        for (int rep = 0; rep < 4; ++rep) { const int w = F.tid + NTHR * rep, t = w >> 4, ch0 = (w & 15) * 8;
            const bf16* wsg = (const bf16*)((P.ws + F.z) + WS_W + (size_t)l * LW_STRIDE + LW_WS) + (size_t)g * 16384;
            *(LAS u32x4*)(WSL + t * LDT + ch0) = *(const u32x4*)(wsg + t * 128 + ch0); }
        __syncthreads();
        f32x4 acc[8];
#pragma unroll
        for (int n = 0; n < 8; ++n) acc[n] = (f32x4){0.f, 0.f, 0.f, 0.f};
        mma_nt<8>(acc, WSL + 16 * F.wave * LDT, LDT, VT, LDT, 128, F.lane);
        const int q = 16 * F.wave + fr; const float bias = P.in[I_CBS + F.z][((size_t)l * 4 + g) * 128 + q];
#pragma unroll
        for (int n = 0; n < 8; ++n) { const int ch = g * 128 + 16 * n + 4 * fq;
            const u32x2 gw = *(const u32x2*)(PROJ + (size_t)(row0 + q) * PROJW + 8 * BW + ch);
            u32x2 o; o.x = pk2(gelu_tanh(bflo(gw.x)) * (acc[n].x + bias), gelu_tanh(bfhi(gw.x)) * (acc[n].y + bias));
            o.y = pk2(gelu_tanh(bflo(gw.y)) * (acc[n].z + bias), gelu_tanh(bfhi(gw.y)) * (acc[n].w + bias));
            *(u32x2*)(O3 + (size_t)(row0 + q) * BW + ch) = o; }
    }
}
__device__ __forceinline__ void merge_phase(const Frame& F, const Args& P) {
    const unsigned char* G = (const unsigned char*)((P.ws + F.z) + WS_G); const bf16* Y = (const bf16*)((P.ws + F.z) + WS_YP); bf16* M = (bf16*)((P.ws + F.z) + WS_MRG);
#pragma unroll 2
    for (int idx = F.bid * NTHR + F.tid; idx < NR * 256; idx += F.G * NTHR) {
        const int row = idx >> 8, c8 = (idx & 255) * 8;
        float m[8];
#pragma unroll
        for (int e = 0; e < 8; ++e) m[e] = 0.f;
#pragma unroll
        for (int k = 0; k < 4; ++k) { float y[8]; const u32x2 gq = *(const u32x2*)(G + (size_t)row * 8192 + k * DM + c8); unpack8(*(const u32x4*)(Y + (size_t)row * 8192 + k * DM + c8), y);
#pragma unroll
            for (int e = 0; e < 4; ++e) { m[e] += (float)((gq.x >> (8 * e)) & 0xffu) * y[e]; m[4 + e] += (float)((gq.y >> (8 * e)) & 0xffu) * y[4 + e]; } }
#pragma unroll
        for (int e = 0; e < 8; ++e) m[e] *= (1.f / 255.f);
        *(u32x4*)(M + (size_t)row * DM + c8) = pack8(m);
    }
}
__device__ __forceinline__ void scan_phase(const Frame& F, const Args& P, int l) {
    if (F.tid < 16) {
        const float2* E = (const float2*)((P.ws + F.z) + WS_S5E); float2* XS = (float2*)((P.ws + F.z) + WS_S5XS);
        for (int idx = F.bid * 16 + F.tid; idx < 2 * 32 * 64; idx += F.G * 16) {
            const int gp = idx & 2047, dir = idx >> 11;
            const float2 al = ((const float2*)((P.ws + F.z) + WS_S5AL))[(l * 2 + dir) * 2048 + gp];
            float xr = 0.f, xi = 0.f;
#pragma unroll 1
            for (int s0 = 0; s0 < NCH; s0 += 33) {
                float2 e[33]; int o[33];
#pragma unroll
                for (int j = 0; j < 33; ++j) { const int c = dir ? bwd_chunk(s0 + j) : s0 + j; o[j] = (dir * NCH + c) * 2048 + gp; e[j] = E[o[j]]; }
#pragma unroll
                for (int j = 0; j < 33; ++j) { XS[o[j]] = make_float2(xr, xi); const float nr = al.x * xr - al.y * xi + e[j].x, ni = al.x * xi + al.y * xr + e[j].y; xr = nr; xi = ni; }
            }
        }
    }
    const float* KVT = (const float*)((P.ws + F.z) + WS_KVT); bf16* ST = (bf16*)((P.ws + F.z) + WS_ST);
    for (int idx = F.bid * NTHR + F.tid; idx < 2 * 4 * 16384; idx += F.G * NTHR) {
        const int e = idx & 16383, h = (idx >> 14) & 3, dir = idx >> 16;
        const float gch = exp2f(128.f * dec_lg(F, P, l, dir, h));
        float s = 0.f;
#pragma unroll 1
        for (int s0 = 0; s0 < NCH; s0 += 33) {
            float kv[33]; int o[33];
#pragma unroll
            for (int j = 0; j < 33; ++j) { const int c = dir ? bwd_chunk(s0 + j) : s0 + j; o[j] = ((dir * NCH + c) * 4 + h) * 16384 + e; kv[j] = KVT[o[j]]; }
#pragma unroll
            for (int j = 0; j < 33; ++j) { ST[o[j]] = (bf16)f2bf(s); s = gch * s + kv[j]; }
        }
    }
}
__device__ __forceinline__ void ret_out_phase(const Frame& F, const Args& P, int l, const int it) {
    LAS bf16* QS = (LAS bf16*)F.lds; LAS bf16* R1 = QS + 128 * LDT; LAS bf16* R2 = R1 + 128 * LDT;
    const bf16* PROJ = (const bf16*)((P.ws + F.z) + WS_PROJ); const bf16* ST = (const bf16*)((P.ws + F.z) + WS_ST); bf16* O0 = (bf16*)((P.ws + F.z) + WS_O);
    const int fr = F.lane & 15, fq = F.lane >> 4;
    {
        const int c = it >> 2, h = it & 3, row0 = c * 128;
        const float lgf = dec_lg(F, P, l, 0, h), lgb = dec_lg(F, P, l, 1, h);
        __syncthreads();
        stage_qk<false>(F, P, QS, row0, 0, h, 0.08838834764831845f);
#pragma unroll
        for (int rep = 0; rep < 4; ++rep) { const int w = F.tid + NTHR * rep, r = w >> 4, pc = (w & 15) * 8;
            *(LAS u32x4*)(R1 + r * LDT + pc) = *(const u32x4*)(ST + (((size_t)0 * NCH + c) * 4 + h) * 16384 + r * 128 + pc);
            *(LAS u32x4*)(R2 + r * LDT + pc) = *(const u32x4*)(ST + (((size_t)1 * NCH + c) * 4 + h) * 16384 + r * 128 + pc); }
        __syncthreads();
        f32x4 o[8], a2[8];
#pragma unroll
        for (int n = 0; n < 8; ++n) { o[n] = (f32x4){0.f, 0.f, 0.f, 0.f}; a2[n] = (f32x4){0.f, 0.f, 0.f, 0.f}; }
        const LAS bf16* qw = QS + 16 * F.wave * LDT;
        mma_nt<8>(o, qw, LDT, R1, LDT, 128, F.lane);
        mma_nt<8>(a2, qw, LDT, R2, LDT, 128, F.lane);
        const int i = 16 * F.wave + fr;
        { const float cf = exp2f(lgf * (float)(i + 1)), cb = exp2f(lgb * (float)(128 - i));
#pragma unroll
          for (int n = 0; n < 8; ++n) o[n] = o[n] * cf + a2[n] * cb; }
        __syncthreads();
        stage_qk<false>(F, P, R1, row0, 1, h, 1.f);
        stage_vt<0>(F, P, R2, R2, row0, h, 0.f, 0.f);
        __syncthreads();
#pragma unroll
        for (int n = 0; n < 8; ++n) a2[n] = (f32x4){0.f, 0.f, 0.f, 0.f};
        mma_nt<8>(a2, qw, LDT, R1, LDT, 128, F.lane);
#pragma unroll
        for (int n = 0; n < 8; ++n) { float sv[4];
#pragma unroll
            for (int r = 0; r < 4; ++r) { const int j = 16 * n + 4 * fq + r, d = i - j; const float dec = d >= 0 ? exp2f(lgf * (float)d) : exp2f(lgb * (float)(-d)); sv[r] = a2[n][r] * dec; }
            u32x2 w; w.x = pk2(sv[0], sv[1]); w.y = pk2(sv[2], sv[3]);
            *(LAS u32x2*)(QS + (16 * F.wave + fr) * LDT + 16 * n + 4 * fq) = w; }
        LDS_WAIT();
        mma_nt<8>(o, qw, LDT, R2, LDT, 128, F.lane);
        float s = 0.f;
#pragma unroll
        for (int n = 0; n < 8; ++n) s += (o[n].x + o[n].y) + (o[n].z + o[n].w);
        s += __shfl_xor(s, 16); s += __shfl_xor(s, 32);
        const float mu = s * (1.f / 128.f); float s2 = 0.f;
#pragma unroll
        for (int n = 0; n < 8; ++n) { o[n] = o[n] - mu; s2 += (o[n].x * o[n].x + o[n].y * o[n].y) + (o[n].z * o[n].z + o[n].w * o[n].w); }
        s2 += __shfl_xor(s2, 16); s2 += __shfl_xor(s2, 32);
        const float rs = 1.f / sqrtf(s2 * (1.f / 128.f) + EPS);
#pragma unroll
        for (int n = 0; n < 8; ++n) { const int col = h * 128 + 16 * n + 4 * fq;
            const u32x2 gw = *(const u32x2*)(PROJ + (size_t)(row0 + i) * PROJW + 3 * BW + col);
            u32x2 w; w.x = pk2(o[n].x * rs * silu_fast(bflo(gw.x)), o[n].y * rs * silu_fast(bfhi(gw.x))); w.y = pk2(o[n].z * rs * silu_fast(bflo(gw.y)), o[n].w * rs * silu_fast(bfhi(gw.y)));
            *(u32x2*)(O0 + (size_t)(row0 + i) * BW + col) = w; }
    }
}

template <int DIR, bool P1>
__device__ __forceinline__ void s5_p2_dir(const Frame& F, const Args& P, int l, int g, int c, LAS float* BUb, LAS bf16* XBh, const bf16x8 (&ua)[8], const bf16x8 (&cfr)[4], f32x4 (&yacc)[8]) {
    const int lane = F.lane, fr = lane & 15, fq = lane >> 4;
    const bf16* bw = (const bf16*)((P.ws + F.z) + WS_S5BW) + ((size_t)((l * 2 + DIR) * 32 + g) * 128 + fr) * 32 + 8 * fq;
    bf16x8 bfr[8];
#pragma unroll
    for (int nt = 0; nt < 8; ++nt) bfr[nt] = *(const bf16x8*)(bw + nt * 16 * 32);
    const float2 ab = ((const float2*)((P.ws + F.z) + WS_S5AB))[((l * 2 + DIR) * 32 + g) * 64 + lane];
    f32x2 x = (f32x2){0.f, 0.f};
    if (!P1) { const float2 x0 = ((const float2*)((P.ws + F.z) + WS_S5XS))[((size_t)DIR * NCH + c) * 2048 + g * 64 + lane]; x = (f32x2){x0.x, x0.y}; }
    const f32x2 a2 = (f32x2){ab.x, ab.x}, n2 = (f32x2){-ab.y, ab.y};
#pragma unroll
    for (int bs = 0; bs < 8; ++bs) {
        const int b = DIR ? 7 - bs : bs;
        f32x4 d[8];
#pragma unroll
        for (int nt = 0; nt < 8; ++nt) d[nt] = __builtin_amdgcn_mfma_f32_16x16x32_bf16(ua[b], bfr[nt], (f32x4){0.f, 0.f, 0.f, 0.f}, 0, 0, 0);
        __builtin_amdgcn_sched_barrier(0); asm volatile("s_nop 15" ::: "memory"); __builtin_amdgcn_sched_barrier(0);
#pragma unroll
        for (int nt = 0; nt < 8; ++nt)
#pragma unroll
            for (int r = 0; r < 4; ++r) BUb[(4 * fq + r) * S5_BUS + 16 * nt + fr] = d[nt][r];
        LDS_WAIT();
        f32x2 bu[16];
#pragma unroll
        for (int s = 0; s < 16; ++s) bu[s] = *(const LAS f32x2*)(BUb + (DIR ? 15 - s : s) * S5_BUS + 2 * lane);
        LDS_WAIT();
#pragma unroll
        for (int s = 0; s < 16; ++s) { const int tl = DIR ? 15 - s : s;
            const f32x2 t = a2 * x + bu[s]; x = n2 * __builtin_shufflevector(x, x, 1, 0) + t;
            if (!P1) *(LAS unsigned*)(XBh + tl * S5_XS + 2 * lane) = pk2(x[0], x[1]); }
        LDS_WAIT();
        if (!P1) {
#pragma unroll
        for (int ks = 0; ks < 4; ++ks) { const bf16x8 xa = *(const LAS bf16x8*)(XBh + fr * S5_XS + 32 * ks + 8 * fq);
            yacc[b] = __builtin_amdgcn_mfma_f32_16x16x32_bf16(cfr[ks], xa, yacc[b], 0, 0, 0); }
        }
        LDS_WAIT();
    }
    if (P1) ((float2*)((P.ws + F.z) + WS_S5E))[((size_t)(DIR * NCH + c) * 32 + g) * 64 + lane] = make_float2(x[0], x[1]);
}
__device__ __forceinline__ void s5_pass1_fast(const Frame& F, const Args& P, int l, const int jb) {
    LAS float* BUb = (LAS float*)(F.lds + F.wave * S5_LDS); LAS bf16* XBh = (LAS bf16*)(BUb + 16 * S5_BUS);
    const bf16* PROJ = (const bf16*)((P.ws + F.z) + WS_PROJ);
    const int lane = F.lane, fr = lane & 15, fq = lane >> 4;
    __syncthreads();
    { const int it = jb * 8 + F.wave;
        const int g = it & 31, c = it >> 5;
        const bf16* ub = PROJ + (size_t)(c * 128 + fr) * PROJW + 4 * BW + g * 16 + 8 * (fq & 1);
        bf16x8 ua[8];
#pragma unroll
        for (int m = 0; m < 8; ++m) ua[m] = *(const bf16x8*)(ub + (size_t)m * 16 * PROJW);
        bf16x8 cfr[4];
#pragma unroll
        for (int ks = 0; ks < 4; ++ks) cfr[ks] = ua[ks];
        f32x4 yacc[8];
#pragma unroll
        for (int b = 0; b < 8; ++b) yacc[b] = (f32x4){0.f, 0.f, 0.f, 0.f};
        s5_p2_dir<0, true>(F, P, l, g, c, BUb, XBh, ua, cfr, yacc);
        s5_p2_dir<1, true>(F, P, l, g, c, BUb, XBh, ua, cfr, yacc);
    }
}
__device__ __forceinline__ void s5_pass2(const Frame& F, const Args& P, int l, const int jb) {
    LAS float* BUb = (LAS float*)(F.lds + F.wave * S5_LDS); LAS bf16* XBh = (LAS bf16*)(BUb + 16 * S5_BUS);
    const bf16* PROJ = (const bf16*)((P.ws + F.z) + WS_PROJ); bf16* S5Y = (bf16*)((P.ws + F.z) + WS_S5Y);
    const int lane = F.lane, fr = lane & 15, fq = lane >> 4;
    __syncthreads();
    { const int it = jb * 8 + F.wave;
        const int g = it & 31, c = it >> 5;
        const bf16* ub = PROJ + (size_t)(c * 128 + fr) * PROJW + 4 * BW + g * 16 + 8 * (fq & 1);
        bf16x8 ua[8];
#pragma unroll
        for (int m = 0; m < 8; ++m) ua[m] = *(const bf16x8*)(ub + (size_t)m * 16 * PROJW);
        const bf16* cw = (const bf16*)((P.ws + F.z) + WS_S5CW) + ((size_t)(l * 32 + g) * 16 + fr) * 128 + 8 * fq;
        bf16x8 cfr[4];
#pragma unroll
        for (int ks = 0; ks < 4; ++ks) cfr[ks] = *(const bf16x8*)(cw + 32 * ks);
        f32x4 yacc[8];
#pragma unroll
        for (int b = 0; b < 8; ++b) yacc[b] = (f32x4){0.f, 0.f, 0.f, 0.f};
        s5_p2_dir<0, false>(F, P, l, g, c, BUb, XBh, ua, cfr, yacc);
        s5_p2_dir<1, false>(F, P, l, g, c, BUb, XBh, ua, cfr, yacc);
        const f32x4 dd = *(const f32x4*)(P.in[I_S5D + F.z] + (size_t)l * BW + g * 16 + 4 * fq);
#pragma unroll
        for (int b = 0; b < 8; ++b) { const int t = 16 * b + fr;
            const u32x2 uw = *(const u32x2*)(PROJ + (size_t)(c * 128 + t) * PROJW + 4 * BW + g * 16 + 4 * fq);
            u32x2 w; w.x = pk2(gelu_tanh(yacc[b].x + dd.x * bflo(uw.x)), gelu_tanh(yacc[b].y + dd.y * bfhi(uw.x))); w.y = pk2(gelu_tanh(yacc[b].z + dd.z * bflo(uw.y)), gelu_tanh(yacc[b].w + dd.w * bfhi(uw.y)));
            *(u32x2*)(S5Y + (size_t)(c * 128 + t) * BW + g * 16 + 4 * fq) = w; }
    }
}

__device__ __forceinline__ void m1_phase(const Frame& F, const Args& P, int l) {
    constexpr int NB = NCH * 4;
    for (int k = 0; k * F.G < 3 * NB; ++k) {
        const int idx = k * F.G + (F.bid + 64 * k) % F.G;
        if (idx < NB) { const Frame Fi = relaunder(F); gmlp_phase(Fi, P, l, idx); }
        else if (idx < 2 * NB) { const Frame Fi = relaunder(F); ret_kv_phase(Fi, P, l, idx - NB); }
        else if (idx < 3 * NB) { const Frame Fi = relaunder(F); s5_pass1_fast(Fi, P, l, idx - 2 * NB); }
    }
    { const Frame Fi = relaunder(F); conv_phase(Fi, P, l, Fi.bid, Fi.G); }
}
__device__ __forceinline__ void m1_phase_b(const Frame& F, const Args& P, int l) {
    constexpr int NB = NCH * 4; const int goff = (l + 1 < DEPTH) ? 0 : 8;
    for (int k = 0; k < 3; ++k) {
        const int idx = k * 256 + (F.bid + 64 * k) % 256;
        if (idx < NB) { for (int rr = 0; rr < PREPS(52); ++rr) { const Frame Fi = relaunder(F); ret_kv_phase(Fi, P, l, idx); } }
        else if (idx < NB + 240) { for (int rr = 0; rr < PREPS(51); ++rr) { const Frame Fi = relaunder(F); gmlp_phase(Fi, P, l, idx - NB + goff); } }
        else { for (int rr = 0; rr < PREPS(53); ++rr) { const Frame Fi = relaunder(F); s5_pass1_fast(Fi, P, l, idx - 240 - NB); } }
    }
}
__device__ __forceinline__ void m3_phase_b(const Frame& F, const Args& P, int l) {
    const bool last = !(l + 1 < DEPTH); const int skip = last ? 8 : 0, NB = NCH * 4 - skip, tot = 2 * NB + (last ? 0 : 24);
    for (int k = 0; k * 256 < tot; ++k) {
        const int idx = k * 256 + (F.bid + 64 * k) % 256;
        if (idx < NB) { for (int rr = 0; rr < PREPS(54); ++rr) { const Frame Fi = relaunder(F); ret_out_phase(Fi, P, l, idx + skip); } }
        else if (idx < 2 * NB) { for (int rr = 0; rr < PREPS(55); ++rr) { const Frame Fi = relaunder(F); s5_pass2(Fi, P, l, idx - NB + skip); } }
        else if (idx < tot) { const Frame Fi = relaunder(F); gmlp_phase(Fi, P, l, 240 + idx - 2 * NB); }
    }
    if (last) { __syncthreads(); const Frame Fc = relaunder(F); convert_tiles(Fc, P, l, CT_L3B, CT_W2, Fc.gw, Fc.NGW); }
    if (!last) {
        const int b = F.bid;
        if (b < 128 || b >= 168) { const Frame Fi = relaunder(F); conv_phase(Fi, P, l, b < 128 ? b : b - 40, 216);
            __syncthreads(); const Frame Fc = relaunder(F); convert_tiles(Fc, P, l, CT_C, CT_END, (Fc.bid < 128 ? Fc.bid : Fc.bid - 40) * NWAVES + Fc.wave, 216 * NWAVES); }
    }
}
__device__ __forceinline__ void glu_extra_b(const Frame& F, const Args& P, int l) {
    if (F.bid >= 66 && F.bid < 82) { const Frame Fi = relaunder(F); gmlp_phase(Fi, P, l, 248 + Fi.bid - 66); }
    else if (F.bid >= 82) { const Frame Fi = relaunder(F); conv_phase(Fi, P, l, Fi.bid - 82, 174); }
}
__device__ __forceinline__ void m3_phase(const Frame& F, const Args& P, int l) {
    const int skip = (l + 1 < DEPTH) ? 0 : 8, NB = NCH * 4 - skip;
    for (int k = 0; k * F.G < 2 * NB; ++k) {
        const int idx = k * F.G + (F.bid + 64 * k) % F.G;
        if (idx < NB) { const Frame Fi = relaunder(F); ret_out_phase(Fi, P, l, idx + skip); }
        else if (idx < 2 * NB) { const Frame Fi = relaunder(F); s5_pass2(Fi, P, l, idx - NB + skip); }
    }
}
constexpr int NSTEP = 12, NPHASE = 2 + DEPTH * NSTEP + 1;
#ifndef PROBE_KIND
#define PROBE_KIND -1
#endif
#ifdef EXP_NOSPLIT
#define NPART(x) 0
#else
#define NPART(x) (x)
#endif
#define REPS(k) ((PROBE_KIND == (k)) ? 2 : 1)
__global__ void __launch_bounds__(NTHR, 2) mega(Args P) {
    extern __shared__ __attribute__((aligned(16))) unsigned char lds_raw[];
    Frame F0;
    F0.lds = (LAS unsigned char*)lds_raw;
    F0.tid = 0; F0.lane = 0; F0.wave = __builtin_amdgcn_readfirstlane((int)threadIdx.x >> 6);
    F0.G = gridDim.x; F0.bid = blockIdx.x; F0.gw = F0.bid * NWAVES + F0.wave; F0.NGW = F0.G * NWAVES; F0.z = 0;
    volatile LAS unsigned* MISC = (volatile LAS unsigned*)(F0.lds + MISC_OFF);
    if (threadIdx.x < 16) MISC[threadIdx.x] = 0u;
    __syncthreads();
    XcdBarrier bar = xcd_barrier_post((unsigned*)(P.ws + WS_CTL) + 4096, MISC + 8);
    const int lo = P.ph_lo, hi = P.ph_hi;
#define IN(k) (lo <= (k) && (k) < hi)
#define SEAM(k) do { if ((k) + 1 < hi) { for (int rb_ = 0; rb_ < REPS(40); ++rb_) { XcdBarrier b2 = bar; asm volatile("" : "+s"(b2.bar)); xcd_barrier(b2); } } } while (0)
    if (IN(0)) { for (int r = 0; r < REPS(0); ++r) { const Frame F = relaunder(F0); prologue_a(F, P); SEAM(0); } }
    if (IN(1)) { const Frame F = relaunder(F0); prologue_b(F, P); SEAM(1); }
    for (int l = 0; l < DEPTH; ++l) {
        const int pb = 2 + l * NSTEP;
        if (IN(pb + 0)) { for (int r = 0; r < REPS(1); ++r) { const Frame F = relaunder(F0); norm_phase(F, P, l, P.in[I_N1G + F.z] + (size_t)l * DM, 0, 1, NPART(l > 0 ? 11 : 0), (const float*)(P.ws + F.z + WS_MOD) + (size_t)(l > 0 ? l - 1 : 0) * 2 * 12288 + 12288 + 5 * DM, l == 0 ? (const void*)(P.in[I_X + F.z] - (size_t)CTXL * DM) : (const void*)(P.ws + F.z + WS_X), l == 0 ? 1 : 0, l == 0 ? (const void*)P.in[I_CTX + F.z] : (const void*)(P.ws + F.z + WS_X), l == 0 ? 1 : 0); SEAM(pb + 0); } }
        if (IN(pb + 1)) for (int r = 0; r < REPS(6); ++r) {
            const Frame F = relaunder(F0); unsigned char* ws = P.ws + F.z; unsigned char* lw = ws + WS_W + (size_t)l * LW_STRIDE;
            pg8::Gemm g{(const bf16*)(ws + WS_H), (const bf16*)(lw + LW_WIN), NR, PROJW + 8192, DM}; pg8::StaticOrder S; S.init(NR, PROJW + 8192, DM, F.G, F.bid);
#ifdef EXP_G1SPLIT
            { pg8::Gemm g1{(const bf16*)(ws + WS_H), (const bf16*)(lw + LW_WIN), NR, PROJW, DM}; pg8::StaticOrder S1; S1.init(NR, PROJW, DM, F.G, F.bid);
              EpiG1 E1{(bf16*)(ws + WS_PROJ), (bf16*)(ws + WS_G), P.in[I_BMERGE + F.z] + (size_t)l * 8192, 0, (float*)(ws + WS_GST)};
              pg8::gemm_phase<EpiG1, pg8::StaticOrder, true, true>(F.lds, g1, S1, E1, F.tid); }
            __syncthreads();
            { pg8::Gemm g2{(const bf16*)(ws + WS_H), (const bf16*)(lw + LW_WM), NR, 8192, DM}; pg8::StaticOrder S2; S2.init(NR, 8192, DM, F.G, F.bid);
              EpiG1 E2{(bf16*)(ws + WS_PROJ), (bf16*)(ws + WS_G), P.in[I_BMERGE + F.z] + (size_t)l * 8192, 20, (float*)(ws + WS_GST)};
              pg8::gemm_phase<EpiG1, pg8::StaticOrder, true, true>(F.lds, g2, S2, E2, F.tid); }
#else
            EpiG1 E{(bf16*)(ws + WS_PROJ), (bf16*)(ws + WS_G), P.in[I_BMERGE + F.z] + (size_t)l * 8192, 0, (float*)(ws + WS_GST)};
            pg8::gemm_phase<EpiG1, pg8::StaticOrder, true, true>(F.lds, g, S, E, F.tid);
#endif
            SHADOW(180, 0, l < DEPTH - 1 ? CT_R0 : CT_L3A);
            SEAM(pb + 1); }
        if (IN(pb + 2)) for (int r = 0; r < REPS(2); ++r) { const Frame F = relaunder(F0); if (F.G == 256) m1_phase_b(F, P, l); else m1_phase(F, P, l); SEAM(pb + 2); }
        if (IN(pb + 3)) for (int r = 0; r < REPS(3); ++r) { const Frame F = relaunder(F0); scan_phase(F, P, l); SEAM(pb + 3); }
        if (IN(pb + 4)) for (int r = 0; r < REPS(4); ++r) { const Frame F = relaunder(F0); if (F.G == 256) m3_phase_b(F, P, l); else m3_phase(F, P, l); SEAM(pb + 4); }
        if (IN(pb + 5)) for (int r = 0; r < REPS(9); ++r) {
            const Frame F = relaunder(F0); unsigned char* ws = P.ws + F.z; unsigned char* lw = ws + WS_W + (size_t)l * LW_STRIDE;
            pg8::Gemm g{(const bf16*)(ws + WS_S5Y), (const bf16*)(lw + LW_WGLU), NR, BW, BW}; pg8::StaticOrder S; S.init(NR, BW, BW, F.G, F.bid);
            EpiGlu E{(const bf16*)(ws + WS_S5Y), (bf16*)(ws + WS_O) + (size_t)1 * NR * BW};
            pg8::gemm_phase<EpiGlu, pg8::StaticOrder, true, true>(F.lds, g, S, E, F.tid);
            if (l < DEPTH - 1) SHADOW(66, CT_R0, CT_R1);
            else if (F.G == 256) { const Frame Fg = relaunder(F0); glu_extra_b(Fg, P, l); SHADOW(82, CT_L3A, CT_L3B); }
            SEAM(pb + 5); }
        if (IN(pb + 6)) for (int r = 0; r < REPS(7); ++r) {
            const Frame F = relaunder(F0); unsigned char* ws = P.ws + F.z; unsigned char* lw = ws + WS_W + (size_t)l * LW_STRIDE;
            pg8::Gemm g{(const bf16*)(ws + WS_O), (const bf16*)(lw + LW_WB), 4 * NR, 4 * DM, BW}; YOrder S; S.init(F.G, F.bid, l + 1 < DEPTH ? 33 : 32);
            EpiY E{(bf16*)(ws + WS_YP)};
            pg8::gemm_phase<EpiY, YOrder, true, true>(F.lds, g, S, E, F.tid);
            if (l < DEPTH - 1) SHADOW(32, CT_R1, CT_R2);
            SEAM(pb + 6); }
        if (IN(pb + 7)) for (int r = 0; r < REPS(8); ++r) { const Frame F = relaunder(F0); merge_phase(F, P); SEAM(pb + 7); }
        if (IN(pb + 8)) for (int r = 0; r < REPS(10); ++r) {
            const Frame F = relaunder(F0); unsigned char* ws = P.ws + F.z; unsigned char* lw = ws + WS_W + (size_t)l * LW_STRIDE;
            const float* MOD = (const float*)(ws + WS_MOD) + (size_t)l * 2 * 12288;
            pg8::Gemm g{(const bf16*)(ws + WS_MRG), (const bf16*)(lw + LW_WO), NR, DM, DM}; SplitOrder S{F.G, F.bid, DM / 64, 4, 8, l < DEPTH - 1 ? 1 : 0};
            EpiRes E{(bf16*)(ws + WS_X), MOD + 2 * DM, (float*)(ws + WS_PART), (REPS(10) == 2 && r == 0) ? 1 : 0, l == 0 ? (const void*)(P.in[I_X + F.z] - (size_t)CTXL * DM) : (const void*)(ws + WS_X), l == 0 ? 1 : 0};
            pg8::gemm_phase<EpiRes, SplitOrder, true, true>(F.lds, g, S, E, F.tid);
            if (l < DEPTH - 1) SHADOW(32, CT_R2, CT_R3);
            SEAM(pb + 8); }
        if (IN(pb + 9)) { for (int r = 0; r < REPS(1); ++r) { const Frame F = relaunder(F0); norm_phase(F, P, l, P.in[I_N2G + F.z] + (size_t)l * DM, 3, 4, NPART(l < DEPTH - 1 ? 4 : 0), (const float*)(P.ws + F.z + WS_MOD) + (size_t)l * 2 * 12288 + 12288 + 2 * DM, (const void*)(P.ws + F.z + WS_X), 0, l == 0 ? (const void*)P.in[I_CTX + F.z] : (const void*)(P.ws + F.z + WS_X), l == 0 ? 1 : 0); SEAM(pb + 9); } }
        if (IN(pb + 10)) for (int r = 0; r < REPS(5); ++r) {
            const Frame F = relaunder(F0); unsigned char* ws = P.ws + F.z; unsigned char* lw = ws + WS_W + (size_t)l * LW_STRIDE;
            pg8::Gemm g{(const bf16*)(ws + WS_H), (const bf16*)(lw + LW_W13), NR, 2 * DFF, DM}; pg8::StaticOrder S; S.init(NR, 2 * DFF, DM, F.G, F.bid);
            EpiFfn1 E{(bf16*)(ws + WS_T)};
            pg8::gemm_phase<EpiFfn1, pg8::StaticOrder, true, true>(F.lds, g, S, E, F.tid);
            if (l < DEPTH - 1) SHADOW(172, CT_R3, CT_R4); else SHADOW(172, CT_W2, CT_WIN);
            SEAM(pb + 10); }
        if (IN(pb + 11)) for (int r = 0; r < REPS(11); ++r) {
            const Frame F = relaunder(F0); unsigned char* ws = P.ws + F.z; unsigned char* lw = ws + WS_W + (size_t)l * LW_STRIDE;
            const float* MOD = (const float*)(ws + WS_MOD) + (size_t)l * 2 * 12288;
            pg8::Gemm g{(const bf16*)(ws + WS_T), (const bf16*)(lw + LW_W2), NR, DM, DFF}; SplitOrder S{F.G, F.bid, DFF / 64, 11, 8, l < DEPTH - 1 ? 1 : 0};
            EpiRes E{(bf16*)(ws + WS_X), MOD + 5 * DM, (float*)(ws + WS_PART), (REPS(11) == 2 && r == 0) ? 1 : 0, (const void*)(ws + WS_X), 0};
            pg8::gemm_phase<EpiRes, SplitOrder, true, true>(F.lds, g, S, E, F.tid);
            if (l < DEPTH - 1) SHADOW(88, CT_R4, CT_C);
            SEAM(pb + 11); }
    }
    if (IN(NPHASE - 1)) { const Frame F = relaunder(F0); final_norm(F, P); }
#undef IN
#undef SEAM
}

#ifndef N_LAUNCH_MODE
#define N_LAUNCH_MODE 1
#endif
extern "C" void kernel_launch(void* const* d_in, const int* in_sizes, int n_in, void* d_out, int out_size, void* d_ws, size_t ws_size, hipStream_t stream) {
    static int grid = 0;
    if (grid == 0) {
        if (n_in != N_IN || out_size != SEQ * DM || ws_size < WS_END) { fprintf(stderr, "kernel_launch: unexpected shapes n_in %d out %d ws %zu (need %zu)\n", n_in, out_size, ws_size, (size_t)WS_END); grid = -1; return; }
        int dev = 0, cus = 0;
        if (hipGetDevice(&dev) != hipSuccess || hipDeviceGetAttribute(&cus, hipDeviceAttributeMultiprocessorCount, dev) != hipSuccess) { grid = -1; return; }
        if (hipFuncSetAttribute((const void*)mega, hipFuncAttributeMaxDynamicSharedMemorySize, LDS_BYTES) != hipSuccess) { fprintf(stderr, "kernel_launch: hipFuncSetAttribute failed\n"); grid = -1; return; }
        int per_cu = 0;
        if (hipOccupancyMaxActiveBlocksPerMultiprocessor(&per_cu, (const void*)mega, NTHR, LDS_BYTES) != hipSuccess || per_cu < 1) fprintf(stderr, "kernel_launch: occupancy query says %d\n", per_cu);
        (void)hipGetLastError();
        grid = cus;
    }
    if (grid < 0) return;
    (void)hipMemsetAsync((char*)d_ws + WS_CTL, 0, CTL_ZERO, stream);
    Args a{};
    for (int i = 0; i < N_IN; ++i) a.in[i] = (const float*)d_in[i];
    a.out = (float*)d_out; a.ws = (unsigned char*)d_ws;
#if N_LAUNCH_MODE == 1
    a.ph_lo = 0; a.ph_hi = NPHASE;
    hipLaunchKernelGGL(mega, dim3(grid), dim3(NTHR), LDS_BYTES, stream, a);
#else
    for (int s = 0; s < NPHASE; ++s) { a.ph_lo = s; a.ph_hi = s + 1; hipLaunchKernelGGL(mega, dim3(grid), dim3(NTHR), LDS_BYTES, stream, a); }
#endif
}
```

```cpp
#include <hip/hip_runtime.h>
#include <cstdio>
#include <cstdint>
#define LAS __attribute__((address_space(3)))
namespace pg8 {
#define PG8_LAS __attribute__((address_space(3)))
typedef unsigned short bf16_t;
typedef short bf16x8 __attribute__((ext_vector_type(8)));
typedef float f32x4 __attribute__((ext_vector_type(4)));
typedef unsigned u32x4 __attribute__((ext_vector_type(4)));
typedef int i32x4 __attribute__((ext_vector_type(4))); typedef int i32x8 __attribute__((ext_vector_type(8)));
constexpr int BM = 256, BK = 64, HALF = 128, HTB = HALF * BK * 2  , STAGE_BYTES = 8 * HTB, NXCD = 8, WGM = 3;

__host__ __device__ __forceinline__ int lds_byte(int r, int c) { const int st = (r >> 4) * 2 + (c >> 5), rr = r & 15, cc = c & 31, ob = rr * 64 + cc * 2; return st * 1024 + (ob ^ (((ob >> 9) & 1) << 5)); }
__host__ __device__ __forceinline__ void stage_rc(int b, int& R, int& C) { const int st = b / 1024, sb = b % 1024, swz = sb ^ (((sb >> 9) & 1) << 5); R = (st >> 1) * 16 + swz / 64; C = (st & 1) * 32 + (swz % 64) / 2; }
__host__ __device__ __forceinline__ int perm32(int rho) { const int n = rho >> 4, i = rho & 15; return 8 * (i >> 2) + 4 * n + (i & 3); }

struct Unit { int pm, pn, k0, nt; };
struct Gemm { const bf16_t* A; const bf16_t* Bt; int M, N, K; };

struct StaticOrder {
    int nM, nN, nwg, G, c, nt;
    __host__ __device__ void init(int M, int N, int K, int G_, int c_) { nM = M / BM; nN = N / BM; nwg = nM * nN; G = G_; c = c_; nt = K / BK; }
    __host__ __device__ bool next(int i, Unit& u) const {
        const long L = (long)i * G + c; if (L >= nwg) return false;
        int wgid = (int)L; { const int q = nwg / NXCD, r = nwg % NXCD, xcd = wgid % NXCD, off = wgid / NXCD; wgid = (xcd < r ? xcd * (q + 1) : r * (q + 1) + (xcd - r) * q) + off; }
        const int nig = WGM * nN, gid = wgid / nig, fm = gid * WGM, gsz = (nM - fm) < WGM ? (nM - fm) : WGM;
        u.pm = fm + ((wgid % nig) % gsz); u.pn = (wgid % nig) / gsz; u.k0 = 0; u.nt = nt; return true;
    }
    __device__ __forceinline__ void a_ready(const Unit&) const {}
    __device__ __forceinline__ void done(const Unit&) const {}
};

typedef float f32x2_cv __attribute__((ext_vector_type(2))); typedef __bf16 bf16x2_cv __attribute__((ext_vector_type(2)));
__device__ __forceinline__ unsigned cvt_pk_bf16(float lo, float hi) { f32x2_cv v = {lo, hi}; bf16x2_cv b = __builtin_convertvector(v, bf16x2_cv); return __builtin_bit_cast(unsigned, b); }
typedef float f32x2 __attribute__((ext_vector_type(2)));
template <class Epi, class Sched, bool ALIGN_EPI = false, bool SP2 = false, bool F8 = false>
__device__ __forceinline__ void gemm_phase(PG8_LAS unsigned char* lds, const Gemm g, const Sched& S, const Epi& E, const int tid_in) {
    int tid_l = tid_in; asm volatile("" : "+v"(tid_l));
    const int tid = tid_l, wid = __builtin_amdgcn_readfirstlane(tid >> 6), lane = tid & 63, wr = wid >> 2, wc = wid & 3, fr = lane & 15, fq = lane >> 4;
    const int K = g.K;
    unsigned voffA[2], voffB[2];
#pragma unroll
    for (int i = 0; i < 2; ++i) { int R, C; stage_rc(tid * 16 + i * 8192, R, C); const int Rb = Epi::PERM ? ((R & ~31) + perm32(R & 31)) : R;
        voffA[i] = (unsigned)(R * K + C) * 2u; voffB[i] = (unsigned)(Rb * K + C) * 2u; }
    const size_t kstep = (size_t)(BK * 2);
    const size_t hstep = (size_t)HALF * K * 2;
    const size_t tstep = 2 * hstep;
    const unsigned ldsw = (unsigned)wid * 1024u;
    const int aoff = lds_byte(wr * 64 + fr, fq * 8), boff = lds_byte(wc * 32 + fr, fq * 8);
#define PG8_SA(b, h) (((b) * 2 + (h)) * HTB)
#define PG8_SB(b, h) ((4 + (b) * 2 + (h)) * HTB)
#define PG8_STAGE(bufoff, gbase, voff) do { _Pragma("unroll") for (int _i = 0; _i < 2; ++_i) \
        __builtin_amdgcn_global_load_lds((const unsigned*)((const char*)(gbase) + (voff)[_i]), (PG8_LAS unsigned*)(lds + (bufoff) + ldsw + _i * 8192), 16, 0, 0); } while (0)
#define PG8_LDA(dst, b, h) do { _Pragma("unroll") for (int m = 0; m < 4; ++m) _Pragma("unroll") for (int k = 0; k < 2; ++k) dst[m][k] = *(const PG8_LAS bf16x8*)(lds + PG8_SA(b, h) + aoff + m * 2048 + k * 1024); } while (0)
#define PG8_LDB(dst, b, h) do { _Pragma("unroll") for (int n = 0; n < 2; ++n) _Pragma("unroll") for (int k = 0; k < 2; ++k) dst[n][k] = *(const PG8_LAS bf16x8*)(lds + PG8_SB(b, h) + boff + n * 2048 + k * 1024); } while (0)
#define PG8_MMA(ai, bj, At, Bt) do { __builtin_amdgcn_s_setprio(1); _Pragma("unroll") for (int m = 0; m < 4; ++m) _Pragma("unroll") for (int n = 0; n < 2; ++n) _Pragma("unroll") for (int k = 0; k < 2; ++k) \
        acc[ai][bj][m][n] = __builtin_amdgcn_mfma_f32_16x16x32_bf16(Bt[n][k], At[m][k], acc[ai][bj][m][n], 0, 0, 0); __builtin_amdgcn_s_setprio(0); } while (0)
#define PG8_MMA8(ai, bj, At, Bt) do { __builtin_amdgcn_s_setprio(1); _Pragma("unroll") for (int m = 0; m < 4; ++m) _Pragma("unroll") for (int n = 0; n < 2; ++n) { \
        const i32x4 a0_ = __builtin_bit_cast(i32x4, At[m][0]), a1_ = __builtin_bit_cast(i32x4, At[m][1]), b0_ = __builtin_bit_cast(i32x4, Bt[n][0]), b1_ = __builtin_bit_cast(i32x4, Bt[n][1]); \
        const i32x8 a8_ = __builtin_shufflevector(a0_, a1_, 0, 1, 2, 3, 4, 5, 6, 7), b8_ = __builtin_shufflevector(b0_, b1_, 0, 1, 2, 3, 4, 5, 6, 7); \
        asm volatile("v_mfma_scale_f32_16x16x128_f8f6f4 %0, %1, %2, %0, %3, %3 op_sel_hi:[0,0,0]" : "+v"(acc[ai][bj][m][n]) : "v"(b8_), "v"(a8_), "v"(sc8_)); } __builtin_amdgcn_s_setprio(0); } while (0)
#define PG8_MM(ai, bj, At, Bt) do { if constexpr (F8) PG8_MMA8(ai, bj, At, Bt); else PG8_MMA(ai, bj, At, Bt); } while (0)
#define PG8_WAIT_V(n) asm volatile("s_waitcnt vmcnt(" #n ")" ::: "memory")
#define PG8_WAIT_L(n) asm volatile("s_waitcnt lgkmcnt(" #n ")" ::: "memory")
#define PG8_BAR __builtin_amdgcn_s_barrier()
#define PG8_SCHED __builtin_amdgcn_sched_barrier(0)
    int sc8_ = 0x7f7f7f7f; asm volatile("" : "+v"(sc8_));
    Unit cur, nxt; int ui = 0;
    if (!S.next(0, cur)) return;
    f32x4 acc[2][2][4][2];
#pragma unroll
    for (int a = 0; a < 2; ++a)
#pragma unroll
        for (int b = 0; b < 2; ++b)
#pragma unroll
            for (int m = 0; m < 4; ++m)
#pragma unroll
                for (int n = 0; n < 2; ++n) acc[a][b][m][n] = (f32x4){0.f, 0.f, 0.f, 0.f};
    bf16x8 At[4][2], B0[2][2], B1[2][2];
    const char* cA = (const char*)g.A + (size_t)cur.pm * tstep + (size_t)cur.k0 * 2; const char* cB = (const char*)g.Bt + (size_t)cur.pn * tstep + (size_t)cur.k0 * 2;
    S.a_ready(cur);
    if constexpr (SP2) {
        PG8_STAGE(PG8_SB(0, 0), cB, voffB); PG8_STAGE(PG8_SB(0, 1), cB + hstep, voffB); PG8_STAGE(PG8_SA(0, 0), cA, voffA); PG8_STAGE(PG8_SA(0, 1), cA + hstep, voffA);
        if (wr == 1) PG8_BAR;
        PG8_WAIT_V(2); PG8_BAR;
        PG8_STAGE(PG8_SB(1, 0), cB + kstep, voffB); PG8_STAGE(PG8_SA(1, 0), cA + kstep, voffA); PG8_STAGE(PG8_SB(1, 1), cB + hstep + kstep, voffB);
        PG8_WAIT_V(6); PG8_BAR;
    } else {
        PG8_STAGE(PG8_SB(0, 0), cB, voffB); PG8_STAGE(PG8_SA(0, 0), cA, voffA); PG8_STAGE(PG8_SB(0, 1), cB + hstep, voffB); PG8_STAGE(PG8_SA(0, 1), cA + hstep, voffA);
        if (wr == 1) PG8_BAR;
        PG8_WAIT_V(4); PG8_BAR;
        PG8_STAGE(PG8_SB(1, 0), cB + kstep, voffB); PG8_STAGE(PG8_SA(1, 0), cA + kstep, voffA); PG8_STAGE(PG8_SB(1, 1), cB + hstep + kstep, voffB);
        PG8_WAIT_V(6); PG8_BAR;
    }
    for (;;) {
        const bool has_next = S.next(ui + 1, nxt);
        const char* nA = has_next ? (const char*)g.A + (size_t)nxt.pm * tstep + (size_t)nxt.k0 * 2 : cA; const char* nB = has_next ? (const char*)g.Bt + (size_t)nxt.pn * tstep + (size_t)nxt.k0 * 2 : cB;
        const int nt = cur.nt;
        for (int t = 0; t < nt; t += 2) {
            const bool last = (t == nt - 2);
            const char* a1 = cA + (size_t)(t + 1) * kstep;
            const char* a2 = last ? nA : cA + (size_t)(t + 2) * kstep; const char* b2 = last ? nB : cB + (size_t)(t + 2) * kstep;
            const char* a3 = a2 + kstep; const char* b3 = b2 + kstep;
            if (last && has_next) S.a_ready(nxt);
            if constexpr (SP2) {
            PG8_LDB(B0, 0, 0); PG8_LDB(B1, 0, 1); PG8_SCHED; PG8_LDA(At, 0, 0); PG8_STAGE(PG8_SA(1, 1), a1 + hstep, voffA);
            PG8_WAIT_V(8); PG8_WAIT_L(0); PG8_BAR; PG8_MM(0, 0, At, B0); PG8_MM(0, 1, At, B1); PG8_BAR; PG8_SCHED;
            PG8_LDA(At, 0, 1); PG8_STAGE(PG8_SB(0, 0), b2, voffB); PG8_STAGE(PG8_SB(0, 1), b2 + hstep, voffB); PG8_STAGE(PG8_SA(0, 0), a2, voffA);
            PG8_WAIT_V(8); PG8_WAIT_L(0); PG8_BAR; PG8_MM(1, 0, At, B0); PG8_MM(1, 1, At, B1); PG8_BAR; PG8_SCHED;
            PG8_LDB(B0, 1, 0); PG8_LDB(B1, 1, 1); PG8_SCHED; PG8_LDA(At, 1, 0); PG8_STAGE(PG8_SA(0, 1), a2 + hstep, voffA);
            PG8_WAIT_V(8); PG8_WAIT_L(0); PG8_BAR; PG8_MM(0, 0, At, B0); PG8_MM(0, 1, At, B1); PG8_BAR; PG8_SCHED;
            PG8_LDA(At, 1, 1); PG8_STAGE(PG8_SB(1, 0), b3, voffB); PG8_STAGE(PG8_SB(1, 1), b3 + hstep, voffB); PG8_STAGE(PG8_SA(1, 0), a3, voffA);
            PG8_WAIT_V(8); PG8_WAIT_L(0); PG8_BAR; PG8_MM(1, 0, At, B0); PG8_MM(1, 1, At, B1); PG8_BAR; PG8_SCHED;
            } else {
            PG8_LDB(B0, 0, 0); PG8_SCHED; PG8_LDA(At, 0, 0); PG8_STAGE(PG8_SA(1, 1), a1 + hstep, voffA);
            PG8_WAIT_L(8); PG8_BAR; PG8_WAIT_L(0); PG8_MM(0, 0, At, B0); PG8_BAR; PG8_SCHED;
            PG8_LDB(B1, 0, 1); PG8_STAGE(PG8_SB(0, 0), b2, voffB);
            PG8_BAR; PG8_WAIT_L(0); PG8_MM(0, 1, At, B1); PG8_BAR;
            PG8_LDA(At, 0, 1); PG8_STAGE(PG8_SA(0, 0), a2, voffA);
            PG8_BAR; PG8_WAIT_L(0); PG8_MM(1, 0, At, B0); PG8_BAR; PG8_SCHED;
            PG8_STAGE(PG8_SB(0, 1), b2 + hstep, voffB);
            PG8_WAIT_V(6); PG8_BAR; PG8_MM(1, 1, At, B1); PG8_BAR;
            PG8_LDB(B0, 1, 0); PG8_SCHED; PG8_LDA(At, 1, 0); PG8_STAGE(PG8_SA(0, 1), a2 + hstep, voffA);
            PG8_WAIT_L(8); PG8_BAR; PG8_WAIT_L(0); PG8_MM(0, 0, At, B0); PG8_BAR; PG8_SCHED;
            PG8_LDB(B1, 1, 1); PG8_STAGE(PG8_SB(1, 0), b3, voffB);
            PG8_BAR; PG8_WAIT_L(0); PG8_MM(0, 1, At, B1); PG8_BAR;
            PG8_LDA(At, 1, 1); PG8_STAGE(PG8_SA(1, 0), a3, voffA);
            PG8_BAR; PG8_WAIT_L(0); PG8_MM(1, 0, At, B0); PG8_BAR; PG8_SCHED;
            PG8_STAGE(PG8_SB(1, 1), b3 + hstep, voffB);
            PG8_WAIT_V(6); PG8_BAR; PG8_MM(1, 1, At, B1); PG8_BAR;
            }
        }
        if constexpr (ALIGN_EPI) { if (wr == 0) PG8_BAR; }
        if constexpr (!Epi::AFTER_DRAIN) { E(acc, cur, wr, wc, fr, fq); S.done(cur); }
        if (!has_next) break;
#pragma unroll
        for (int a = 0; a < 2; ++a)
#pragma unroll
            for (int b = 0; b < 2; ++b)
#pragma unroll
                for (int m = 0; m < 4; ++m)
#pragma unroll
                    for (int n = 0; n < 2; ++n) acc[a][b][m][n] = (f32x4){0.f, 0.f, 0.f, 0.f};
        cur = nxt; cA = nA; cB = nB; ++ui;
        if constexpr (ALIGN_EPI) { if (wr == 1) PG8_BAR; }
    }
    PG8_WAIT_V(0);
    if constexpr (!ALIGN_EPI) { if (wr == 0) PG8_BAR; }
    PG8_BAR;
    if constexpr (Epi::AFTER_DRAIN) { E.fused(acc, cur, wr, wc, fr, fq, lds, wid, lane); S.done(cur); }
#undef PG8_SA
#undef PG8_SB
#undef PG8_STAGE
#undef PG8_LDA
#undef PG8_LDB
#undef PG8_MMA
#undef PG8_MMA8
#undef PG8_MM
#undef PG8_WAIT_V
#undef PG8_WAIT_L
#undef PG8_BAR
#undef PG8_SCHED
}
}
#define XB_TMO      128
#define XB_XCNT(j)  (256  + 64 * (j))
#define XB_XSUB(j)  (1280 + 64 * (j))
#define XB_XGEN(j)  (2304 + 64 * (j))
#define XB_TOP      3328
#define XB_TOPGEN   3392
#define XCD_BAR_WORDS 3456
#define XB_SPIN_CAP (1u << 18)

__device__ __forceinline__ unsigned xb_ld(unsigned* p)              { return __hip_atomic_load(p, __ATOMIC_RELAXED, __HIP_MEMORY_SCOPE_AGENT); }
__device__ __forceinline__ unsigned xb_add(unsigned* p, unsigned v) { return __hip_atomic_fetch_add(p, v, __ATOMIC_RELAXED, __HIP_MEMORY_SCOPE_AGENT); }
__device__ __forceinline__ unsigned xb_xcc_id() { return (unsigned)__builtin_amdgcn_s_getreg((3 << 11) | 20) & 0xFu; }
#define XB_SPIN(cond, bar) do { unsigned _sp = 0; while (cond) { __builtin_amdgcn_s_sleep(1); \
    if ((++_sp & 255u) == 0u) { if (xb_ld(&(bar)[XB_TMO])) break; if (_sp > XB_SPIN_CAP) { atomicAdd(&(bar)[XB_TMO], 1u); break; } } } } while (0)

struct XcdBarrier {
    unsigned* bar; unsigned x; unsigned w;
    volatile LAS unsigned* st;
};

__device__ __forceinline__ XcdBarrier xcd_barrier_post(unsigned* bar, volatile LAS unsigned* st) {
    XcdBarrier b; b.bar = bar; b.x = xb_xcc_id(); b.st = st; b.w = (unsigned)__builtin_amdgcn_readfirstlane((int)(threadIdx.x >> 6));
    if (threadIdx.x == 0) (void)xb_add(&bar[XB_XCNT(b.x)], 1u);
    return b;
}
__device__ __forceinline__ void xcd_barrier_complete(unsigned* bar, unsigned x, unsigned& nloc, unsigned& nx) {
    const unsigned G = gridDim.x * gridDim.y * gridDim.z;
    unsigned sum, cnt, mine, sp = 0u;
    for (;;) {
        sum = 0u; cnt = 0u; mine = 0u;
#pragma unroll
        for (unsigned j = 0; j < 16; ++j) { const unsigned c = xb_ld(&bar[XB_XCNT(j)]); sum += c; cnt += (c > 0u) ? 1u : 0u; mine = (j == x) ? c : mine; }
        if (sum == G) break;
        __builtin_amdgcn_s_sleep(1);
        if ((++sp & 255u) == 0u) { if (xb_ld(&bar[XB_TMO])) break; if (sp > XB_SPIN_CAP) { atomicAdd(&bar[XB_TMO], 1u); break; } }
    }
    nloc = mine > 0u ? mine : 1u; nx = cnt > 0u ? cnt : 1u;
}

__device__ __forceinline__ void xcd_barrier(const XcdBarrier& b) {
    asm volatile("s_waitcnt vmcnt(0)" ::: "memory");
    __syncthreads();
    if (b.w == 0u && __builtin_amdgcn_mbcnt_hi(~0u, __builtin_amdgcn_mbcnt_lo(~0u, 0u)) == 0u) {
        unsigned* bar = b.bar;
        __builtin_amdgcn_s_waitcnt(0);
        unsigned nloc = b.st[0], nx = b.st[1];
        if (nloc == 0u) { xcd_barrier_complete(bar, b.x, nloc, nx); b.st[0] = nloc; b.st[1] = nx; }
        const unsigned old = xb_add(&bar[XB_XSUB(b.x)], 1u);
        const unsigned gen = old / nloc;
        if (old + 1u == (gen + 1u) * nloc) {
            __builtin_amdgcn_fence(__ATOMIC_RELEASE, "agent");
            asm volatile("s_waitcnt vmcnt(0)" ::: "memory");
            const unsigned og = xb_add(&bar[XB_TOP], 1u);
            const unsigned tg = og / nx;
            if (og + 1u == (tg + 1u) * nx) xb_add(&bar[XB_TOPGEN], 1u);
            else XB_SPIN(xb_ld(&bar[XB_TOPGEN]) == tg, bar);
            __builtin_amdgcn_fence(__ATOMIC_ACQUIRE, "agent");
            xb_add(&bar[XB_XGEN(b.x)], 1u);
            asm volatile("s_waitcnt vmcnt(0)" ::: "memory");
        } else {
            XB_SPIN(xb_ld(&bar[XB_XGEN(b.x)]) == gen, bar);
            __builtin_amdgcn_fence(__ATOMIC_ACQUIRE, "agent");
            asm volatile("s_waitcnt vmcnt(0)" ::: "memory");
        }
    }
    __syncthreads();
}

typedef unsigned short bf16;
typedef short bf16x8 __attribute__((ext_vector_type(8)));
typedef float f32x4 __attribute__((ext_vector_type(4)));
typedef unsigned u32x4 __attribute__((ext_vector_type(4)));
typedef unsigned u32x2 __attribute__((ext_vector_type(2)));
typedef float f32x2 __attribute__((ext_vector_type(2)));

constexpr int DM = 2048, SEQ = 8192, CTXL = 256, NR = SEQ + CTXL, DEPTH = 4, BW = 512, PROJW = 5120, DFF = 5632;
constexpr int NCH = NR / 128;
constexpr float EPS = 1e-6f;
constexpr int NWAVES = 8, NTHR = 512;
constexpr int LDT = 136;

constexpr size_t WS_CTL = 0, CTL_BYTES = 1u << 20, CTL_ZERO = 32768;
constexpr size_t LW_WIN = 0;
constexpr size_t LW_WM  = LW_WIN + (size_t)PROJW * DM * 2;
constexpr size_t LW_WB  = LW_WM + (size_t)8192 * DM * 2;
constexpr size_t LW_WO  = LW_WB + (size_t)4 * DM * BW * 2;
constexpr size_t LW_W13 = LW_WO + (size_t)DM * DM * 2;
constexpr size_t LW_W2  = LW_W13 + (size_t)2 * DFF * DM * 2;
constexpr size_t LW_WGLU = LW_W2 + (size_t)DM * DFF * 2;
constexpr size_t LW_WS  = LW_WGLU + (size_t)BW * BW * 2;
constexpr size_t LW_STRIDE = LW_WS + (size_t)4 * 128 * 128 * 2;
constexpr size_t WS_W = CTL_BYTES;
constexpr size_t WS_X = WS_W + DEPTH * LW_STRIDE;
constexpr size_t WS_H = WS_X + (size_t)NR * DM * 4;
constexpr size_t WS_PROJ = WS_H + (size_t)NR * DM * 2;
constexpr size_t WS_O = WS_PROJ + (size_t)NR * PROJW * 2;
constexpr size_t WS_YP = WS_O + (size_t)4 * NR * BW * 2;
constexpr size_t WS_T = WS_YP;
constexpr size_t WS_G = WS_YP + (size_t)NR * 8192 * 2;
constexpr size_t WS_MRG = WS_G + (size_t)NR * 8192 * 2;
constexpr size_t WS_PART = WS_MRG + (size_t)NR * DM * 2;
constexpr size_t WS_S5Y = WS_PART + (size_t)11 * 256 * DM * 4;
constexpr size_t WS_KVT = WS_S5Y + (size_t)NR * BW * 2;
constexpr size_t WS_ST = WS_KVT + (size_t)2 * NCH * 4 * 16384 * 4;
constexpr size_t WS_S5E = WS_ST + (size_t)2 * NCH * 4 * 16384 * 2;
constexpr size_t WS_S5XS = WS_S5E + (size_t)2 * NCH * 32 * 64 * 8;
constexpr size_t WS_MODP = WS_S5XS + (size_t)2 * NCH * 32 * 64 * 8;
constexpr size_t WS_MOD = WS_MODP + (size_t)32 * 4 * 2 * 12288 * 4;
constexpr size_t WS_COS = WS_MOD + (size_t)4 * 2 * 12288 * 4;
constexpr size_t WS_SIN = WS_COS + (size_t)SEQ * 64 * 4;
constexpr size_t WS_S5AB = WS_SIN + (size_t)SEQ * 64 * 4;
constexpr size_t WS_S5AL = WS_S5AB + (size_t)4 * 2 * 32 * 64 * 8;
constexpr size_t WS_S5BW = WS_S5AL + (size_t)4 * 2 * 32 * 64 * 8;
constexpr size_t WS_S5CW = WS_S5BW + (size_t)4 * 2 * 32 * 128 * 32 * 2;
constexpr size_t WS_S5BB = WS_S5CW + (size_t)4 * 32 * 16 * 128 * 2;
constexpr size_t WS_GST = WS_S5BB + (size_t)4 * 2 * 32 * 64 * 16 * 8;
constexpr size_t WS_H8 = WS_GST + (size_t)NR * 8 * 8;
constexpr size_t WS_END = WS_H8 + (size_t)NR * DM;

constexpr int MISC_OFF = 143360, LDS_BYTES = 147456;

enum { I_X = 0, I_C, I_CTX, I_CCTX, I_ADAW, I_ADAB, I_N1G, I_N2G, I_WIN, I_DECAY, I_S5ARE, I_S5AIM, I_S5BRE, I_S5BIM, I_S5CRE, I_S5CIM, I_S5D, I_S5LDT,
       I_WGLU, I_CONVW, I_LNG, I_LNB, I_CWS, I_CBS, I_WBR, I_WMERGE, I_BMERGE, I_WOUT, I_W1, I_W3, I_W2, I_FNG, N_IN };

struct Args { const float* in[N_IN]; float* out; unsigned char* ws; int ph_lo, ph_hi; };

struct Frame { LAS unsigned char* lds; int tid, lane, wave, G, gw, NGW, bid, z; };
__device__ __forceinline__ int lane_id() { return (int)__builtin_amdgcn_mbcnt_hi(~0u, __builtin_amdgcn_mbcnt_lo(~0u, 0u)); }
__device__ __forceinline__ Frame relaunder(const Frame& F0) { Frame F = F0; int w = F0.wave, z = 0, b = F0.bid, g = F0.G; asm volatile("" : "+s"(w), "+s"(z), "+s"(b), "+s"(g)); int ln = lane_id(); asm volatile("" : "+v"(ln)); F.wave = w; F.lane = ln; F.tid = w * 64 + ln; F.z = z; F.bid = b; F.G = g; F.gw = b * 8 + w; F.NGW = g * 8; return F; }

#define LDS_WAIT() asm volatile("s_waitcnt lgkmcnt(0)" ::: "memory")

__device__ __forceinline__ unsigned f2bf(float f) { unsigned u = __builtin_bit_cast(unsigned, f); return (u + 0x7fffu + ((u >> 16) & 1u)) >> 16; }
__device__ __forceinline__ unsigned pk2(float lo, float hi) { return pg8::cvt_pk_bf16(lo, hi); }
__device__ __forceinline__ float bflo(unsigned w) { return __builtin_bit_cast(float, w << 16); }
__device__ __forceinline__ float bfhi(unsigned w) { return __builtin_bit_cast(float, w & 0xffff0000u); }
__device__ __forceinline__ float bf2f(bf16 b) { return __builtin_bit_cast(float, (unsigned)b << 16); }
__device__ __forceinline__ void unpack8(const u32x4 w, float (&f)[8]) {
    f[0] = bflo(w.x); f[1] = bfhi(w.x); f[2] = bflo(w.y); f[3] = bfhi(w.y); f[4] = bflo(w.z); f[5] = bfhi(w.z); f[6] = bflo(w.w); f[7] = bfhi(w.w); }
__device__ __forceinline__ u32x4 pack8(const float (&f)[8]) { u32x4 w; w.x = pk2(f[0], f[1]); w.y = pk2(f[2], f[3]); w.z = pk2(f[4], f[5]); w.w = pk2(f[6], f[7]); return w; }
__device__ __forceinline__ float wave_sum(float v) {
#pragma unroll
    for (int o = 1; o < 64; o <<= 1) v += __shfl_xor(v, o);
    return v;
}
__device__ __forceinline__ float sigmoid_fast(float x) { return __builtin_amdgcn_rcpf(1.f + __builtin_amdgcn_exp2f(-1.4426950408889634f * x)); }
__device__ __forceinline__ float silu_fast(float x) { return x * sigmoid_fast(x); }
__device__ __forceinline__ f32x4 sig4_t(const f32x4 t) { f32x4 e; e[0] = __builtin_amdgcn_exp2f(t[0]); e[1] = __builtin_amdgcn_exp2f(t[1]); e[2] = __builtin_amdgcn_exp2f(t[2]); e[3] = __builtin_amdgcn_exp2f(t[3]);
    const f32x4 d = e + 1.f; f32x4 r; r[0] = __builtin_amdgcn_rcpf(d[0]); r[1] = __builtin_amdgcn_rcpf(d[1]); r[2] = __builtin_amdgcn_rcpf(d[2]); r[3] = __builtin_amdgcn_rcpf(d[3]); return r; }
__device__ __forceinline__ float gelu_tanh(float x) { const float t = x * (x * x * -0.10294324f + -2.3022082f); return x * __builtin_amdgcn_rcpf(1.f + __builtin_amdgcn_exp2f(t)); }
__device__ __forceinline__ float silu_acc(float x) { return x / (1.f + expf(-x)); }

template <int NT>
__device__ __forceinline__ void mma_nt(f32x4 (&acc)[NT], const LAS bf16* A, int lda, const LAS bf16* Bt, int ldb, int K, int lane) {
    const int fr = lane & 15, fq = lane >> 4;
    const LAS bf16* ap = A + fr * lda + 8 * fq;
    const LAS bf16* bp = Bt + fr * ldb + 8 * fq;
    for (int k0 = 0; k0 < K; k0 += 32) {
        const bf16x8 a = *(const LAS bf16x8*)(ap + k0);
#pragma unroll
        for (int n = 0; n < NT; ++n) {
            const bf16x8 b = *(const LAS bf16x8*)(bp + n * 16 * ldb + k0);
            acc[n] = __builtin_amdgcn_mfma_f32_16x16x32_bf16(b, a, acc[n], 0, 0, 0);
        }
    }
}

#ifndef PROBE_KIND
#define PROBE_KIND -1
#endif
#define PREPS(k) ((PROBE_KIND == (k)) ? 2 : 1)
struct RowId { __device__ __forceinline__ int operator()(int n) const { return n; } };
template <int M> struct RowW13 { __device__ __forceinline__ int operator()(int n) const { const int pn = n >> 7, o = n & 127; const int wc = o >> 5, fq = (o >> 3) & 3, bj = (o >> 2) & 1, i = o & 3;
    return 256 * pn + 128 * bj + 32 * wc + 16 * M + 4 * fq + i; } };
template <class RowMap>
__device__ __forceinline__ void transpose2(const Frame& F, const float* src, size_t ldsrc, int K, int N, bf16* dst, int ld_dst, const RowMap rm, int lo, int hi, int wid, int nw) {
    LAS bf16* t = (LAS bf16*)(F.lds + F.wave * 16384);
    const int nblk = N / 64, lane = F.lane, q = lane >> 4, n4 = 4 * (lane & 15);
    for (int it = lo + wid; it < hi; it += nw) {
        const int kb = it / nblk, nb = it % nblk, k0 = 64 * kb, n0 = 64 * nb;
        const float* sp = src + (size_t)(k0 + 16 * q) * ldsrc + n0 + n4;
        f32x4 v[16];
#pragma unroll
        for (int r = 0; r < 16; ++r) v[r] = *(const f32x4*)(sp + (size_t)r * ldsrc);
#pragma unroll
        for (int rq = 0; rq < 4; ++rq)
#pragma unroll
            for (int j = 0; j < 4; ++j) { u32x2 w; w.x = pk2(v[4 * rq][j], v[4 * rq + 1][j]); w.y = pk2(v[4 * rq + 2][j], v[4 * rq + 3][j]);
                *(LAS u32x2*)(t + (n4 + j) * 72 + 16 * q + 4 * rq) = w; }
        LDS_WAIT();
#pragma unroll
        for (int j = 0; j < 8; ++j) { const int n = (lane >> 3) + 8 * j, c = lane & 7;
            *(u32x4*)(dst + (size_t)rm(n0 + n) * ld_dst + k0 + 8 * c) = *(const LAS u32x4*)(t + n * 72 + 8 * c); }
        LDS_WAIT();
    }
}

__device__ __forceinline__ unsigned pk_e4m3(float a, float b, float c, float d) { int w = __builtin_amdgcn_cvt_pk_fp8_f32(a, b, 0, false); w = __builtin_amdgcn_cvt_pk_fp8_f32(c, d, w, true); return (unsigned)w; }
__device__ __forceinline__ void transpose8(const Frame& F, const float* src, size_t ldsrc, int K, int N, unsigned char* dst, int ld_dst, float scale, int lo, int hi, int wid, int nw) {
    LAS unsigned char* t = (LAS unsigned char*)(F.lds + F.wave * 16384);
    const int nblk = N / 64, lane = F.lane, q = lane >> 4, n4 = 4 * (lane & 15);
    for (int it = lo + wid; it < hi; it += nw) {
        const int kb = it / nblk, nb = it % nblk, k0 = 64 * kb, n0 = 64 * nb;
        const float* sp = src + (size_t)(k0 + 16 * q) * ldsrc + n0 + n4;
        f32x4 v[16];
#pragma unroll
        for (int r = 0; r < 16; ++r) v[r] = *(const f32x4*)(sp + (size_t)r * ldsrc) * scale;
#pragma unroll
        for (int j = 0; j < 4; ++j) { u32x4 w;
            w.x = pk_e4m3(v[0][j], v[1][j], v[2][j], v[3][j]); w.y = pk_e4m3(v[4][j], v[5][j], v[6][j], v[7][j]); w.z = pk_e4m3(v[8][j], v[9][j], v[10][j], v[11][j]); w.w = pk_e4m3(v[12][j], v[13][j], v[14][j], v[15][j]);
            *(LAS u32x4*)(t + (n4 + j) * 80 + 16 * q) = w; }
        LDS_WAIT();
#pragma unroll
        for (int c = 0; c < 4; ++c) *(u32x4*)(dst + (size_t)(n0 + lane) * ld_dst + k0 + 16 * c) = *(const LAS u32x4*)(t + lane * 80 + 16 * c);
        LDS_WAIT();
    }
}
constexpr int CT_WB = 0, CT_WO = CT_WB + 4 * 8 * 32, CT_W1 = CT_WO + 32 * 32, CT_W3 = CT_W1 + 32 * 88, CT_W2 = CT_W3 + 32 * 88, CT_WIN = CT_W2 + 88 * 32, CT_WM = CT_WIN + 32 * 80, CT_WG = CT_WM + 32 * 128, CT_END = CT_WG + 64;
__device__ __forceinline__ void convert_tiles(const Frame& F, const Args& P, int l, int a, int b, int wid, int nw) {
#define CT_SEG(off, cnt, call) do { const int lo_ = (a > (off) ? a : (off)) - (off), hi_ = (b < (off) + (cnt) ? b : (off) + (cnt)) - (off); if (lo_ < hi_) { const int lo = lo_, hi = hi_; call; } } while (0)
    if (l >= 0 && a < CT_WIN) {
        unsigned char* lw = (P.ws + F.z) + WS_W + (size_t)l * LW_STRIDE;
#pragma unroll 1
        for (int k = 0; k < 4; ++k)
            CT_SEG(CT_WB + k * 256, 256, transpose2(F, P.in[I_WBR + F.z] + ((size_t)l * 4 + k) * BW * DM, DM, BW, DM, (bf16*)(lw + LW_WB) + (size_t)k * DM * BW, BW, RowId{}, lo, hi, wid, nw));
        CT_SEG(CT_WO, 32 * 32, transpose2(F, P.in[I_WOUT + F.z] + (size_t)l * DM * DM, DM, DM, DM, (bf16*)(lw + LW_WO), DM, RowId{}, lo, hi, wid, nw));
        CT_SEG(CT_W1, 32 * 88, transpose2(F, P.in[I_W1 + F.z] + (size_t)l * DM * DFF, DFF, DM, DFF, (bf16*)(lw + LW_W13), DM, RowW13<0>{}, lo, hi, wid, nw));
        CT_SEG(CT_W3, 32 * 88, transpose2(F, P.in[I_W3 + F.z] + (size_t)l * DM * DFF, DFF, DM, DFF, (bf16*)(lw + LW_W13), DM, RowW13<1>{}, lo, hi, wid, nw));
        CT_SEG(CT_W2, 88 * 32, transpose2(F, P.in[I_W2 + F.z] + (size_t)l * DFF * DM, DM, DFF, DM, (bf16*)(lw + LW_W2), DFF, RowId{}, lo, hi, wid, nw));
    }
    if (l + 1 < DEPTH && b > CT_WIN) {
        const int l1 = l + 1; unsigned char* lw = (P.ws + F.z) + WS_W + (size_t)l1 * LW_STRIDE;
        CT_SEG(CT_WIN, 32 * 80, transpose2(F, P.in[I_WIN + F.z] + (size_t)l1 * DM * PROJW, PROJW, DM, PROJW, (bf16*)(lw + LW_WIN), DM, RowId{}, lo, hi, wid, nw));
        CT_SEG(CT_WM, 32 * 128, transpose8(F, P.in[I_WMERGE + F.z] + (size_t)l1 * DM * 8192, 8192, DM, 8192, lw + LW_WM, DM, 64.f, lo, hi, wid, nw));
        CT_SEG(CT_WG, 64, transpose2(F, P.in[I_WGLU + F.z] + (size_t)l1 * BW * BW, BW, BW, BW, (bf16*)(lw + LW_WGLU), BW, RowId{}, lo, hi, wid, nw));
    }
#undef CT_SEG
}
#ifndef CT_G1P
#define CT_G1P 4816
#endif
#ifndef CT_GLU
#define CT_GLU 2200
#endif
#ifndef CT_YP
#define CT_YP 1800
#endif
#ifndef CT_WOP
#define CT_WOP 2600
#endif
#ifndef CT_F1P
#define CT_F1P 3800
#endif
#ifndef CT_F2P
#define CT_F2P 2000
#endif
constexpr int CT_R0 = CT_G1P, CT_R1 = CT_R0 + CT_GLU, CT_R2 = CT_R1 + CT_YP, CT_R3 = CT_R2 + CT_WOP, CT_R4 = CT_R3 + CT_F1P, CT_C = CT_R4 + CT_F2P;
static_assert(CT_C <= CT_END, "shadow conversion ranges exceed a layer's tile list");
#define SHADOW(first, lo, hi) do { if (F.G == 256 && F.bid >= (first)) { const Frame Fc = relaunder(F0); convert_tiles(Fc, P, l, (lo), (hi), (Fc.bid - (first)) * NWAVES + Fc.wave, (Fc.G - (first)) * NWAVES); } } while (0)
constexpr int CT_L3A = CT_W2 - 1800, CT_L3B = CT_W2;
static_assert(CT_L3B <= CT_W2 && CT_R0 >= CT_W1 && CT_R3 >= CT_W2 && CT_R4 >= CT_WIN, "conversion deadlines");

__device__ __forceinline__ void prologue_a(const Frame& F, const Args& P) {
    unsigned char* ws = (P.ws + F.z);
    for (int l = 0; l < DEPTH; ++l) {
        if (l == 0) convert_tiles(F, P, -1, CT_WIN, CT_END, F.gw, F.NGW);
        if (F.G != 256) convert_tiles(F, P, l, 0, CT_END, F.gw, F.NGW);
        unsigned char* lw = ws + WS_W + (size_t)l * LW_STRIDE;
        { const float* s = P.in[I_CWS + F.z] + (size_t)l * 4 * 128 * 128; bf16* d = (bf16*)(lw + LW_WS);
          for (int i = F.bid * NTHR + F.tid; i < 4 * 128 * 128; i += F.G * NTHR) d[i] = (bf16)f2bf(s[i]); }
    }
    __syncthreads();
    {
        LAS float* sl = (LAS float*)F.lds; LAS float* sc = sl + DM;
        for (int i = F.tid; i < DM; i += NTHR) { sl[i] = silu_acc(P.in[I_C + F.z][i]); sc[i] = silu_acc(P.in[I_CCTX + F.z][i]); }
        __syncthreads();
        float* MODP = (float*)(ws + WS_MODP);
        for (int rr = 0; rr < PREPS(31); ++rr)
        for (int it = F.bid; it < 4 * 6 * 32; it += F.G) {
            const int l = it / 192, r = it % 192, jb = r >> 5, sli = r & 31, j = jb * 2048 + 4 * F.tid, i0 = sli * 64;
            const float* w = P.in[I_ADAW + F.z] + ((size_t)l * DM + i0) * 12288 + j;
            f32x4 a0 = (f32x4){0.f, 0.f, 0.f, 0.f}, a1 = a0;
#pragma unroll 32
            for (int i = 0; i < 64; ++i) { const f32x4 wv = *(const f32x4*)(w + (size_t)i * 12288); a0 = a0 + wv * sl[i0 + i]; a1 = a1 + wv * sc[i0 + i]; }
            *(f32x4*)(MODP + ((size_t)(sli * 4 + l) * 2 + 0) * 12288 + j) = a0; *(f32x4*)(MODP + ((size_t)(sli * 4 + l) * 2 + 1) * 12288 + j) = a1;
        }
    }
    const int gt = F.bid * NTHR + F.tid, GT = F.G * NTHR;
    for (int rr = 0; rr < PREPS(32); ++rr)
    for (int idx = gt; idx < 4 * 2 * 32 * 128; idx += GT) {
        const int n = idx & 127, p = n >> 1, ri = n & 1, g = (idx >> 7) & 31, dir = (idx >> 12) & 1, l = idx >> 13;
        const float a_re = P.in[I_S5ARE + F.z][(l * 32 + g) * 64 + p], a_im = P.in[I_S5AIM + F.z][(l * 32 + g) * 64 + p];
        const float dt = expf(P.in[I_S5LDT + F.z][(l * 2 + dir) * 32 + g]);
        const float mag = expf(dt * a_re), ang = dt * a_im, abr = mag * cosf(ang), abi = mag * sinf(ang);
        const float nr = abr - 1.f, ni = abi, den = a_re * a_re + a_im * a_im;
        const float fre = (nr * a_re + ni * a_im) / den, fim = (ni * a_re - nr * a_im) / den;
        const size_t bi = ((size_t)((l * 2 + dir) * 32 + g) * 64 + p) * 16;
        const float* bre = P.in[I_S5BRE + F.z] + bi; const float* bim = P.in[I_S5BIM + F.z] + bi;
        bf16* bw = (bf16*)(ws + WS_S5BW) + (size_t)idx * 32;
        float* bbf = (float*)(ws + WS_S5BB) + ((size_t)(((l * 2 + dir) * 32 + g) * 64 + p) * 16) * 2 + ri;
        f32x4 brv[4], biv[4];
#pragma unroll
        for (int c4 = 0; c4 < 4; ++c4) { brv[c4] = *(const f32x4*)(bre + 4 * c4); biv[c4] = *(const f32x4*)(bim + 4 * c4); }
#pragma unroll
        for (int c = 0; c < 16; ++c) { const float br_ = brv[c >> 2][c & 3], bi_ = biv[c >> 2][c & 3]; const float v = ri ? (fre * bi_ + fim * br_) : (fre * br_ - fim * bi_);
            bbf[2 * c] = v;
            const unsigned hi = f2bf(v); const float hf = __builtin_bit_cast(float, hi << 16); bw[c] = (bf16)hi; bw[16 + c] = (bf16)f2bf(v - hf); }
        if (ri == 0) { const int i2 = ((l * 2 + dir) * 32 + g) * 64 + p;
            ((float2*)(ws + WS_S5AB))[i2] = make_float2(abr, abi);
            float pr = abr, pi = abi;
            for (int s2 = 0; s2 < 7; ++s2) { const float t = pr * pr - pi * pi; pi = 2.f * pr * pi; pr = t; }
            ((float2*)(ws + WS_S5AL))[i2] = make_float2(pr, pi); }
    }
    for (int rr = 0; rr < PREPS(32); ++rr)
    for (int idx = gt; idx < 4 * 32 * 16 * 128; idx += GT) {
        const int n = idx & 127, p = n >> 1, ch = (idx >> 7) & 15, lg = idx >> 11;
        const size_t ci = ((size_t)lg * 16 + ch) * 64 + p;
        ((bf16*)(ws + WS_S5CW))[idx] = (bf16)f2bf((n & 1) ? -P.in[I_S5CIM + F.z][ci] : P.in[I_S5CRE + F.z][ci]);
    }
    {
        float* COS = (float*)(ws + WS_COS); float* SIN = (float*)(ws + WS_SIN);
        for (int idx = gt; idx < 192 * 32; idx += GT) {
            const int r = idx >> 5, j = idx & 31;
            const float fr = expf(-((float)j / 32.f) * 9.210340371976184f);
            const float ang = (float)(r < 128 ? r : r - 128) * fr;
            COS[idx] = cosf(ang); SIN[idx] = sinf(ang);
        }
    }
}
__device__ __forceinline__ void prologue_b(const Frame& F, const Args& P) {
    const float* MODP = (const float*)((P.ws + F.z) + WS_MODP); float* MOD = (float*)((P.ws + F.z) + WS_MOD);
    for (int idx = F.bid * NTHR + F.tid; idx < 4 * 2 * 12288; idx += F.G * NTHR) {
        const int l = idx / 24576, j = idx % 12288;
        float s = P.in[I_ADAB + F.z][l * 12288 + j];
        float pv[32];
#pragma unroll
        for (int k = 0; k < 32; ++k) pv[k] = MODP[(size_t)k * 98304 + idx];
#pragma unroll
        for (int k = 0; k < 32; ++k) s += pv[k];
        MOD[idx] = s;
    }
}

__device__ __forceinline__ void load_row(f32x4 (&v)[8], const void* base, int f32src, size_t row, int lane) {
    if (f32src) {
#pragma unroll
        for (int j = 0; j < 8; ++j) v[j] = *((const f32x4*)((const float*)base + row * DM) + lane + 64 * j);
    } else {
        u32x2 w[8];
#pragma unroll
        for (int j = 0; j < 8; ++j) w[j] = *((const u32x2*)((const bf16*)base + row * DM) + lane + 64 * j);
#pragma unroll
        for (int j = 0; j < 8; ++j) { v[j].x = __uint_as_float(w[j].x << 16); v[j].y = __uint_as_float(w[j].x & 0xffff0000u); v[j].z = __uint_as_float(w[j].y << 16); v[j].w = __uint_as_float(w[j].y & 0xffff0000u); }
    }
}
__device__ __forceinline__ void norm_phase(const Frame& F, const Args& P, int l, const float* gvec, int ish, int isc, int npart, const float* gate_ctx, const void* rd_lat, int lat_f32, const void* rd_ctx, int ctx_f32, unsigned char* H8) {
    LAS float* ga = (LAS float*)F.lds; LAS float* sh = ga + 2 * DM;
    LAS float* gc = sh + 2 * DM;
    if (npart > 0) for (int i = F.tid; i < DM; i += NTHR) gc[i] = gate_ctx[i];
    const float* MOD = (const float*)((P.ws + F.z) + WS_MOD) + (size_t)l * 2 * 12288;
    for (int i = F.tid; i < 2 * DM; i += NTHR) { const int s = i / DM, c = i % DM; ga[i] = gvec[c] * (1.f + MOD[s * 12288 + isc * DM + c]); sh[i] = MOD[s * 12288 + ish * DM + c]; }
    __syncthreads();
    bf16* X = (bf16*)((P.ws + F.z) + WS_X); bf16* H = (bf16*)((P.ws + F.z) + WS_H); const float* PART = (const float*)((P.ws + F.z) + WS_PART);
    f32x4 vn[8];
    if (F.gw < NR) { if (F.gw < CTXL) load_row(vn, rd_ctx, ctx_f32, F.gw, F.lane); else load_row(vn, rd_lat, lat_f32, F.gw, F.lane); }
    for (int row = F.gw; row < NR; row += F.NGW) {
        const int s = row < CTXL ? 1 : 0;
        f32x4 v[8]; float ss = 0.f;
#pragma unroll
        for (int j = 0; j < 8; ++j) v[j] = vn[j];
        if (row + F.NGW < NR) load_row(vn, rd_lat, lat_f32, row + F.NGW, F.lane);
        if (row < CTXL && npart > 0) {
            u32x2* xr = (u32x2*)(X + (size_t)row * DM) + F.lane;
#pragma unroll
            for (int j = 0; j < 8; ++j) { f32x4 pv[11];
#pragma unroll
                for (int q = 0; q < 11; ++q) pv[q] = q < npart ? *((const f32x4*)(PART + ((size_t)q * 256 + row) * DM) + F.lane + 64 * j) : (f32x4){0.f, 0.f, 0.f, 0.f};
                f32x4 a = pv[0];
#pragma unroll
                for (int q = 1; q < 11; ++q) a = a + pv[q];
                v[j] = v[j] + a * *(const LAS f32x4*)(gc + 4 * F.lane + 256 * j); u32x2 w; w.x = pk2(v[j].x, v[j].y); w.y = pk2(v[j].z, v[j].w); xr[64 * j] = w; }
        }
#pragma unroll
        for (int j = 0; j < 8; ++j) { ss += (v[j].x * v[j].x + v[j].y * v[j].y) + (v[j].z * v[j].z + v[j].w * v[j].w); }
        const float rstd = 1.f / sqrtf(wave_sum(ss) * (1.f / DM) + EPS);
        u32x2* o = (u32x2*)(H + (size_t)row * DM) + F.lane;
#pragma unroll
        for (int j = 0; j < 8; ++j) { const f32x4 g4 = *(const LAS f32x4*)(ga + s * DM + 4 * F.lane + 256 * j), s4 = *(const LAS f32x4*)(sh + s * DM + 4 * F.lane + 256 * j);
            const f32x4 y = v[j] * rstd * g4 + s4;
            u32x2 w; w.x = pk2(y.x, y.y); w.y = pk2(y.z, y.w); o[64 * j] = w;
            if (H8 != nullptr) ((unsigned*)(H8 + (size_t)row * DM))[F.lane + 64 * j] = pk_e4m3(y.x, y.y, y.z, y.w); }
    }
}
__device__ __forceinline__ void final_norm(const Frame& F, const Args& P) {
    const bf16* X = (const bf16*)((P.ws + F.z) + WS_X); const float* g = P.in[I_FNG + F.z];
    f32x4 vn[8];
    if (CTXL + F.gw < NR) load_row(vn, X, 0, CTXL + F.gw, F.lane);
    for (int row = CTXL + F.gw; row < NR; row += F.NGW) {
        f32x4 v[8]; float ss = 0.f;
#pragma unroll
        for (int j = 0; j < 8; ++j) v[j] = vn[j];
        if (row + F.NGW < NR) load_row(vn, X, 0, row + F.NGW, F.lane);
#pragma unroll
        for (int j = 0; j < 8; ++j) ss += (v[j].x * v[j].x + v[j].y * v[j].y) + (v[j].z * v[j].z + v[j].w * v[j].w);
        const float rstd = 1.f / sqrtf(wave_sum(ss) * (1.f / DM) + EPS);
        f32x4* o = (f32x4*)(P.out + (size_t)(row - CTXL) * DM) + F.lane;
#pragma unroll
        for (int j = 0; j < 8; ++j) { const f32x4 g4 = *((const f32x4*)g + F.lane + 64 * j); o[64 * j] = v[j] * rstd * g4; }
    }
}

using pg8::Unit;
__device__ __forceinline__ unsigned q8(float g) { return (unsigned)(g * 255.f + 0.5f); }
struct EpiG1 {
    static constexpr bool PERM = true, AFTER_DRAIN = false;
    bf16* PROJ; bf16* G; const float* bias; int pn_off; float* GST; float gsc;
    __device__ __forceinline__ void operator()(const f32x4 (&acc)[2][2][4][2], const Unit& u0, int wr, int wc, int fr, int fq) const {
        Unit u = u0; u.pn += pn_off;
        const int row0 = u.pm * 256 + wr * 64 + fr;
        if (u.pn < 20) {
            const int col0 = u.pn * 256 + wc * 32 + 8 * fq;
#pragma unroll
            for (int ai = 0; ai < 2; ++ai)
#pragma unroll
                for (int m = 0; m < 4; ++m) { bf16* rowp = PROJ + (size_t)(row0 + ai * 128 + m * 16) * PROJW + col0;
#pragma unroll
                    for (int bj = 0; bj < 2; ++bj) { const f32x4 v0 = acc[ai][bj][m][0], v1 = acc[ai][bj][m][1];
                        u32x4 w; w.x = pg8::cvt_pk_bf16(v0[0], v0[1]); w.y = pg8::cvt_pk_bf16(v0[2], v0[3]); w.z = pg8::cvt_pk_bf16(v1[0], v1[1]); w.w = pg8::cvt_pk_bf16(v1[2], v1[3]);
                        *(u32x4*)(rowp + bj * 128) = w; } }
            if (u.pn == 18 || u.pn == 19) {
#pragma unroll
                for (int ai = 0; ai < 2; ++ai)
#pragma unroll
                    for (int m = 0; m < 4; ++m) { float s = 0.f, s2 = 0.f;
#pragma unroll
                        for (int bj = 0; bj < 2; ++bj)
#pragma unroll
                            for (int n = 0; n < 2; ++n)
#pragma unroll
                                for (int i = 0; i < 4; i += 2) { const unsigned pw = pg8::cvt_pk_bf16(acc[ai][bj][m][n][i], acc[ai][bj][m][n][i + 1]); const float g0 = gelu_tanh(bflo(pw)), g1 = gelu_tanh(bfhi(pw)); s += g0 + g1; s2 += g0 * g0 + g1 * g1; }
                        s += __shfl_xor(s, 16); s += __shfl_xor(s, 32); s2 += __shfl_xor(s2, 16); s2 += __shfl_xor(s2, 32);
                        if (fq == 0) *(f32x2*)(GST + ((size_t)(row0 + ai * 128 + m * 16) * 8 + (u.pn - 18) * 4 + wc) * 2) = (f32x2){s, s2}; }
            }
        } else {
            const int col0 = (u.pn - 20) * 256 + wc * 32 + 8 * fq;
            f32x4 bv[2][2];
#pragma unroll
            for (int bj = 0; bj < 2; ++bj)
#pragma unroll
                for (int n = 0; n < 2; ++n) bv[bj][n] = *(const f32x4*)(bias + col0 + bj * 128 + 4 * n) * -1.4426950408889634f;
#pragma unroll
            for (int ai = 0; ai < 2; ++ai)
#pragma unroll
                for (int m = 0; m < 4; ++m) { unsigned char* rowp = (unsigned char*)G + (size_t)(row0 + ai * 128 + m * 16) * 8192 + col0;
#pragma unroll
                    for (int bj = 0; bj < 2; ++bj) { const f32x4 g0 = sig4_t(acc[ai][bj][m][0] * gsc + bv[bj][0]) * 255.f + 0.5f, g1 = sig4_t(acc[ai][bj][m][1] * gsc + bv[bj][1]) * 255.f + 0.5f;
                        u32x2 w; w.x = (unsigned)g0[0] | ((unsigned)g0[1] << 8) | ((unsigned)g0[2] << 16) | ((unsigned)g0[3] << 24);
                        w.y = (unsigned)g1[0] | ((unsigned)g1[1] << 8) | ((unsigned)g1[2] << 16) | ((unsigned)g1[3] << 24);
                        *(u32x2*)(rowp + bj * 128) = w; } }
        }
    }
};
struct EpiY {
    static constexpr bool PERM = true, AFTER_DRAIN = false;
    bf16* Y;
    __device__ __forceinline__ void operator()(const f32x4 (&acc)[2][2][4][2], const Unit& u, int wr, int wc, int fr, int fq) const {
        const int k = u.pn >> 3; const int row0 = (u.pm - 33 * k) * 256 + wr * 64 + fr, col0 = u.pn * 256 + wc * 32 + 8 * fq;
#pragma unroll
        for (int ai = 0; ai < 2; ++ai)
#pragma unroll
            for (int m = 0; m < 4; ++m) { bf16* rowp = Y + (size_t)(row0 + ai * 128 + m * 16) * 8192 + col0;
#pragma unroll
                for (int bj = 0; bj < 2; ++bj) { const f32x4 v0 = acc[ai][bj][m][0], v1 = acc[ai][bj][m][1];
                    u32x4 w; w.x = pg8::cvt_pk_bf16(v0[0], v0[1]); w.y = pg8::cvt_pk_bf16(v0[2], v0[3]); w.z = pg8::cvt_pk_bf16(v1[0], v1[1]); w.w = pg8::cvt_pk_bf16(v1[2], v1[3]);
                    *(u32x4*)(rowp + bj * 128) = w; } }
    }
};
struct EpiGlu {
    static constexpr bool PERM = true, AFTER_DRAIN = false;
    const bf16* S5Y; bf16* O1;
    __device__ __forceinline__ void operator()(const f32x4 (&acc)[2][2][4][2], const Unit& u, int wr, int wc, int fr, int fq) const {
        const int row0 = u.pm * 256 + wr * 64 + fr, col0 = u.pn * 256 + wc * 32 + 8 * fq;
#pragma unroll
        for (int ai = 0; ai < 2; ++ai)
#pragma unroll
            for (int m = 0; m < 4; ++m) { const size_t ro = (size_t)(row0 + ai * 128 + m * 16) * BW + col0;
#pragma unroll
                for (int bj = 0; bj < 2; ++bj) { const f32x4 v0 = acc[ai][bj][m][0], v1 = acc[ai][bj][m][1];
                    const u32x4 yw = *(const u32x4*)(S5Y + ro + bj * 128); float y[8]; unpack8(yw, y);
                    float o[8];
#pragma unroll
                    for (int i = 0; i < 4; ++i) { o[i] = sigmoid_fast(v0[i]) * y[i]; o[4 + i] = sigmoid_fast(v1[i]) * y[4 + i]; }
                    u32x4 w; w.x = pg8::cvt_pk_bf16(o[0], o[1]); w.y = pg8::cvt_pk_bf16(o[2], o[3]); w.z = pg8::cvt_pk_bf16(o[4], o[5]); w.w = pg8::cvt_pk_bf16(o[6], o[7]);
                    *(u32x4*)(O1 + ro + bj * 128) = w; } }
    }
};
struct EpiRes {
    static constexpr bool PERM = true, AFTER_DRAIN = false;
    bf16* X; const float* g_lat; float* PART; int dry; const void* Xr; int xr_f32;
    template <bool F32>
    __device__ __forceinline__ void latent(const f32x4 (&acc)[2][2][4][2], int row0, int col0) const {
        f32x4 gv[2][2];
#pragma unroll
        for (int bj = 0; bj < 2; ++bj)
#pragma unroll
            for (int n = 0; n < 2; ++n) gv[bj][n] = *(const f32x4*)(g_lat + col0 + bj * 128 + n * 4);
#pragma unroll
        for (int ai = 0; ai < 2; ++ai)
#pragma unroll
            for (int m = 0; m < 4; ++m) { const size_t off = (size_t)(row0 + ai * 128 + m * 16) * DM + col0;
#pragma unroll
                for (int bj = 0; bj < 2; ++bj) { f32x4 x0, x1;
                    if (F32) { const float* p = (const float*)Xr + off + bj * 128; x0 = *(const f32x4*)p; x1 = *(const f32x4*)(p + 4); }
                    else { const u32x4 r = *(const u32x4*)((const bf16*)Xr + off + bj * 128); float a[8]; unpack8(r, a); x0 = (f32x4){a[0], a[1], a[2], a[3]}; x1 = (f32x4){a[4], a[5], a[6], a[7]}; }
                    x0 = x0 + gv[bj][0] * acc[ai][bj][m][0]; x1 = x1 + gv[bj][1] * acc[ai][bj][m][1];
                    u32x4 w; w.x = pg8::cvt_pk_bf16(x0[0], x0[1]); w.y = pg8::cvt_pk_bf16(x0[2], x0[3]); w.z = pg8::cvt_pk_bf16(x1[0], x1[1]); w.w = pg8::cvt_pk_bf16(x1[2], x1[3]);
                    *(u32x4*)(X + off + bj * 128) = w; } }
    }
    __device__ __forceinline__ void operator()(const f32x4 (&acc)[2][2][4][2], const Unit& u, int wr, int wc, int fr, int fq) const {
        const int row0 = u.pm * 256 + wr * 64 + fr, col0 = u.pn * 256 + wc * 32 + 8 * fq;
        if (dry) return;
#ifdef EXP_NOSPLIT
        if (false) {
#else
        if (u.pm == 0) {
#endif
            float* base = PART + (size_t)(u.k0 / (u.nt * 64)) * 256 * DM;
#pragma unroll
            for (int ai = 0; ai < 2; ++ai)
#pragma unroll
                for (int m = 0; m < 4; ++m) { float* rowp = base + (size_t)(row0 + ai * 128 + m * 16) * DM + col0;
#pragma unroll
                    for (int bj = 0; bj < 2; ++bj)
#pragma unroll
                        for (int n = 0; n < 2; ++n) *(f32x4*)(rowp + bj * 128 + n * 4) = acc[ai][bj][m][n]; }
        } else {
            if (xr_f32) latent<true>(acc, row0, col0); else latent<false>(acc, row0, col0);
        }
    }
};
struct EpiFfn1 {
    static constexpr bool PERM = false, AFTER_DRAIN = false;
    bf16* T;
    __device__ __forceinline__ void operator()(const f32x4 (&acc)[2][2][4][2], const Unit& u, int wr, int wc, int fr, int fq) const {
        const int row0 = u.pm * 256 + wr * 64 + fr, col0 = u.pn * 128 + wc * 32 + 8 * fq;
#pragma unroll
        for (int ai = 0; ai < 2; ++ai)
#pragma unroll
            for (int m = 0; m < 4; ++m) { bf16* rowp = T + (size_t)(row0 + ai * 128 + m * 16) * DFF + col0;
                float o[8];
#pragma unroll
                for (int bj = 0; bj < 2; ++bj)
#pragma unroll
                    for (int i = 0; i < 4; ++i) o[4 * bj + i] = 0.f;
#pragma unroll
                for (int bj = 0; bj < 2; ++bj) { const f32x4 a = acc[ai][bj][m][0]; const f32x4 r = (a * acc[ai][bj][m][1]) * sig4_t(a * -1.4426950408889634f); o[4 * bj] = r[0]; o[4 * bj + 1] = r[1]; o[4 * bj + 2] = r[2]; o[4 * bj + 3] = r[3]; }
                u32x4 w; w.x = pg8::cvt_pk_bf16(o[0], o[1]); w.y = pg8::cvt_pk_bf16(o[2], o[3]); w.z = pg8::cvt_pk_bf16(o[4], o[5]); w.w = pg8::cvt_pk_bf16(o[6], o[7]);
                *(u32x4*)rowp = w; }
    }
};
struct YOrder {
    pg8::StaticOrder S; int rows;
    __device__ void init(int G, int c, int rows_) { rows = rows_; S.init(4 * rows_ * 256, DM, BW, G, c); }
    __device__ bool next(int i, Unit& u) const { if (!S.next(i, u)) return false; const int k = u.pm / rows, r = u.pm - k * rows; u.pm = k * 33 + (33 - rows) + r; u.pn += k * 8; return true; }
    __device__ __forceinline__ void a_ready(const Unit&) const {}
    __device__ __forceinline__ void done(const Unit&) const {}
};

struct SplitOrder {
    int G, c, nt_full, nsl, nt_sl, ctx;
    __device__ bool next(int i, Unit& u) const {
        const long L = (long)i * G + c;
        if (L < 256) { const int w = (int)L, x = w & 7, o = w >> 3;
            u.pm = 1 + x * 4 + (o & 3); u.pn = o >> 2; u.k0 = 0; u.nt = nt_full; return true; }
        const int j = (int)(L - 256);
#ifdef EXP_NOSPLIT
        if (ctx && j < 8) { u.pm = 0; u.pn = j; u.k0 = 0; u.nt = nt_full; return true; }
#else
        if (ctx && j < 8 * nsl) { u.pm = 0; u.pn = j & 7; u.k0 = (j >> 3) * nt_sl * 64; u.nt = nt_sl; return true; }
#endif
        return false;
    }
    __device__ __forceinline__ void a_ready(const Unit&) const {}
    __device__ __forceinline__ void done(const Unit&) const {}
};

__device__ __forceinline__ float log2_sigmoid(float x) { return -log1pf(expf(-x)) * 1.4426950408889634f; }
__device__ __forceinline__ float dec_lg(const Frame& F, const Args& P, int l, int dir, int h) { return log2_sigmoid(P.in[I_DECAY + F.z][(l * 2 + dir) * 4 + h]); }

__device__ __forceinline__ int rope_idx(int pos, int j0) { return ((j0 < 32) ? (pos >> 6) : 128 + (pos & 63)) * 32 + (j0 & 31); }
template <bool TRANS>
__device__ __forceinline__ void stage_qk(const Frame& F, const Args& P, LAS bf16* dst, int row0, int sec, int h, float scale) {
    const bf16* PROJ = (const bf16*)((P.ws + F.z) + WS_PROJ); const float* COS = (const float*)((P.ws + F.z) + WS_COS); const float* SIN = (const float*)((P.ws + F.z) + WS_SIN);
    const bool lat = row0 >= CTXL;
    if (!TRANS) {
#pragma unroll
        for (int rep = 0; rep < 2; ++rep) {
            const int w = F.tid + NTHR * rep, t = w >> 3, j0 = (w & 7) * 8;
            const bf16* kp = PROJ + (size_t)(row0 + t) * PROJW + sec * BW + h * 128;
            float a[8], b[8]; unpack8(*(const u32x4*)(kp + j0), a); unpack8(*(const u32x4*)(kp + 64 + j0), b);
            float o1[8], o2[8];
            if (lat) {
                const int pos = row0 + t - CTXL; const int ri = rope_idx(pos, j0); const float* cp = COS + ri; const float* sp = SIN + ri;
#pragma unroll
                for (int e = 0; e < 8; ++e) { const float c = cp[e], s = sp[e]; o1[e] = (a[e] * c - b[e] * s) * scale; o2[e] = (a[e] * s + b[e] * c) * scale; }
            } else {
#pragma unroll
                for (int e = 0; e < 8; ++e) { o1[e] = a[e] * scale; o2[e] = b[e] * scale; }
            }
            *(LAS u32x4*)(dst + t * LDT + j0) = pack8(o1); *(LAS u32x4*)(dst + t * LDT + 64 + j0) = pack8(o2);
        }
    } else {
        const int tp = F.tid >> 3, j0 = (F.tid & 7) * 8, t = 2 * tp;
        const bf16* kp = PROJ + (size_t)(row0 + t) * PROJW + sec * BW + h * 128;
        float a0[8], b0[8], a1[8], b1[8];
        unpack8(*(const u32x4*)(kp + j0), a0); unpack8(*(const u32x4*)(kp + 64 + j0), b0); unpack8(*(const u32x4*)(kp + PROJW + j0), a1); unpack8(*(const u32x4*)(kp + PROJW + 64 + j0), b1);
        if (lat) {
            const int pos = row0 + t - CTXL; const int ri = rope_idx(pos, j0), d1 = rope_idx(pos + 1, j0) - ri; const float* cp = COS + ri; const float* sp = SIN + ri;
#pragma unroll
            for (int e = 0; e < 8; ++e) { const float c0 = cp[e], s0 = sp[e], c1 = cp[d1 + e], s1 = sp[d1 + e];
                const float x0 = a0[e] * c0 - b0[e] * s0, y0 = a0[e] * s0 + b0[e] * c0, x1 = a1[e] * c1 - b1[e] * s1, y1 = a1[e] * s1 + b1[e] * c1;
                a0[e] = x0; b0[e] = y0; a1[e] = x1; b1[e] = y1; }
        }
#pragma unroll
        for (int e = 0; e < 8; ++e) { *(LAS unsigned*)(dst + (j0 + e) * LDT + t) = pk2(a0[e] * scale, a1[e] * scale); *(LAS unsigned*)(dst + (64 + j0 + e) * LDT + t) = pk2(b0[e] * scale, b1[e] * scale); }
    }
}
template <int MODE>
__device__ __forceinline__ void stage_vt(const Frame& F, const Args& P, LAS bf16* dst, LAS bf16* dst2, int row0, int h, float lg, float lg2) {
    const bf16* PROJ = (const bf16*)((P.ws + F.z) + WS_PROJ);
#pragma unroll
    for (int rep = 0; rep < 2; ++rep) {
        const int w = F.tid + NTHR * rep, tp = w >> 4, d0 = (w & 15) * 8, t = 2 * tp;
        const bf16* vp = PROJ + (size_t)(row0 + t) * PROJW + 2 * BW + h * 128 + d0;
        float v0[8], v1[8]; unpack8(*(const u32x4*)vp, v0); unpack8(*(const u32x4*)(vp + PROJW), v1);
        if (MODE == 0) {
#pragma unroll
            for (int e = 0; e < 8; ++e) *(LAS unsigned*)(dst + (d0 + e) * LDT + t) = pk2(v0[e], v1[e]);
        } else {
            const float f0 = exp2f(lg * (float)(127 - t)), f1 = exp2f(lg * (float)(126 - t)), b0 = exp2f(lg2 * (float)t), b1 = exp2f(lg2 * (float)(t + 1));
#pragma unroll
            for (int e = 0; e < 8; ++e) { *(LAS unsigned*)(dst + (d0 + e) * LDT + t) = pk2(v0[e] * f0, v1[e] * f1); *(LAS unsigned*)(dst2 + (d0 + e) * LDT + t) = pk2(v0[e] * b0, v1[e] * b1); }
        }
    }
}

__device__ __forceinline__ void ret_kv_phase(const Frame& F, const Args& P, int l, const int it) {
    LAS bf16* KT = (LAS bf16*)F.lds; LAS bf16* VF = KT + 128 * LDT; LAS bf16* VB = VF + 128 * LDT;
    float* KVT = (float*)((P.ws + F.z) + WS_KVT);
    const int fr = F.lane & 15, fq = F.lane >> 4;
    {
        const int c = it >> 2, h = it & 3, row0 = c * 128;
        __syncthreads();
        stage_qk<true>(F, P, KT, row0, 1, h, 1.f);
        stage_vt<1>(F, P, VF, VB, row0, h, dec_lg(F, P, l, 0, h), dec_lg(F, P, l, 1, h));
        __syncthreads();
        f32x4 af[8], ab[8];
#pragma unroll
        for (int n = 0; n < 8; ++n) { af[n] = (f32x4){0.f, 0.f, 0.f, 0.f}; ab[n] = (f32x4){0.f, 0.f, 0.f, 0.f}; }
        mma_nt<8>(af, VF + 16 * F.wave * LDT, LDT, KT, LDT, 128, F.lane);
        mma_nt<8>(ab, VB + 16 * F.wave * LDT, LDT, KT, LDT, 128, F.lane);
        float* of = KVT + ((((size_t)0 * NCH + c) * 4 + h) * 128 + 16 * F.wave + fr) * 128 + 4 * fq;
        float* ob = KVT + ((((size_t)1 * NCH + c) * 4 + h) * 128 + 16 * F.wave + fr) * 128 + 4 * fq;
#pragma unroll
        for (int n = 0; n < 8; ++n) { *(f32x4*)(of + 16 * n) = af[n]; *(f32x4*)(ob + 16 * n) = ab[n]; }
    }
}
__device__ __forceinline__ int bwd_chunk(int step) { return step < 2 ? 1 - step : NCH + 1 - step; }

__device__ __forceinline__ void s5_pass1(const Frame& F, const Args& P, int l) {
    LAS float* U = (LAS float*)(F.lds + F.wave * 17408);
    const bf16* PROJ = (const bf16*)((P.ws + F.z) + WS_PROJ);
    float2* E = (float2*)((P.ws + F.z) + WS_S5E);
    for (int it = F.gw; it < NCH * 32 * 2; it += F.NGW) {
        const int dir = it & 1, g = (it >> 1) & 31, c = it >> 6;
#pragma unroll
        for (int rr = 0; rr < 2; ++rr) { const int t = F.lane + 64 * rr; const bf16* up = PROJ + (size_t)(c * 128 + t) * PROJW + 4 * BW + g * 16;
            float a[8], b[8]; unpack8(*(const u32x4*)up, a); unpack8(*(const u32x4*)(up + 8), b);
#pragma unroll
            for (int e = 0; e < 8; ++e) { U[t * 16 + e] = a[e]; U[t * 16 + 8 + e] = b[e]; } }
        LDS_WAIT();
        const int idx = ((l * 2 + dir) * 32 + g) * 64 + F.lane;
        const float2 ab = ((const float2*)((P.ws + F.z) + WS_S5AB))[idx];
        float2 bb[16];
#pragma unroll
        for (int k = 0; k < 16; ++k) bb[k] = ((const float2*)((P.ws + F.z) + WS_S5BB))[(size_t)idx * 16 + k];
        float xr = 0.f, xi = 0.f;
        for (int s = 0; s < 128; ++s) {
            const int t = dir ? 127 - s : s;
            float u[16];
#pragma unroll
            for (int q = 0; q < 4; ++q) { const f32x4 uu = *(const LAS f32x4*)(U + t * 16 + 4 * q); u[4 * q] = uu.x; u[4 * q + 1] = uu.y; u[4 * q + 2] = uu.z; u[4 * q + 3] = uu.w; }
            float bur = 0.f, bui = 0.f;
#pragma unroll
            for (int k = 0; k < 16; ++k) { bur += bb[k].x * u[k]; bui += bb[k].y * u[k]; }
            const float nr = ab.x * xr - ab.y * xi + bur, ni = ab.x * xi + ab.y * xr + bui; xr = nr; xi = ni;
        }
        E[((size_t)(dir * NCH + c) * 32 + g) * 64 + F.lane] = make_float2(xr, xi);
        LDS_WAIT();
    }
}
constexpr int S5_LDS = 13312, S5_BUS = 132, S5_XS = 136;
__device__ __forceinline__ void conv_phase(const Frame& F, const Args& P, int l, int rank, int nblk) {
    const bf16* PROJ = (const bf16*)((P.ws + F.z) + WS_PROJ); bf16* O2 = (bf16*)((P.ws + F.z) + WS_O) + (size_t)2 * NR * BW;
    const float* cw = P.in[I_CONVW + F.z] + (size_t)l * 3 * BW;
    for (int idx = rank * NTHR + F.tid; idx < NR * 64; idx += nblk * NTHR) {
        const int row = idx >> 6, ch0 = (idx & 63) * 8;
        const int lo = row < CTXL ? 0 : CTXL, hi = row < CTXL ? CTXL : NR;
        float y[8];
#pragma unroll
        for (int e = 0; e < 8; ++e) y[e] = 0.f;
#pragma unroll
        for (int w = 0; w < 3; ++w) { const int r = row + w - 1;
            if (r >= lo && r < hi) { const bf16* pr = PROJ + (size_t)r * PROJW + ch0; float cx[8], cc[8]; unpack8(*(const u32x4*)(pr + 5 * BW), cx); unpack8(*(const u32x4*)(pr + 7 * BW), cc);
#pragma unroll
                for (int e = 0; e < 8; ++e) y[e] += cw[w * BW + ch0 + e] * (cc[e] * cx[e]); } }
        float cb[8]; unpack8(*(const u32x4*)(PROJ + (size_t)row * PROJW + 6 * BW + ch0), cb);
#pragma unroll
        for (int e = 0; e < 8; ++e) y[e] *= cb[e];
        *(u32x4*)(O2 + (size_t)row * BW + ch0) = pack8(y);
    }
}
__device__ __forceinline__ void gmlp_phase(const Frame& F, const Args& P, int l, const int it) {
    LAS bf16* VT = (LAS bf16*)F.lds; LAS bf16* WSL = VT + 128 * LDT; LAS float* mean = (LAS float*)(F.lds + 2 * 128 * LDT * 2); LAS float* rstd = mean + 128;
    const bf16* PROJ = (const bf16*)((P.ws + F.z) + WS_PROJ); bf16* O3 = (bf16*)((P.ws + F.z) + WS_O) + (size_t)3 * NR * BW;
    const float* lng = P.in[I_LNG + F.z] + (size_t)l * BW; const float* lnb = P.in[I_LNB + F.z] + (size_t)l * BW;
    const int fr = F.lane & 15, fq = F.lane >> 4;
    {
        const int c = it >> 2, g = it & 3, row0 = c * 128;
        __syncthreads();
        if (F.tid < 128) {
            const f32x4* gs = (const f32x4*)((const float*)((P.ws + F.z) + WS_GST) + (size_t)(row0 + F.tid) * 16);
            const f32x4 p0 = gs[0], p1 = gs[1], p2 = gs[2], p3 = gs[3];
            const float s = ((p0[0] + p0[2]) + (p1[0] + p1[2])) + ((p2[0] + p2[2]) + (p3[0] + p3[2])), s2 = ((p0[1] + p0[3]) + (p1[1] + p1[3])) + ((p2[1] + p2[3]) + (p3[1] + p3[3]));
            const float mu = s * (1.f / BW), var = fmaxf(s2 * (1.f / BW) - mu * mu, 0.f);
            mean[F.tid] = mu; rstd[F.tid] = 1.f / sqrtf(var + EPS);
        }
        __syncthreads();
#pragma unroll
        for (int rep = 0; rep < 2; ++rep) { const int w = F.tid + NTHR * rep, tp = w >> 4, ch0 = (w & 15) * 8, t = 2 * tp;
            const bf16* gp = PROJ + (size_t)(row0 + t) * PROJW + 9 * BW + g * 128 + ch0;
            float a0[8], a1[8]; unpack8(*(const u32x4*)gp, a0); unpack8(*(const u32x4*)(gp + PROJW), a1);
            const float mu0 = mean[t], rs0 = rstd[t], mu1 = mean[t + 1], rs1 = rstd[t + 1];
#pragma unroll
            for (int e = 0; e < 8; ++e) { const float lg_ = lng[g * 128 + ch0 + e], lb_ = lnb[g * 128 + ch0 + e];
                *(LAS unsigned*)(VT + (ch0 + e) * LDT + t) = pk2((gelu_tanh(a0[e]) - mu0) * rs0 * lg_ + lb_, (gelu_tanh(a1[e]) - mu1) * rs1 * lg_ + lb_); } }
#pragma unroll
        for (int rep = 0; rep < 4; ++rep) { const int w = F.tid + NTHR * rep, t = w >> 4, ch0 = (w & 15) * 8;
            const bf16* wsg = (const bf16*)((P.ws + F.z) + WS_W + (size_t)l * LW_STRIDE + LW_WS) + (size_t)g * 16384;
            *(LAS u32x4*)(WSL + t * LDT + ch0) = *(const u32x4*)(wsg + t * 128 + ch0); }
        __syncthreads();
        f32x4 acc[8];
#pragma unroll
        for (int n = 0; n < 8; ++n) acc[n] = (f32x4){0.f, 0.f, 0.f, 0.f};
        mma_nt<8>(acc, WSL + 16 * F.wave * LDT, LDT, VT, LDT, 128, F.lane);
        const int q = 16 * F.wave + fr; const float bias = P.in[I_CBS + F.z][((size_t)l * 4 + g) * 128 + q];
#pragma unroll
        for (int n = 0; n < 8; ++n) { const int ch = g * 128 + 16 * n + 4 * fq;
            const u32x2 gw = *(const u32x2*)(PROJ + (size_t)(row0 + q) * PROJW + 8 * BW + ch);
            u32x2 o; o.x = pk2(gelu_tanh(bflo(gw.x)) * (acc[n].x + bias), gelu_tanh(bfhi(gw.x)) * (acc[n].y + bias));
            o.y = pk2(gelu_tanh(bflo(gw.y)) * (acc[n].z + bias), gelu_tanh(bfhi(gw.y)) * (acc[n].w + bias));
            *(u32x2*)(O3 + (size_t)(row0 + q) * BW + ch) = o; }
    }
}
__device__ __forceinline__ void merge_phase(const Frame& F, const Args& P) {
    const unsigned char* G = (const unsigned char*)((P.ws + F.z) + WS_G); const bf16* Y = (const bf16*)((P.ws + F.z) + WS_YP); bf16* M = (bf16*)((P.ws + F.z) + WS_MRG);
#pragma unroll 2
    for (int idx = F.bid * NTHR + F.tid; idx < NR * 256; idx += F.G * NTHR) {
        const int row = idx >> 8, c8 = (idx & 255) * 8;
        float m[8];
#pragma unroll
        for (int e = 0; e < 8; ++e) m[e] = 0.f;
#pragma unroll
        for (int k = 0; k < 4; ++k) { float y[8]; const u32x2 gq = *(const u32x2*)(G + (size_t)row * 8192 + k * DM + c8); unpack8(*(const u32x4*)(Y + (size_t)row * 8192 + k * DM + c8), y);
#pragma unroll
            for (int e = 0; e < 4; ++e) { m[e] += (float)((gq.x >> (8 * e)) & 0xffu) * y[e]; m[4 + e] += (float)((gq.y >> (8 * e)) & 0xffu) * y[4 + e]; } }
#pragma unroll
        for (int e = 0; e < 8; ++e) m[e] *= (1.f / 255.f);
        *(u32x4*)(M + (size_t)row * DM + c8) = pack8(m);
    }
}
__device__ __forceinline__ void scan_phase(const Frame& F, const Args& P, int l) {
    if (F.tid < 16) {
        const float2* E = (const float2*)((P.ws + F.z) + WS_S5E); float2* XS = (float2*)((P.ws + F.z) + WS_S5XS);
        for (int idx = F.bid * 16 + F.tid; idx < 2 * 32 * 64; idx += F.G * 16) {
            const int gp = idx & 2047, dir = idx >> 11;
            const float2 al = ((const float2*)((P.ws + F.z) + WS_S5AL))[(l * 2 + dir) * 2048 + gp];
            float xr = 0.f, xi = 0.f;
#pragma unroll 1
            for (int s0 = 0; s0 < NCH; s0 += 33) {
                float2 e[33]; int o[33];
#pragma unroll
                for (int j = 0; j < 33; ++j) { const int c = dir ? bwd_chunk(s0 + j) : s0 + j; o[j] = (dir * NCH + c) * 2048 + gp; e[j] = E[o[j]]; }
#pragma unroll
                for (int j = 0; j < 33; ++j) { XS[o[j]] = make_float2(xr, xi); const float nr = al.x * xr - al.y * xi + e[j].x, ni = al.x * xi + al.y * xr + e[j].y; xr = nr; xi = ni; }
            }
        }
    }
    const float* KVT = (const float*)((P.ws + F.z) + WS_KVT); bf16* ST = (bf16*)((P.ws + F.z) + WS_ST);
    for (int idx = F.bid * NTHR + F.tid; idx < 2 * 4 * 16384; idx += F.G * NTHR) {
        const int e = idx & 16383, h = (idx >> 14) & 3, dir = idx >> 16;
        const float gch = exp2f(128.f * dec_lg(F, P, l, dir, h));
        float s = 0.f;
#pragma unroll 1
        for (int s0 = 0; s0 < NCH; s0 += 33) {
            float kv[33]; int o[33];
#pragma unroll
            for (int j = 0; j < 33; ++j) { const int c = dir ? bwd_chunk(s0 + j) : s0 + j; o[j] = ((dir * NCH + c) * 4 + h) * 16384 + e; kv[j] = KVT[o[j]]; }
#pragma unroll
            for (int j = 0; j < 33; ++j) { ST[o[j]] = (bf16)f2bf(s); s = gch * s + kv[j]; }
        }
    }
}
__device__ __forceinline__ void ret_out_phase(const Frame& F, const Args& P, int l, const int it) {
    LAS bf16* QS = (LAS bf16*)F.lds; LAS bf16* R1 = QS + 128 * LDT; LAS bf16* R2 = R1 + 128 * LDT;
    const bf16* PROJ = (const bf16*)((P.ws + F.z) + WS_PROJ); const bf16* ST = (const bf16*)((P.ws + F.z) + WS_ST); bf16* O0 = (bf16*)((P.ws + F.z) + WS_O);
    const int fr = F.lane & 15, fq = F.lane >> 4;
    {
        const int c = it >> 2, h = it & 3, row0 = c * 128;
        const float lgf = dec_lg(F, P, l, 0, h), lgb = dec_lg(F, P, l, 1, h);
        __syncthreads();
        stage_qk<false>(F, P, QS, row0, 0, h, 0.08838834764831845f);
#pragma unroll
        for (int rep = 0; rep < 4; ++rep) { const int w = F.tid + NTHR * rep, r = w >> 4, pc = (w & 15) * 8;
            *(LAS u32x4*)(R1 + r * LDT + pc) = *(const u32x4*)(ST + (((size_t)0 * NCH + c) * 4 + h) * 16384 + r * 128 + pc);
            *(LAS u32x4*)(R2 + r * LDT + pc) = *(const u32x4*)(ST + (((size_t)1 * NCH + c) * 4 + h) * 16384 + r * 128 + pc); }
        __syncthreads();
        f32x4 o[8], a2[8];
#pragma unroll
        for (int n = 0; n < 8; ++n) { o[n] = (f32x4){0.f, 0.f, 0.f, 0.f}; a2[n] = (f32x4){0.f, 0.f, 0.f, 0.f}; }
        const LAS bf16* qw = QS + 16 * F.wave * LDT;
        mma_nt<8>(o, qw, LDT, R1, LDT, 128, F.lane);
        mma_nt<8>(a2, qw, LDT, R2, LDT, 128, F.lane);
        const int i = 16 * F.wave + fr;
        { const float cf = exp2f(lgf * (float)(i + 1)), cb = exp2f(lgb * (float)(128 - i));
#pragma unroll
          for (int n = 0; n < 8; ++n) o[n] = o[n] * cf + a2[n] * cb; }
        __syncthreads();
        stage_qk<false>(F, P, R1, row0, 1, h, 1.f);
        stage_vt<0>(F, P, R2, R2, row0, h, 0.f, 0.f);
        __syncthreads();
#pragma unroll
        for (int n = 0; n < 8; ++n) a2[n] = (f32x4){0.f, 0.f, 0.f, 0.f};
        mma_nt<8>(a2, qw, LDT, R1, LDT, 128, F.lane);
#pragma unroll
        for (int n = 0; n < 8; ++n) { float sv[4];
#pragma unroll
            for (int r = 0; r < 4; ++r) { const int j = 16 * n + 4 * fq + r, d = i - j; const float dec = d >= 0 ? exp2f(lgf * (float)d) : exp2f(lgb * (float)(-d)); sv[r] = a2[n][r] * dec; }
            u32x2 w; w.x = pk2(sv[0], sv[1]); w.y = pk2(sv[2], sv[3]);
            *(LAS u32x2*)(QS + (16 * F.wave + fr) * LDT + 16 * n + 4 * fq) = w; }
        LDS_WAIT();
        mma_nt<8>(o, qw, LDT, R2, LDT, 128, F.lane);
        float s = 0.f;
#pragma unroll
        for (int n = 0; n < 8; ++n) s += (o[n].x + o[n].y) + (o[n].z + o[n].w);
        s += __shfl_xor(s, 16); s += __shfl_xor(s, 32);
        const float mu = s * (1.f / 128.f); float s2 = 0.f;
#pragma unroll
        for (int n = 0; n < 8; ++n) { o[n] = o[n] - mu; s2 += (o[n].x * o[n].x + o[n].y * o[n].y) + (o[n].z * o[n].z + o[n].w * o[n].w); }
        s2 += __shfl_xor(s2, 16); s2 += __shfl_xor(s2, 32);
        const float rs = 1.f / sqrtf(s2 * (1.f / 128.f) + EPS);
#pragma unroll
        for (int n = 0; n < 8; ++n) { const int col = h * 128 + 16 * n + 4 * fq;
            const u32x2 gw = *(const u32x2*)(PROJ + (size_t)(row0 + i) * PROJW + 3 * BW + col);
            u32x2 w; w.x = pk2(o[n].x * rs * silu_fast(bflo(gw.x)), o[n].y * rs * silu_fast(bfhi(gw.x))); w.y = pk2(o[n].z * rs * silu_fast(bflo(gw.y)), o[n].w * rs * silu_fast(bfhi(gw.y)));
            *(u32x2*)(O0 + (size_t)(row0 + i) * BW + col) = w; }
    }
}

template <int DIR, bool P1>
__device__ __forceinline__ void s5_p2_dir(const Frame& F, const Args& P, int l, int g, int c, LAS float* BUb, LAS bf16* XBh, const bf16x8 (&ua)[8], const bf16x8 (&cfr)[4], f32x4 (&yacc)[8]) {
    const int lane = F.lane, fr = lane & 15, fq = lane >> 4;
    const bf16* bw = (const bf16*)((P.ws + F.z) + WS_S5BW) + ((size_t)((l * 2 + DIR) * 32 + g) * 128 + fr) * 32 + 8 * fq;
    bf16x8 bfr[8];
#pragma unroll
    for (int nt = 0; nt < 8; ++nt) bfr[nt] = *(const bf16x8*)(bw + nt * 16 * 32);
    const float2 ab = ((const float2*)((P.ws + F.z) + WS_S5AB))[((l * 2 + DIR) * 32 + g) * 64 + lane];
    f32x2 x = (f32x2){0.f, 0.f};
    if (!P1) { const float2 x0 = ((const float2*)((P.ws + F.z) + WS_S5XS))[((size_t)DIR * NCH + c) * 2048 + g * 64 + lane]; x = (f32x2){x0.x, x0.y}; }
    const f32x2 a2 = (f32x2){ab.x, ab.x}, n2 = (f32x2){-ab.y, ab.y};
#pragma unroll
    for (int bs = 0; bs < 8; ++bs) {
        const int b = DIR ? 7 - bs : bs;
        f32x4 d[8];
#pragma unroll
        for (int nt = 0; nt < 8; ++nt) d[nt] = __builtin_amdgcn_mfma_f32_16x16x32_bf16(ua[b], bfr[nt], (f32x4){0.f, 0.f, 0.f, 0.f}, 0, 0, 0);
        __builtin_amdgcn_sched_barrier(0); asm volatile("s_nop 15" ::: "memory"); __builtin_amdgcn_sched_barrier(0);
#pragma unroll
        for (int nt = 0; nt < 8; ++nt)
#pragma unroll
            for (int r = 0; r < 4; ++r) BUb[(4 * fq + r) * S5_BUS + 16 * nt + fr] = d[nt][r];
        LDS_WAIT();
        f32x2 bu[16];
#pragma unroll
        for (int s = 0; s < 16; ++s) bu[s] = *(const LAS f32x2*)(BUb + (DIR ? 15 - s : s) * S5_BUS + 2 * lane);
        LDS_WAIT();
#pragma unroll
        for (int s = 0; s < 16; ++s) { const int tl = DIR ? 15 - s : s;
            const f32x2 t = a2 * x + bu[s]; x = n2 * __builtin_shufflevector(x, x, 1, 0) + t;
            if (!P1) *(LAS unsigned*)(XBh + tl * S5_XS + 2 * lane) = pk2(x[0], x[1]); }
        LDS_WAIT();
        if (!P1) {
#pragma unroll
        for (int ks = 0; ks < 4; ++ks) { const bf16x8 xa = *(const LAS bf16x8*)(XBh + fr * S5_XS + 32 * ks + 8 * fq);
            yacc[b] = __builtin_amdgcn_mfma_f32_16x16x32_bf16(cfr[ks], xa, yacc[b], 0, 0, 0); }
        }
        LDS_WAIT();
    }
    if (P1) ((float2*)((P.ws + F.z) + WS_S5E))[((size_t)(DIR * NCH + c) * 32 + g) * 64 + lane] = make_float2(x[0], x[1]);
}
__device__ __forceinline__ void s5_pass1_fast(const Frame& F, const Args& P, int l, const int jb) {
    LAS float* BUb = (LAS float*)(F.lds + F.wave * S5_LDS); LAS bf16* XBh = (LAS bf16*)(BUb + 16 * S5_BUS);
    const bf16* PROJ = (const bf16*)((P.ws + F.z) + WS_PROJ);
    const int lane = F.lane, fr = lane & 15, fq = lane >> 4;
    __syncthreads();
    { const int it = jb * 8 + F.wave;
        const int g = it & 31, c = it >> 5;
        const bf16* ub = PROJ + (size_t)(c * 128 + fr) * PROJW + 4 * BW + g * 16 + 8 * (fq & 1);
        bf16x8 ua[8];
#pragma unroll
        for (int m = 0; m < 8; ++m) ua[m] = *(const bf16x8*)(ub + (size_t)m * 16 * PROJW);
        bf16x8 cfr[4];
#pragma unroll
        for (int ks = 0; ks < 4; ++ks) cfr[ks] = ua[ks];
        f32x4 yacc[8];
#pragma unroll
        for (int b = 0; b < 8; ++b) yacc[b] = (f32x4){0.f, 0.f, 0.f, 0.f};
        s5_p2_dir<0, true>(F, P, l, g, c, BUb, XBh, ua, cfr, yacc);
        s5_p2_dir<1, true>(F, P, l, g, c, BUb, XBh, ua, cfr, yacc);
    }
}
__device__ __forceinline__ void s5_pass2(const Frame& F, const Args& P, int l, const int jb) {
    LAS float* BUb = (LAS float*)(F.lds + F.wave * S5_LDS); LAS bf16* XBh = (LAS bf16*)(BUb + 16 * S5_BUS);
    const bf16* PROJ = (const bf16*)((P.ws + F.z) + WS_PROJ); bf16* S5Y = (bf16*)((P.ws + F.z) + WS_S5Y);
    const int lane = F.lane, fr = lane & 15, fq = lane >> 4;
    __syncthreads();
    { const int it = jb * 8 + F.wave;
        const int g = it & 31, c = it >> 5;
        const bf16* ub = PROJ + (size_t)(c * 128 + fr) * PROJW + 4 * BW + g * 16 + 8 * (fq & 1);
        bf16x8 ua[8];
#pragma unroll
        for (int m = 0; m < 8; ++m) ua[m] = *(const bf16x8*)(ub + (size_t)m * 16 * PROJW);
        const bf16* cw = (const bf16*)((P.ws + F.z) + WS_S5CW) + ((size_t)(l * 32 + g) * 16 + fr) * 128 + 8 * fq;
        bf16x8 cfr[4];
#pragma unroll
        for (int ks = 0; ks < 4; ++ks) cfr[ks] = *(const bf16x8*)(cw + 32 * ks);
        f32x4 yacc[8];
#pragma unroll
        for (int b = 0; b < 8; ++b) yacc[b] = (f32x4){0.f, 0.f, 0.f, 0.f};
        s5_p2_dir<0, false>(F, P, l, g, c, BUb, XBh, ua, cfr, yacc);
        s5_p2_dir<1, false>(F, P, l, g, c, BUb, XBh, ua, cfr, yacc);
        const f32x4 dd = *(const f32x4*)(P.in[I_S5D + F.z] + (size_t)l * BW + g * 16 + 4 * fq);
#pragma unroll
        for (int b = 0; b < 8; ++b) { const int t = 16 * b + fr;
            const u32x2 uw = *(const u32x2*)(PROJ + (size_t)(c * 128 + t) * PROJW + 4 * BW + g * 16 + 4 * fq);
            u32x2 w; w.x = pk2(gelu_tanh(yacc[b].x + dd.x * bflo(uw.x)), gelu_tanh(yacc[b].y + dd.y * bfhi(uw.x))); w.y = pk2(gelu_tanh(yacc[b].z + dd.z * bflo(uw.y)), gelu_tanh(yacc[b].w + dd.w * bfhi(uw.y)));
            *(u32x2*)(S5Y + (size_t)(c * 128 + t) * BW + g * 16 + 4 * fq) = w; }
    }
}

__device__ __forceinline__ void m1_phase(const Frame& F, const Args& P, int l) {
    constexpr int NB = NCH * 4;
    for (int k = 0; k * F.G < 3 * NB; ++k) {
        const int idx = k * F.G + (F.bid + 64 * k) % F.G;
        if (idx < NB) { const Frame Fi = relaunder(F); gmlp_phase(Fi, P, l, idx); }
        else if (idx < 2 * NB) { const Frame Fi = relaunder(F); ret_kv_phase(Fi, P, l, idx - NB); }
        else if (idx < 3 * NB) { const Frame Fi = relaunder(F); s5_pass1_fast(Fi, P, l, idx - 2 * NB); }
    }
    { const Frame Fi = relaunder(F); conv_phase(Fi, P, l, Fi.bid, Fi.G); }
}
__device__ __forceinline__ void m1_phase_b(const Frame& F, const Args& P, int l) {
    constexpr int NB = NCH * 4; const int goff = (l + 1 < DEPTH) ? 0 : 8;
    for (int k = 0; k < 3; ++k) {
        const int idx = k * 256 + (F.bid + 64 * k) % 256;
        if (idx < NB) { for (int rr = 0; rr < PREPS(52); ++rr) { const Frame Fi = relaunder(F); ret_kv_phase(Fi, P, l, idx); } }
        else if (idx < NB + 240) { for (int rr = 0; rr < PREPS(51); ++rr) { const Frame Fi = relaunder(F); gmlp_phase(Fi, P, l, idx - NB + goff); } }
        else { for (int rr = 0; rr < PREPS(53); ++rr) { const Frame Fi = relaunder(F); s5_pass1_fast(Fi, P, l, idx - 240 - NB); } }
    }
}
__device__ __forceinline__ void m3_phase_b(const Frame& F, const Args& P, int l) {
    const bool last = !(l + 1 < DEPTH); const int skip = last ? 8 : 0, NB = NCH * 4 - skip, tot = 2 * NB + (last ? 0 : 24);
    for (int k = 0; k * 256 < tot; ++k) {
        const int idx = k * 256 + (F.bid + 64 * k) % 256;
        if (idx < NB) { for (int rr = 0; rr < PREPS(54); ++rr) { const Frame Fi = relaunder(F); ret_out_phase(Fi, P, l, idx + skip); } }
        else if (idx < 2 * NB) { for (int rr = 0; rr < PREPS(55); ++rr) { const Frame Fi = relaunder(F); s5_pass2(Fi, P, l, idx - NB + skip); } }
        else if (idx < tot) { const Frame Fi = relaunder(F); gmlp_phase(Fi, P, l, 240 + idx - 2 * NB); }
    }
    if (last) { __syncthreads(); const Frame Fc = relaunder(F); convert_tiles(Fc, P, l, CT_L3B, CT_W2, Fc.gw, Fc.NGW); }
    if (!last) {
        const int b = F.bid;
        if (b < 128 || b >= 168) { const Frame Fi = relaunder(F); conv_phase(Fi, P, l, b < 128 ? b : b - 40, 216);
            __syncthreads(); const Frame Fc = relaunder(F); convert_tiles(Fc, P, l, CT_C, CT_END, (Fc.bid < 128 ? Fc.bid : Fc.bid - 40) * NWAVES + Fc.wave, 216 * NWAVES); }
    }
}
__device__ __forceinline__ void glu_extra_b(const Frame& F, const Args& P, int l) {
    if (F.bid >= 66 && F.bid < 82) { const Frame Fi = relaunder(F); gmlp_phase(Fi, P, l, 248 + Fi.bid - 66); }
    else if (F.bid >= 82) { const Frame Fi = relaunder(F); conv_phase(Fi, P, l, Fi.bid - 82, 174); }
}
__device__ __forceinline__ void m3_phase(const Frame& F, const Args& P, int l) {
    const int skip = (l + 1 < DEPTH) ? 0 : 8, NB = NCH * 4 - skip;
    for (int k = 0; k * F.G < 2 * NB; ++k) {
        const int idx = k * F.G + (F.bid + 64 * k) % F.G;
        if (idx < NB) { const Frame Fi = relaunder(F); ret_out_phase(Fi, P, l, idx + skip); }
        else if (idx < 2 * NB) { const Frame Fi = relaunder(F); s5_pass2(Fi, P, l, idx - NB + skip); }
    }
}
constexpr int NSTEP = 12, NPHASE = 2 + DEPTH * NSTEP + 1;
#ifndef PROBE_KIND
#define PROBE_KIND -1
#endif
#ifdef EXP_NOSPLIT
#define NPART(x) 0
#else
#define NPART(x) (x)
#endif
#define REPS(k) ((PROBE_KIND == (k)) ? 2 : 1)
__global__ void __launch_bounds__(NTHR, 2) mega(Args P) {
    extern __shared__ __attribute__((aligned(16))) unsigned char lds_raw[];
    Frame F0;
    F0.lds = (LAS unsigned char*)lds_raw;
    F0.tid = 0; F0.lane = 0; F0.wave = __builtin_amdgcn_readfirstlane((int)threadIdx.x >> 6);
    F0.G = gridDim.x; F0.bid = blockIdx.x; F0.gw = F0.bid * NWAVES + F0.wave; F0.NGW = F0.G * NWAVES; F0.z = 0;
    volatile LAS unsigned* MISC = (volatile LAS unsigned*)(F0.lds + MISC_OFF);
    if (threadIdx.x < 16) MISC[threadIdx.x] = 0u;
    __syncthreads();
    XcdBarrier bar = xcd_barrier_post((unsigned*)(P.ws + WS_CTL) + 4096, MISC + 8);
    const int lo = P.ph_lo, hi = P.ph_hi;
#define IN(k) (lo <= (k) && (k) < hi)
#define SEAM(k) do { if ((k) + 1 < hi) { for (int rb_ = 0; rb_ < REPS(40); ++rb_) { XcdBarrier b2 = bar; asm volatile("" : "+s"(b2.bar)); xcd_barrier(b2); } } } while (0)
    if (IN(0)) { for (int r = 0; r < REPS(0); ++r) { const Frame F = relaunder(F0); prologue_a(F, P); SEAM(0); } }
    if (IN(1)) { const Frame F = relaunder(F0); prologue_b(F, P); SEAM(1); }
    for (int l = 0; l < DEPTH; ++l) {
        const int pb = 2 + l * NSTEP;
        if (IN(pb + 0)) { for (int r = 0; r < REPS(1); ++r) { const Frame F = relaunder(F0); norm_phase(F, P, l, P.in[I_N1G + F.z] + (size_t)l * DM, 0, 1, NPART(l > 0 ? 11 : 0), (const float*)(P.ws + F.z + WS_MOD) + (size_t)(l > 0 ? l - 1 : 0) * 2 * 12288 + 12288 + 5 * DM, l == 0 ? (const void*)(P.in[I_X + F.z] - (size_t)CTXL * DM) : (const void*)(P.ws + F.z + WS_X), l == 0 ? 1 : 0, l == 0 ? (const void*)P.in[I_CTX + F.z] : (const void*)(P.ws + F.z + WS_X), l == 0 ? 1 : 0, P.ws + F.z + WS_H8); SEAM(pb + 0); } }
        if (IN(pb + 1)) for (int r = 0; r < REPS(6); ++r) {
            const Frame F = relaunder(F0); unsigned char* ws = P.ws + F.z; unsigned char* lw = ws + WS_W + (size_t)l * LW_STRIDE;
            { pg8::Gemm g1{(const bf16*)(ws + WS_H), (const bf16*)(lw + LW_WIN), NR, PROJW, DM}; pg8::StaticOrder S1; S1.init(NR, PROJW, DM, F.G, F.bid);
              EpiG1 E1{(bf16*)(ws + WS_PROJ), (bf16*)(ws + WS_G), P.in[I_BMERGE + F.z] + (size_t)l * 8192, 0, (float*)(ws + WS_GST), -1.4426950408889634f};
              pg8::gemm_phase<EpiG1, pg8::StaticOrder, true, true>(F.lds, g1, S1, E1, F.tid); }
            { const Frame F2 = relaunder(F0); unsigned char* ws2 = P.ws + F2.z; unsigned char* lw2 = ws2 + WS_W + (size_t)l * LW_STRIDE;
              pg8::Gemm g2{(const bf16*)(ws2 + WS_H8), (const bf16*)(lw2 + LW_WM), NR, 8192, DM / 2}; pg8::StaticOrder S2; S2.init(NR, 8192, DM / 2, F2.G, F2.bid);
              EpiG1 E2{(bf16*)(ws2 + WS_PROJ), (bf16*)(ws2 + WS_G), P.in[I_BMERGE + F2.z] + (size_t)l * 8192, 20, (float*)(ws2 + WS_GST), -1.4426950408889634f / 64.f};
              pg8::gemm_phase<EpiG1, pg8::StaticOrder, true, true, true>(F2.lds, g2, S2, E2, F2.tid); }
            SHADOW(148, 0, l < DEPTH - 1 ? CT_R0 : CT_L3A);
            SEAM(pb + 1); }
        if (IN(pb + 2)) for (int r = 0; r < REPS(2); ++r) { const Frame F = relaunder(F0); if (F.G == 256) m1_phase_b(F, P, l); else m1_phase(F, P, l); SEAM(pb + 2); }
        if (IN(pb + 3)) for (int r = 0; r < REPS(3); ++r) { const Frame F = relaunder(F0); scan_phase(F, P, l); SEAM(pb + 3); }
        if (IN(pb + 4)) for (int r = 0; r < REPS(4); ++r) { const Frame F = relaunder(F0); if (F.G == 256) m3_phase_b(F, P, l); else m3_phase(F, P, l); SEAM(pb + 4); }
        if (IN(pb + 5)) for (int r = 0; r < REPS(9); ++r) {
            const Frame F = relaunder(F0); unsigned char* ws = P.ws + F.z; unsigned char* lw = ws + WS_W + (size_t)l * LW_STRIDE;
            pg8::Gemm g{(const bf16*)(ws + WS_S5Y), (const bf16*)(lw + LW_WGLU), NR, BW, BW}; pg8::StaticOrder S; S.init(NR, BW, BW, F.G, F.bid);
            EpiGlu E{(const bf16*)(ws + WS_S5Y), (bf16*)(ws + WS_O) + (size_t)1 * NR * BW};
            pg8::gemm_phase<EpiGlu, pg8::StaticOrder, true, true>(F.lds, g, S, E, F.tid);
            if (l < DEPTH - 1) SHADOW(66, CT_R0, CT_R1);
            else if (F.G == 256) { const Frame Fg = relaunder(F0); glu_extra_b(Fg, P, l); SHADOW(82, CT_L3A, CT_L3B); }
            SEAM(pb + 5); }
        if (IN(pb + 6)) for (int r = 0; r < REPS(7); ++r) {
            const Frame F = relaunder(F0); unsigned char* ws = P.ws + F.z; unsigned char* lw = ws + WS_W + (size_t)l * LW_STRIDE;
            pg8::Gemm g{(const bf16*)(ws + WS_O), (const bf16*)(lw + LW_WB), 4 * NR, 4 * DM, BW}; YOrder S; S.init(F.G, F.bid, l + 1 < DEPTH ? 33 : 32);
            EpiY E{(bf16*)(ws + WS_YP)};
            pg8::gemm_phase<EpiY, YOrder, true, true>(F.lds, g, S, E, F.tid);
            if (l < DEPTH - 1) SHADOW(32, CT_R1, CT_R2);
            SEAM(pb + 6); }
        if (IN(pb + 7)) for (int r = 0; r < REPS(8); ++r) { const Frame F = relaunder(F0); merge_phase(F, P); SEAM(pb + 7); }
        if (IN(pb + 8)) for (int r = 0; r < REPS(10); ++r) {
            const Frame F = relaunder(F0); unsigned char* ws = P.ws + F.z; unsigned char* lw = ws + WS_W + (size_t)l * LW_STRIDE;
            const float* MOD = (const float*)(ws + WS_MOD) + (size_t)l * 2 * 12288;
            pg8::Gemm g{(const bf16*)(ws + WS_MRG), (const bf16*)(lw + LW_WO), NR, DM, DM}; SplitOrder S{F.G, F.bid, DM / 64, 4, 8, l < DEPTH - 1 ? 1 : 0};
            EpiRes E{(bf16*)(ws + WS_X), MOD + 2 * DM, (float*)(ws + WS_PART), (REPS(10) == 2 && r == 0) ? 1 : 0, l == 0 ? (const void*)(P.in[I_X + F.z] - (size_t)CTXL * DM) : (const void*)(ws + WS_X), l == 0 ? 1 : 0};
            pg8::gemm_phase<EpiRes, SplitOrder, true, true>(F.lds, g, S, E, F.tid);
            if (l < DEPTH - 1) SHADOW(32, CT_R2, CT_R3);
            SEAM(pb + 8); }
        if (IN(pb + 9)) { for (int r = 0; r < REPS(1); ++r) { const Frame F = relaunder(F0); norm_phase(F, P, l, P.in[I_N2G + F.z] + (size_t)l * DM, 3, 4, NPART(l < DEPTH - 1 ? 4 : 0), (const float*)(P.ws + F.z + WS_MOD) + (size_t)l * 2 * 12288 + 12288 + 2 * DM, (const void*)(P.ws + F.z + WS_X), 0, l == 0 ? (const void*)P.in[I_CTX + F.z] : (const void*)(P.ws + F.z + WS_X), l == 0 ? 1 : 0, nullptr); SEAM(pb + 9); } }
        if (IN(pb + 10)) for (int r = 0; r < REPS(5); ++r) {
            const Frame F = relaunder(F0); unsigned char* ws = P.ws + F.z; unsigned char* lw = ws + WS_W + (size_t)l * LW_STRIDE;
            pg8::Gemm g{(const bf16*)(ws + WS_H), (const bf16*)(lw + LW_W13), NR, 2 * DFF, DM}; pg8::StaticOrder S; S.init(NR, 2 * DFF, DM, F.G, F.bid);
            EpiFfn1 E{(bf16*)(ws + WS_T)};
            pg8::gemm_phase<EpiFfn1, pg8::StaticOrder, true, true>(F.lds, g, S, E, F.tid);
            if (l < DEPTH - 1) SHADOW(172, CT_R3, CT_R4); else SHADOW(172, CT_W2, CT_WIN);
            SEAM(pb + 10); }
        if (IN(pb + 11)) for (int r = 0; r < REPS(11); ++r) {
            const Frame F = relaunder(F0); unsigned char* ws = P.ws + F.z; unsigned char* lw = ws + WS_W + (size_t)l * LW_STRIDE;
            const float* MOD = (const float*)(ws + WS_MOD) + (size_t)l * 2 * 12288;
            pg8::Gemm g{(const bf16*)(ws + WS_T), (const bf16*)(lw + LW_W2), NR, DM, DFF}; SplitOrder S{F.G, F.bid, DFF / 64, 11, 8, l < DEPTH - 1 ? 1 : 0};
            EpiRes E{(bf16*)(ws + WS_X), MOD + 5 * DM, (float*)(ws + WS_PART), (REPS(11) == 2 && r == 0) ? 1 : 0, (const void*)(ws + WS_X), 0};
            pg8::gemm_phase<EpiRes, SplitOrder, true, true>(F.lds, g, S, E, F.tid);
            if (l < DEPTH - 1) SHADOW(88, CT_R4, CT_C);
            SEAM(pb + 11); }
    }
    if (IN(NPHASE - 1)) { const Frame F = relaunder(F0); final_norm(F, P); }
#undef IN
#undef SEAM
}

#ifndef N_LAUNCH_MODE
#define N_LAUNCH_MODE 1
#endif
extern "C" void kernel_launch(void* const* d_in, const int* in_sizes, int n_in, void* d_out, int out_size, void* d_ws, size_t ws_size, hipStream_t stream) {
    static int grid = 0;
    if (grid == 0) {
        if (n_in != N_IN || out_size != SEQ * DM || ws_size < WS_END) { fprintf(stderr, "kernel_launch: unexpected shapes n_in %d out %d ws %zu (need %zu)\n", n_in, out_size, ws_size, (size_t)WS_END); grid = -1; return; }
        int dev = 0, cus = 0;
        if (hipGetDevice(&dev) != hipSuccess || hipDeviceGetAttribute(&cus, hipDeviceAttributeMultiprocessorCount, dev) != hipSuccess) { grid = -1; return; }
        if (hipFuncSetAttribute((const void*)mega, hipFuncAttributeMaxDynamicSharedMemorySize, LDS_BYTES) != hipSuccess) { fprintf(stderr, "kernel_launch: hipFuncSetAttribute failed\n"); grid = -1; return; }
        int per_cu = 0;
        if (hipOccupancyMaxActiveBlocksPerMultiprocessor(&per_cu, (const void*)mega, NTHR, LDS_BYTES) != hipSuccess || per_cu < 1) fprintf(stderr, "kernel_launch: occupancy query says %d\n", per_cu);
        (void)hipGetLastError();
        grid = cus;
    }
    if (grid < 0) return;
    (void)hipMemsetAsync((char*)d_ws + WS_CTL, 0, CTL_ZERO, stream);
    Args a{};
    for (int i = 0; i < N_IN; ++i) a.in[i] = (const float*)d_in[i];
    a.out = (float*)d_out; a.ws = (unsigned char*)d_ws;
#if N_LAUNCH_MODE == 1
    a.ph_lo = 0; a.ph_hi = NPHASE;
    hipLaunchKernelGGL(mega, dim3(grid), dim3(NTHR), LDS_BYTES, stream, a);
#else
    for (int s = 0; s < NPHASE; ++s) { a.ph_lo = s; a.ph_hi = s + 1; hipLaunchKernelGGL(mega, dim3(grid), dim3(NTHR), LDS_BYTES, stream, a); }
#endif
}
```

```cpp
#include <hip/hip_runtime.h>
#include <cstdio>
#include <cstdint>
#define LAS __attribute__((address_space(3)))
namespace pg8 {
#define PG8_LAS __attribute__((address_space(3)))
typedef unsigned short bf16_t;
typedef short bf16x8 __attribute__((ext_vector_type(8)));
typedef float f32x4 __attribute__((ext_vector_type(4)));
typedef unsigned u32x4 __attribute__((ext_vector_type(4)));
typedef int i32x4 __attribute__((ext_vector_type(4))); typedef int i32x8 __attribute__((ext_vector_type(8)));
constexpr int BM = 256, BK = 64, HALF = 128, HTB = HALF * BK * 2  , STAGE_BYTES = 8 * HTB, NXCD = 8, WGM = 3;

__host__ __device__ __forceinline__ int lds_byte(int r, int c) { const int st = (r >> 4) * 2 + (c >> 5), rr = r & 15, cc = c & 31, ob = rr * 64 + cc * 2; return st * 1024 + (ob ^ (((ob >> 9) & 1) << 5)); }
__host__ __device__ __forceinline__ void stage_rc(int b, int& R, int& C) { const int st = b / 1024, sb = b % 1024, swz = sb ^ (((sb >> 9) & 1) << 5); R = (st >> 1) * 16 + swz / 64; C = (st & 1) * 32 + (swz % 64) / 2; }
__host__ __device__ __forceinline__ int perm32(int rho) { const int n = rho >> 4, i = rho & 15; return 8 * (i >> 2) + 4 * n + (i & 3); }

struct Unit { int pm, pn, k0, nt; };
struct Gemm { const bf16_t* A; const bf16_t* Bt; int M, N, K; };

struct StaticOrder {
    int nM, nN, nwg, G, c, nt;
    __host__ __device__ void init(int M, int N, int K, int G_, int c_) { nM = M / BM; nN = N / BM; nwg = nM * nN; G = G_; c = c_; nt = K / BK; }
    __host__ __device__ bool next(int i, Unit& u) const {
        const long L = (long)i * G + c; if (L >= nwg) return false;
        int wgid = (int)L; { const int q = nwg / NXCD, r = nwg % NXCD, xcd = wgid % NXCD, off = wgid / NXCD; wgid = (xcd < r ? xcd * (q + 1) : r * (q + 1) + (xcd - r) * q) + off; }
        const int nig = WGM * nN, gid = wgid / nig, fm = gid * WGM, gsz = (nM - fm) < WGM ? (nM - fm) : WGM;
        u.pm = fm + ((wgid % nig) % gsz); u.pn = (wgid % nig) / gsz; u.k0 = 0; u.nt = nt; return true;
    }
    __device__ __forceinline__ void a_ready(const Unit&) const {}
    __device__ __forceinline__ void done(const Unit&) const {}
};

typedef float f32x2_cv __attribute__((ext_vector_type(2))); typedef __bf16 bf16x2_cv __attribute__((ext_vector_type(2)));
__device__ __forceinline__ unsigned cvt_pk_bf16(float lo, float hi) { f32x2_cv v = {lo, hi}; bf16x2_cv b = __builtin_convertvector(v, bf16x2_cv); return __builtin_bit_cast(unsigned, b); }
typedef float f32x2 __attribute__((ext_vector_type(2)));
template <class Epi, class Sched, bool ALIGN_EPI = false, bool SP2 = false, bool F8 = false>
__device__ __forceinline__ void gemm_phase(PG8_LAS unsigned char* lds, const Gemm g, const Sched& S, const Epi& E, const int tid_in) {
    int tid_l = tid_in; asm volatile("" : "+v"(tid_l));
    const int tid = tid_l, wid = __builtin_amdgcn_readfirstlane(tid >> 6), lane = tid & 63, wr = wid >> 2, wc = wid & 3, fr = lane & 15, fq = lane >> 4;
    const int K = g.K;
    unsigned voffA[2], voffB[2];
#pragma unroll
    for (int i = 0; i < 2; ++i) { int R, C; stage_rc(tid * 16 + i * 8192, R, C); const int Rb = Epi::PERM ? ((R & ~31) + perm32(R & 31)) : R;
        voffA[i] = (unsigned)(R * K + C) * 2u; voffB[i] = (unsigned)(Rb * K + C) * 2u; }
    const size_t kstep = (size_t)(BK * 2);
    const size_t hstep = (size_t)HALF * K * 2;
    const size_t tstep = 2 * hstep;
    const unsigned ldsw = (unsigned)wid * 1024u;
    const int aoff = lds_byte(wr * 64 + fr, fq * 8), boff = lds_byte(wc * 32 + fr, fq * 8);
#define PG8_SA(b, h) (((b) * 2 + (h)) * HTB)
#define PG8_SB(b, h) ((4 + (b) * 2 + (h)) * HTB)
#define PG8_STAGE(bufoff, gbase, voff) do { _Pragma("unroll") for (int _i = 0; _i < 2; ++_i) \
        __builtin_amdgcn_global_load_lds((const unsigned*)((const char*)(gbase) + (voff)[_i]), (PG8_LAS unsigned*)(lds + (bufoff) + ldsw + _i * 8192), 16, 0, 0); } while (0)
#define PG8_LDA(dst, b, h) do { _Pragma("unroll") for (int m = 0; m < 4; ++m) _Pragma("unroll") for (int k = 0; k < 2; ++k) dst[m][k] = *(const PG8_LAS bf16x8*)(lds + PG8_SA(b, h) + aoff + m * 2048 + k * 1024); } while (0)
#define PG8_LDB(dst, b, h) do { _Pragma("unroll") for (int n = 0; n < 2; ++n) _Pragma("unroll") for (int k = 0; k < 2; ++k) dst[n][k] = *(const PG8_LAS bf16x8*)(lds + PG8_SB(b, h) + boff + n * 2048 + k * 1024); } while (0)
#define PG8_MMA(ai, bj, At, Bt) do { __builtin_amdgcn_s_setprio(1); _Pragma("unroll") for (int m = 0; m < 4; ++m) _Pragma("unroll") for (int n = 0; n < 2; ++n) _Pragma("unroll") for (int k = 0; k < 2; ++k) \
        acc[ai][bj][m][n] = __builtin_amdgcn_mfma_f32_16x16x32_bf16(Bt[n][k], At[m][k], acc[ai][bj][m][n], 0, 0, 0); __builtin_amdgcn_s_setprio(0); } while (0)
#define PG8_MMA8(ai, bj, At, Bt) do { __builtin_amdgcn_s_setprio(1); _Pragma("unroll") for (int m = 0; m < 4; ++m) _Pragma("unroll") for (int n = 0; n < 2; ++n) { \
        const i32x4 a0_ = __builtin_bit_cast(i32x4, At[m][0]), a1_ = __builtin_bit_cast(i32x4, At[m][1]), b0_ = __builtin_bit_cast(i32x4, Bt[n][0]), b1_ = __builtin_bit_cast(i32x4, Bt[n][1]); \
        const i32x8 a8_ = __builtin_shufflevector(a0_, a1_, 0, 1, 2, 3, 4, 5, 6, 7), b8_ = __builtin_shufflevector(b0_, b1_, 0, 1, 2, 3, 4, 5, 6, 7); \
        asm volatile("v_mfma_scale_f32_16x16x128_f8f6f4 %0, %1, %2, %0, %3, %3 op_sel_hi:[0,0,0]" : "+v"(acc[ai][bj][m][n]) : "v"(b8_), "v"(a8_), "v"(sc8_)); } __builtin_amdgcn_s_setprio(0); } while (0)
#define PG8_MM(ai, bj, At, Bt) do { if constexpr (F8) PG8_MMA8(ai, bj, At, Bt); else PG8_MMA(ai, bj, At, Bt); } while (0)
#define PG8_WAIT_V(n) asm volatile("s_waitcnt vmcnt(" #n ")" ::: "memory")
#define PG8_WAIT_L(n) asm volatile("s_waitcnt lgkmcnt(" #n ")" ::: "memory")
#define PG8_BAR __builtin_amdgcn_s_barrier()
#define PG8_SCHED __builtin_amdgcn_sched_barrier(0)
    int sc8_ = 0x7f7f7f7f; asm volatile("" : "+v"(sc8_));
    Unit cur, nxt; int ui = 0;
    if (!S.next(0, cur)) return;
    f32x4 acc[2][2][4][2];
#pragma unroll
    for (int a = 0; a < 2; ++a)
#pragma unroll
        for (int b = 0; b < 2; ++b)
#pragma unroll
            for (int m = 0; m < 4; ++m)
#pragma unroll
                for (int n = 0; n < 2; ++n) acc[a][b][m][n] = (f32x4){0.f, 0.f, 0.f, 0.f};
    bf16x8 At[4][2], B0[2][2], B1[2][2];
    const char* cA = (const char*)g.A + (size_t)cur.pm * tstep + (size_t)cur.k0 * 2; const char* cB = (const char*)g.Bt + (size_t)cur.pn * tstep + (size_t)cur.k0 * 2;
    S.a_ready(cur);
    if constexpr (SP2) {
        PG8_STAGE(PG8_SB(0, 0), cB, voffB); PG8_STAGE(PG8_SB(0, 1), cB + hstep, voffB); PG8_STAGE(PG8_SA(0, 0), cA, voffA); PG8_STAGE(PG8_SA(0, 1), cA + hstep, voffA);
        if (wr == 1) PG8_BAR;
        PG8_WAIT_V(2); PG8_BAR;
        PG8_STAGE(PG8_SB(1, 0), cB + kstep, voffB); PG8_STAGE(PG8_SA(1, 0), cA + kstep, voffA); PG8_STAGE(PG8_SB(1, 1), cB + hstep + kstep, voffB);
        PG8_WAIT_V(6); PG8_BAR;
    } else {
        PG8_STAGE(PG8_SB(0, 0), cB, voffB); PG8_STAGE(PG8_SA(0, 0), cA, voffA); PG8_STAGE(PG8_SB(0, 1), cB + hstep, voffB); PG8_STAGE(PG8_SA(0, 1), cA + hstep, voffA);
        if (wr == 1) PG8_BAR;
        PG8_WAIT_V(4); PG8_BAR;
        PG8_STAGE(PG8_SB(1, 0), cB + kstep, voffB); PG8_STAGE(PG8_SA(1, 0), cA + kstep, voffA); PG8_STAGE(PG8_SB(1, 1), cB + hstep + kstep, voffB);
        PG8_WAIT_V(6); PG8_BAR;
    }
    for (;;) {
        const bool has_next = S.next(ui + 1, nxt);
        const char* nA = has_next ? (const char*)g.A + (size_t)nxt.pm * tstep + (size_t)nxt.k0 * 2 : cA; const char* nB = has_next ? (const char*)g.Bt + (size_t)nxt.pn * tstep + (size_t)nxt.k0 * 2 : cB;
        const int nt = cur.nt;
        for (int t = 0; t < nt; t += 2) {
            const bool last = (t == nt - 2);
            const char* a1 = cA + (size_t)(t + 1) * kstep;
            const char* a2 = last ? nA : cA + (size_t)(t + 2) * kstep; const char* b2 = last ? nB : cB + (size_t)(t + 2) * kstep;
            const char* a3 = a2 + kstep; const char* b3 = b2 + kstep;
            if (last && has_next) S.a_ready(nxt);
            if constexpr (SP2) {
            PG8_LDB(B0, 0, 0); PG8_LDB(B1, 0, 1); PG8_SCHED; PG8_LDA(At, 0, 0); PG8_STAGE(PG8_SA(1, 1), a1 + hstep, voffA);
            PG8_WAIT_V(8); PG8_WAIT_L(0); PG8_BAR; PG8_MM(0, 0, At, B0); PG8_MM(0, 1, At, B1); PG8_BAR; PG8_SCHED;
            PG8_LDA(At, 0, 1); PG8_STAGE(PG8_SB(0, 0), b2, voffB); PG8_STAGE(PG8_SB(0, 1), b2 + hstep, voffB); PG8_STAGE(PG8_SA(0, 0), a2, voffA);
            PG8_WAIT_V(8); PG8_WAIT_L(0); PG8_BAR; PG8_MM(1, 0, At, B0); PG8_MM(1, 1, At, B1); PG8_BAR; PG8_SCHED;
            PG8_LDB(B0, 1, 0); PG8_LDB(B1, 1, 1); PG8_SCHED; PG8_LDA(At, 1, 0); PG8_STAGE(PG8_SA(0, 1), a2 + hstep, voffA);
            PG8_WAIT_V(8); PG8_WAIT_L(0); PG8_BAR; PG8_MM(0, 0, At, B0); PG8_MM(0, 1, At, B1); PG8_BAR; PG8_SCHED;
            PG8_LDA(At, 1, 1); PG8_STAGE(PG8_SB(1, 0), b3, voffB); PG8_STAGE(PG8_SB(1, 1), b3 + hstep, voffB); PG8_STAGE(PG8_SA(1, 0), a3, voffA);
            PG8_WAIT_V(8); PG8_WAIT_L(0); PG8_BAR; PG8_MM(1, 0, At, B0); PG8_MM(1, 1, At, B1); PG8_BAR; PG8_SCHED;
            } else {
            PG8_LDB(B0, 0, 0); PG8_SCHED; PG8_LDA(At, 0, 0); PG8_STAGE(PG8_SA(1, 1), a1 + hstep, voffA);
            PG8_WAIT_L(8); PG8_BAR; PG8_WAIT_L(0); PG8_MM(0, 0, At, B0); PG8_BAR; PG8_SCHED;
            PG8_LDB(B1, 0, 1); PG8_STAGE(PG8_SB(0, 0), b2, voffB);
            PG8_BAR; PG8_WAIT_L(0); PG8_MM(0, 1, At, B1); PG8_BAR;
            PG8_LDA(At, 0, 1); PG8_STAGE(PG8_SA(0, 0), a2, voffA);
            PG8_BAR; PG8_WAIT_L(0); PG8_MM(1, 0, At, B0); PG8_BAR; PG8_SCHED;
            PG8_STAGE(PG8_SB(0, 1), b2 + hstep, voffB);
            PG8_WAIT_V(6); PG8_BAR; PG8_MM(1, 1, At, B1); PG8_BAR;
            PG8_LDB(B0, 1, 0); PG8_SCHED; PG8_LDA(At, 1, 0); PG8_STAGE(PG8_SA(0, 1), a2 + hstep, voffA);
            PG8_WAIT_L(8); PG8_BAR; PG8_WAIT_L(0); PG8_MM(0, 0, At, B0); PG8_BAR; PG8_SCHED;
            PG8_LDB(B1, 1, 1); PG8_STAGE(PG8_SB(1, 0), b3, voffB);
            PG8_BAR; PG8_WAIT_L(0); PG8_MM(0, 1, At, B1); PG8_BAR;
            PG8_LDA(At, 1, 1); PG8_STAGE(PG8_SA(1, 0), a3, voffA);
            PG8_BAR; PG8_WAIT_L(0); PG8_MM(1, 0, At, B0); PG8_BAR; PG8_SCHED;
            PG8_STAGE(PG8_SB(1, 1), b3 + hstep, voffB);
            PG8_WAIT_V(6); PG8_BAR; PG8_MM(1, 1, At, B1); PG8_BAR;
            }
        }
        if constexpr (ALIGN_EPI) { if (wr == 0) PG8_BAR; }
        if constexpr (!Epi::AFTER_DRAIN) { E(acc, cur, wr, wc, fr, fq); S.done(cur); }
        if (!has_next) break;
#pragma unroll
        for (int a = 0; a < 2; ++a)
#pragma unroll
            for (int b = 0; b < 2; ++b)
#pragma unroll
                for (int m = 0; m < 4; ++m)
#pragma unroll
                    for (int n = 0; n < 2; ++n) acc[a][b][m][n] = (f32x4){0.f, 0.f, 0.f, 0.f};
        cur = nxt; cA = nA; cB = nB; ++ui;
        if constexpr (ALIGN_EPI) { if (wr == 1) PG8_BAR; }
    }
    PG8_WAIT_V(0);
    if constexpr (!ALIGN_EPI) { if (wr == 0) PG8_BAR; }
    PG8_BAR;
    if constexpr (Epi::AFTER_DRAIN) { E.fused(acc, cur, wr, wc, fr, fq, lds, wid, lane); S.done(cur); }
#undef PG8_SA
#undef PG8_SB
#undef PG8_STAGE
#undef PG8_LDA
#undef PG8_LDB
#undef PG8_MMA
#undef PG8_MMA8
#undef PG8_MM
#undef PG8_WAIT_V
#undef PG8_WAIT_L
#undef PG8_BAR
#undef PG8_SCHED
}
}
#define XB_TMO      128
#define XB_XCNT(j)  (256  + 64 * (j))
#define XB_XSUB(j)  (1280 + 64 * (j))
#define XB_XGEN(j)  (2304 + 64 * (j))
#define XB_TOP      3328
#define XB_TOPGEN   3392
#define XCD_BAR_WORDS 3456
#define XB_SPIN_CAP (1u << 18)

__device__ __forceinline__ unsigned xb_ld(unsigned* p)              { return __hip_atomic_load(p, __ATOMIC_RELAXED, __HIP_MEMORY_SCOPE_AGENT); }
__device__ __forceinline__ unsigned xb_add(unsigned* p, unsigned v) { return __hip_atomic_fetch_add(p, v, __ATOMIC_RELAXED, __HIP_MEMORY_SCOPE_AGENT); }
__device__ __forceinline__ unsigned xb_xcc_id() { return (unsigned)__builtin_amdgcn_s_getreg((3 << 11) | 20) & 0xFu; }
#define XB_SPIN(cond, bar) do { unsigned _sp = 0; while (cond) { __builtin_amdgcn_s_sleep(1); \
    if ((++_sp & 255u) == 0u) { if (xb_ld(&(bar)[XB_TMO])) break; if (_sp > XB_SPIN_CAP) { atomicAdd(&(bar)[XB_TMO], 1u); break; } } } } while (0)

struct XcdBarrier {
    unsigned* bar; unsigned x; unsigned w;
    volatile LAS unsigned* st;
};

__device__ __forceinline__ XcdBarrier xcd_barrier_post(unsigned* bar, volatile LAS unsigned* st) {
    XcdBarrier b; b.bar = bar; b.x = xb_xcc_id(); b.st = st; b.w = (unsigned)__builtin_amdgcn_readfirstlane((int)(threadIdx.x >> 6));
    if (threadIdx.x == 0) (void)xb_add(&bar[XB_XCNT(b.x)], 1u);
    return b;
}
__device__ __forceinline__ void xcd_barrier_complete(unsigned* bar, unsigned x, unsigned& nloc, unsigned& nx) {
    const unsigned G = gridDim.x * gridDim.y * gridDim.z;
    unsigned sum, cnt, mine, sp = 0u;
    for (;;) {
        sum = 0u; cnt = 0u; mine = 0u;
#pragma unroll
        for (unsigned j = 0; j < 16; ++j) { const unsigned c = xb_ld(&bar[XB_XCNT(j)]); sum += c; cnt += (c > 0u) ? 1u : 0u; mine = (j == x) ? c : mine; }
        if (sum == G) break;
        __builtin_amdgcn_s_sleep(1);
        if ((++sp & 255u) == 0u) { if (xb_ld(&bar[XB_TMO])) break; if (sp > XB_SPIN_CAP) { atomicAdd(&bar[XB_TMO], 1u); break; } }
    }
    nloc = mine > 0u ? mine : 1u; nx = cnt > 0u ? cnt : 1u;
}

__device__ __forceinline__ void xcd_barrier(const XcdBarrier& b) {
    asm volatile("s_waitcnt vmcnt(0)" ::: "memory");
    __syncthreads();
    if (b.w == 0u && __builtin_amdgcn_mbcnt_hi(~0u, __builtin_amdgcn_mbcnt_lo(~0u, 0u)) == 0u) {
        unsigned* bar = b.bar;
        __builtin_amdgcn_s_waitcnt(0);
        unsigned nloc = b.st[0], nx = b.st[1];
        if (nloc == 0u) { xcd_barrier_complete(bar, b.x, nloc, nx); b.st[0] = nloc; b.st[1] = nx; }
        const unsigned old = xb_add(&bar[XB_XSUB(b.x)], 1u);
        const unsigned gen = old / nloc;
        if (old + 1u == (gen + 1u) * nloc) {
            __builtin_amdgcn_fence(__ATOMIC_RELEASE, "agent");
            asm volatile("s_waitcnt vmcnt(0)" ::: "memory");
            const unsigned og = xb_add(&bar[XB_TOP], 1u);
            const unsigned tg = og / nx;
            if (og + 1u == (tg + 1u) * nx) xb_add(&bar[XB_TOPGEN], 1u);
            else XB_SPIN(xb_ld(&bar[XB_TOPGEN]) == tg, bar);
            __builtin_amdgcn_fence(__ATOMIC_ACQUIRE, "agent");
            xb_add(&bar[XB_XGEN(b.x)], 1u);
            asm volatile("s_waitcnt vmcnt(0)" ::: "memory");
        } else {
            XB_SPIN(xb_ld(&bar[XB_XGEN(b.x)]) == gen, bar);
            __builtin_amdgcn_fence(__ATOMIC_ACQUIRE, "agent");
            asm volatile("s_waitcnt vmcnt(0)" ::: "memory");
        }
    }
    __syncthreads();
}

typedef unsigned short bf16;
typedef short bf16x8 __attribute__((ext_vector_type(8)));
typedef float f32x4 __attribute__((ext_vector_type(4)));
typedef unsigned u32x4 __attribute__((ext_vector_type(4)));
typedef unsigned u32x2 __attribute__((ext_vector_type(2)));
typedef float f32x2 __attribute__((ext_vector_type(2)));

constexpr int DM = 2048, SEQ = 8192, CTXL = 256, NR = SEQ + CTXL, DEPTH = 4, BW = 512, PROJW = 5120, DFF = 5632;
constexpr int NCH = NR / 128;
constexpr float EPS = 1e-6f;
constexpr int NWAVES = 8, NTHR = 512;
constexpr int LDT = 136;

constexpr size_t WS_CTL = 0, CTL_BYTES = 1u << 20, CTL_ZERO = 32768;
constexpr size_t LW_WIN = 0;
constexpr size_t LW_WM  = LW_WIN + (size_t)PROJW * DM * 2;
constexpr size_t LW_WB  = LW_WM + (size_t)8192 * DM * 2;
constexpr size_t LW_WO  = LW_WB + (size_t)4 * DM * BW * 2;
constexpr size_t LW_W13 = LW_WO + (size_t)DM * DM * 2;
constexpr size_t LW_W2  = LW_W13 + (size_t)2 * DFF * DM * 2;
constexpr size_t LW_WGLU = LW_W2 + (size_t)DM * DFF * 2;
constexpr size_t LW_WS  = LW_WGLU + (size_t)BW * BW * 2;
constexpr size_t LW_STRIDE = LW_WS + (size_t)4 * 128 * 128 * 2;
constexpr size_t WS_W = CTL_BYTES;
constexpr size_t WS_X = WS_W + DEPTH * LW_STRIDE;
constexpr size_t WS_H = WS_X + (size_t)NR * DM * 4;
constexpr size_t WS_PROJ = WS_H + (size_t)NR * DM * 2;
constexpr size_t WS_O = WS_PROJ + (size_t)NR * PROJW * 2;
constexpr size_t WS_YP = WS_O + (size_t)4 * NR * BW * 2;
constexpr size_t WS_T = WS_YP;
constexpr size_t WS_G = WS_YP + (size_t)NR * 8192 * 2;
constexpr size_t WS_MRG = WS_G + (size_t)NR * 8192 * 2;
constexpr size_t WS_PART = WS_MRG + (size_t)NR * DM * 2;
constexpr size_t WS_S5Y = WS_PART + (size_t)11 * 256 * DM * 4;
constexpr size_t WS_KVT = WS_S5Y + (size_t)NR * BW * 2;
constexpr size_t WS_ST = WS_KVT + (size_t)2 * NCH * 4 * 16384 * 4;
constexpr size_t WS_S5E = WS_ST + (size_t)2 * NCH * 4 * 16384 * 2;
constexpr size_t WS_S5XS = WS_S5E + (size_t)2 * NCH * 32 * 64 * 8;
constexpr size_t WS_MODP = WS_S5XS + (size_t)2 * NCH * 32 * 64 * 8;
constexpr size_t WS_MOD = WS_MODP + (size_t)32 * 4 * 2 * 12288 * 4;
constexpr size_t WS_COS = WS_MOD + (size_t)4 * 2 * 12288 * 4;
constexpr size_t WS_SIN = WS_COS + (size_t)SEQ * 64 * 4;
constexpr size_t WS_S5AB = WS_SIN + (size_t)SEQ * 64 * 4;
constexpr size_t WS_S5AL = WS_S5AB + (size_t)4 * 2 * 32 * 64 * 8;
constexpr size_t WS_S5BW = WS_S5AL + (size_t)4 * 2 * 32 * 64 * 8;
constexpr size_t WS_S5CW = WS_S5BW + (size_t)4 * 2 * 32 * 128 * 32 * 2;
constexpr size_t WS_S5BB = WS_S5CW + (size_t)4 * 32 * 16 * 128 * 2;
constexpr size_t WS_GST = WS_S5BB + (size_t)4 * 2 * 32 * 64 * 16 * 8;
constexpr size_t WS_H8 = WS_GST + (size_t)NR * 8 * 8;
constexpr size_t WS_END = WS_H8 + (size_t)NR * DM;

constexpr int MISC_OFF = 143360, LDS_BYTES = 147456;

enum { I_X = 0, I_C, I_CTX, I_CCTX, I_ADAW, I_ADAB, I_N1G, I_N2G, I_WIN, I_DECAY, I_S5ARE, I_S5AIM, I_S5BRE, I_S5BIM, I_S5CRE, I_S5CIM, I_S5D, I_S5LDT,
       I_WGLU, I_CONVW, I_LNG, I_LNB, I_CWS, I_CBS, I_WBR, I_WMERGE, I_BMERGE, I_WOUT, I_W1, I_W3, I_W2, I_FNG, N_IN };

struct Args { const float* in[N_IN]; float* out; unsigned char* ws; int ph_lo, ph_hi; };

struct Frame { LAS unsigned char* lds; int tid, lane, wave, G, gw, NGW, bid, z; };
__device__ __forceinline__ int lane_id() { return (int)__builtin_amdgcn_mbcnt_hi(~0u, __builtin_amdgcn_mbcnt_lo(~0u, 0u)); }
__device__ __forceinline__ Frame relaunder(const Frame& F0) { Frame F = F0; int w = F0.wave, z = 0, b = F0.bid, g = F0.G; asm volatile("" : "+s"(w), "+s"(z), "+s"(b), "+s"(g)); int ln = lane_id(); asm volatile("" : "+v"(ln)); F.wave = w; F.lane = ln; F.tid = w * 64 + ln; F.z = z; F.bid = b; F.G = g; F.gw = b * 8 + w; F.NGW = g * 8; return F; }

#define LDS_WAIT() asm volatile("s_waitcnt lgkmcnt(0)" ::: "memory")

__device__ __forceinline__ unsigned f2bf(float f) { unsigned u = __builtin_bit_cast(unsigned, f); return (u + 0x7fffu + ((u >> 16) & 1u)) >> 16; }
__device__ __forceinline__ unsigned pk2(float lo, float hi) { return pg8::cvt_pk_bf16(lo, hi); }
__device__ __forceinline__ float bflo(unsigned w) { return __builtin_bit_cast(float, w << 16); }
__device__ __forceinline__ float bfhi(unsigned w) { return __builtin_bit_cast(float, w & 0xffff0000u); }
__device__ __forceinline__ float bf2f(bf16 b) { return __builtin_bit_cast(float, (unsigned)b << 16); }
__device__ __forceinline__ void unpack8(const u32x4 w, float (&f)[8]) {
    f[0] = bflo(w.x); f[1] = bfhi(w.x); f[2] = bflo(w.y); f[3] = bfhi(w.y); f[4] = bflo(w.z); f[5] = bfhi(w.z); f[6] = bflo(w.w); f[7] = bfhi(w.w); }
__device__ __forceinline__ u32x4 pack8(const float (&f)[8]) { u32x4 w; w.x = pk2(f[0], f[1]); w.y = pk2(f[2], f[3]); w.z = pk2(f[4], f[5]); w.w = pk2(f[6], f[7]); return w; }
__device__ __forceinline__ float wave_sum(float v) {
#pragma unroll
    for (int o = 1; o < 64; o <<= 1) v += __shfl_xor(v, o);
    return v;
}
__device__ __forceinline__ float sigmoid_fast(float x) { return __builtin_amdgcn_rcpf(1.f + __builtin_amdgcn_exp2f(-1.4426950408889634f * x)); }
__device__ __forceinline__ float silu_fast(float x) { return x * sigmoid_fast(x); }
__device__ __forceinline__ f32x4 sig4_t(const f32x4 t) { f32x4 e; e[0] = __builtin_amdgcn_exp2f(t[0]); e[1] = __builtin_amdgcn_exp2f(t[1]); e[2] = __builtin_amdgcn_exp2f(t[2]); e[3] = __builtin_amdgcn_exp2f(t[3]);
    const f32x4 d = e + 1.f; f32x4 r; r[0] = __builtin_amdgcn_rcpf(d[0]); r[1] = __builtin_amdgcn_rcpf(d[1]); r[2] = __builtin_amdgcn_rcpf(d[2]); r[3] = __builtin_amdgcn_rcpf(d[3]); return r; }
__device__ __forceinline__ float gelu_tanh(float x) { const float t = x * (x * x * -0.10294324f + -2.3022082f); return x * __builtin_amdgcn_rcpf(1.f + __builtin_amdgcn_exp2f(t)); }
__device__ __forceinline__ float silu_acc(float x) { return x / (1.f + expf(-x)); }

template <int NT>
__device__ __forceinline__ void mma_nt(f32x4 (&acc)[NT], const LAS bf16* A, int lda, const LAS bf16* Bt, int ldb, int K, int lane) {
    const int fr = lane & 15, fq = lane >> 4;
    const LAS bf16* ap = A + fr * lda + 8 * fq;
    const LAS bf16* bp = Bt + fr * ldb + 8 * fq;
    for (int k0 = 0; k0 < K; k0 += 32) {
        const bf16x8 a = *(const LAS bf16x8*)(ap + k0);
#pragma unroll
        for (int n = 0; n < NT; ++n) {
            const bf16x8 b = *(const LAS bf16x8*)(bp + n * 16 * ldb + k0);
            acc[n] = __builtin_amdgcn_mfma_f32_16x16x32_bf16(b, a, acc[n], 0, 0, 0);
        }
    }
}

#ifndef PROBE_KIND
#define PROBE_KIND -1
#endif
#define PREPS(k) ((PROBE_KIND == (k)) ? 2 : 1)
struct RowId { __device__ __forceinline__ int operator()(int n) const { return n; } };
template <int M> struct RowW13 { __device__ __forceinline__ int operator()(int n) const { const int pn = n >> 7, o = n & 127; const int wc = o >> 5, fq = (o >> 3) & 3, bj = (o >> 2) & 1, i = o & 3;
    return 256 * pn + 128 * bj + 32 * wc + 16 * M + 4 * fq + i; } };
template <class RowMap>
__device__ __forceinline__ void transpose2(const Frame& F, const float* src, size_t ldsrc, int K, int N, bf16* dst, int ld_dst, const RowMap rm, int lo, int hi, int wid, int nw) {
    LAS bf16* t = (LAS bf16*)(F.lds + F.wave * 16384);
    const int nblk = N / 64, lane = F.lane, q = lane >> 4, n4 = 4 * (lane & 15);
    for (int it = lo + wid; it < hi; it += nw) {
        const int kb = it / nblk, nb = it % nblk, k0 = 64 * kb, n0 = 64 * nb;
        const float* sp = src + (size_t)(k0 + 16 * q) * ldsrc + n0 + n4;
        f32x4 v[16];
#pragma unroll
        for (int r = 0; r < 16; ++r) v[r] = *(const f32x4*)(sp + (size_t)r * ldsrc);
#pragma unroll
        for (int rq = 0; rq < 4; ++rq)
#pragma unroll
            for (int j = 0; j < 4; ++j) { u32x2 w; w.x = pk2(v[4 * rq][j], v[4 * rq + 1][j]); w.y = pk2(v[4 * rq + 2][j], v[4 * rq + 3][j]);
                *(LAS u32x2*)(t + (n4 + j) * 72 + 16 * q + 4 * rq) = w; }
        LDS_WAIT();
#pragma unroll
        for (int j = 0; j < 8; ++j) { const int n = (lane >> 3) + 8 * j, c = lane & 7;
            *(u32x4*)(dst + (size_t)rm(n0 + n) * ld_dst + k0 + 8 * c) = *(const LAS u32x4*)(t + n * 72 + 8 * c); }
        LDS_WAIT();
    }
}

__device__ __forceinline__ unsigned pk_e4m3(float a, float b, float c, float d) { int w = __builtin_amdgcn_cvt_pk_fp8_f32(a, b, 0, false); w = __builtin_amdgcn_cvt_pk_fp8_f32(c, d, w, true); return (unsigned)w; }
__device__ __forceinline__ void transpose8(const Frame& F, const float* src, size_t ldsrc, int K, int N, unsigned char* dst, int ld_dst, float scale, int lo, int hi, int wid, int nw) {
    LAS unsigned char* t = (LAS unsigned char*)(F.lds + F.wave * 16384);
    const int nblk = N / 64, lane = F.lane, q = lane >> 4, n4 = 4 * (lane & 15);
    for (int it = lo + wid; it < hi; it += nw) {
        const int kb = it / nblk, nb = it % nblk, k0 = 64 * kb, n0 = 64 * nb;
        const float* sp = src + (size_t)(k0 + 16 * q) * ldsrc + n0 + n4;
        f32x4 v[16];
#pragma unroll
        for (int r = 0; r < 16; ++r) v[r] = *(const f32x4*)(sp + (size_t)r * ldsrc) * scale;
#pragma unroll
        for (int j = 0; j < 4; ++j) { u32x4 w;
            w.x = pk_e4m3(v[0][j], v[1][j], v[2][j], v[3][j]); w.y = pk_e4m3(v[4][j], v[5][j], v[6][j], v[7][j]); w.z = pk_e4m3(v[8][j], v[9][j], v[10][j], v[11][j]); w.w = pk_e4m3(v[12][j], v[13][j], v[14][j], v[15][j]);
            *(LAS u32x4*)(t + (n4 + j) * 80 + 16 * q) = w; }
        LDS_WAIT();
#pragma unroll
        for (int c = 0; c < 4; ++c) *(u32x4*)(dst + (size_t)(n0 + lane) * ld_dst + k0 + 16 * c) = *(const LAS u32x4*)(t + lane * 80 + 16 * c);
        LDS_WAIT();
    }
}
constexpr int CT_WB = 0, CT_WO = CT_WB + 4 * 8 * 32, CT_W1 = CT_WO + 32 * 32, CT_W3 = CT_W1 + 32 * 88, CT_W2 = CT_W3 + 32 * 88, CT_WIN = CT_W2 + 88 * 32, CT_WM = CT_WIN + 32 * 80, CT_WG = CT_WM + 32 * 128, CT_END = CT_WG + 64;
__device__ __forceinline__ void convert_tiles(const Frame& F, const Args& P, int l, int a, int b, int wid, int nw) {
#define CT_SEG(off, cnt, call) do { const int lo_ = (a > (off) ? a : (off)) - (off), hi_ = (b < (off) + (cnt) ? b : (off) + (cnt)) - (off); if (lo_ < hi_) { const int lo = lo_, hi = hi_; call; } } while (0)
    if (l >= 0 && a < CT_WIN) {
        unsigned char* lw = (P.ws + F.z) + WS_W + (size_t)l * LW_STRIDE;
#pragma unroll 1
        for (int k = 0; k < 4; ++k)
            CT_SEG(CT_WB + k * 256, 256, transpose2(F, P.in[I_WBR + F.z] + ((size_t)l * 4 + k) * BW * DM, DM, BW, DM, (bf16*)(lw + LW_WB) + (size_t)k * DM * BW, BW, RowId{}, lo, hi, wid, nw));
        CT_SEG(CT_WO, 32 * 32, transpose2(F, P.in[I_WOUT + F.z] + (size_t)l * DM * DM, DM, DM, DM, (bf16*)(lw + LW_WO), DM, RowId{}, lo, hi, wid, nw));
        CT_SEG(CT_W1, 32 * 88, transpose2(F, P.in[I_W1 + F.z] + (size_t)l * DM * DFF, DFF, DM, DFF, (bf16*)(lw + LW_W13), DM, RowW13<0>{}, lo, hi, wid, nw));
        CT_SEG(CT_W3, 32 * 88, transpose2(F, P.in[I_W3 + F.z] + (size_t)l * DM * DFF, DFF, DM, DFF, (bf16*)(lw + LW_W13), DM, RowW13<1>{}, lo, hi, wid, nw));
        CT_SEG(CT_W2, 88 * 32, transpose2(F, P.in[I_W2 + F.z] + (size_t)l * DFF * DM, DM, DFF, DM, (bf16*)(lw + LW_W2), DFF, RowId{}, lo, hi, wid, nw));
    }
    if (l + 1 < DEPTH && b > CT_WIN) {
        const int l1 = l + 1; unsigned char* lw = (P.ws + F.z) + WS_W + (size_t)l1 * LW_STRIDE;
        CT_SEG(CT_WIN, 32 * 80, transpose2(F, P.in[I_WIN + F.z] + (size_t)l1 * DM * PROJW, PROJW, DM, PROJW, (bf16*)(lw + LW_WIN), DM, RowId{}, lo, hi, wid, nw));
        CT_SEG(CT_WM, 32 * 128, transpose8(F, P.in[I_WMERGE + F.z] + (size_t)l1 * DM * 8192, 8192, DM, 8192, lw + LW_WM, DM, 64.f, lo, hi, wid, nw));
        CT_SEG(CT_WG, 64, transpose2(F, P.in[I_WGLU + F.z] + (size_t)l1 * BW * BW, BW, BW, BW, (bf16*)(lw + LW_WGLU), BW, RowId{}, lo, hi, wid, nw));
    }
#undef CT_SEG
}
#ifndef CT_G1P
#define CT_G1P 4816
#endif
#ifndef CT_GLU
#define CT_GLU 2200
#endif
#ifndef CT_YP
#define CT_YP 1800
#endif
#ifndef CT_WOP
#define CT_WOP 2600
#endif
#ifndef CT_F1P
#define CT_F1P 3800
#endif
#ifndef CT_F2P
#define CT_F2P 2000
#endif
constexpr int CT_R0 = CT_G1P, CT_R1 = CT_R0 + CT_GLU, CT_R2 = CT_R1 + CT_YP, CT_R3 = CT_R2 + CT_WOP, CT_R4 = CT_R3 + CT_F1P, CT_C = CT_R4 + CT_F2P;
static_assert(CT_C <= CT_END, "shadow conversion ranges exceed a layer's tile list");
#define SHADOW(first, lo, hi) do { if (F.G == 256 && F.bid >= (first)) { const Frame Fc = relaunder(F0); convert_tiles(Fc, P, l, (lo), (hi), (Fc.bid - (first)) * NWAVES + Fc.wave, (Fc.G - (first)) * NWAVES); } } while (0)
constexpr int CT_L3A = CT_W2 - 1800, CT_L3B = CT_W2;
static_assert(CT_L3B <= CT_W2 && CT_R0 >= CT_W1 && CT_R3 >= CT_W2 && CT_R4 >= CT_WIN, "conversion deadlines");

__device__ __forceinline__ void prologue_a(const Frame& F, const Args& P) {
    unsigned char* ws = (P.ws + F.z);
    for (int l = 0; l < DEPTH; ++l) {
        if (l == 0) convert_tiles(F, P, -1, CT_WIN, CT_END, F.gw, F.NGW);
        if (F.G != 256) convert_tiles(F, P, l, 0, CT_END, F.gw, F.NGW);
        unsigned char* lw = ws + WS_W + (size_t)l * LW_STRIDE;
        { const float* s = P.in[I_CWS + F.z] + (size_t)l * 4 * 128 * 128; bf16* d = (bf16*)(lw + LW_WS);
          for (int i = F.bid * NTHR + F.tid; i < 4 * 128 * 128; i += F.G * NTHR) d[i] = (bf16)f2bf(s[i]); }
    }
    __syncthreads();
    {
        LAS float* sl = (LAS float*)F.lds; LAS float* sc = sl + DM;
        for (int i = F.tid; i < DM; i += NTHR) { sl[i] = silu_acc(P.in[I_C + F.z][i]); sc[i] = silu_acc(P.in[I_CCTX + F.z][i]); }
        __syncthreads();
        float* MODP = (float*)(ws + WS_MODP);
        for (int rr = 0; rr < PREPS(31); ++rr)
        for (int it = F.bid; it < 4 * 6 * 32; it += F.G) {
            const int l = it / 192, r = it % 192, jb = r >> 5, sli = r & 31, j = jb * 2048 + 4 * F.tid, i0 = sli * 64;
            const float* w = P.in[I_ADAW + F.z] + ((size_t)l * DM + i0) * 12288 + j;
            f32x4 a0 = (f32x4){0.f, 0.f, 0.f, 0.f}, a1 = a0;
#pragma unroll 32
            for (int i = 0; i < 64; ++i) { const f32x4 wv = *(const f32x4*)(w + (size_t)i * 12288); a0 = a0 + wv * sl[i0 + i]; a1 = a1 + wv * sc[i0 + i]; }
            *(f32x4*)(MODP + ((size_t)(sli * 4 + l) * 2 + 0) * 12288 + j) = a0; *(f32x4*)(MODP + ((size_t)(sli * 4 + l) * 2 + 1) * 12288 + j) = a1;
        }
    }
    const int gt = F.bid * NTHR + F.tid, GT = F.G * NTHR;
    for (int rr = 0; rr < PREPS(32); ++rr)
    for (int idx = gt; idx < 4 * 2 * 32 * 128; idx += GT) {
        const int n = idx & 127, p = n >> 1, ri = n & 1, g = (idx >> 7) & 31, dir = (idx >> 12) & 1, l = idx >> 13;
        const float a_re = P.in[I_S5ARE + F.z][(l * 32 + g) * 64 + p], a_im = P.in[I_S5AIM + F.z][(l * 32 + g) * 64 + p];
        const float dt = expf(P.in[I_S5LDT + F.z][(l * 2 + dir) * 32 + g]);
        const float mag = expf(dt * a_re), ang = dt * a_im, abr = mag * cosf(ang), abi = mag * sinf(ang);
        const float nr = abr - 1.f, ni = abi, den = a_re * a_re + a_im * a_im;
        const float fre = (nr * a_re + ni * a_im) / den, fim = (ni * a_re - nr * a_im) / den;
        const size_t bi = ((size_t)((l * 2 + dir) * 32 + g) * 64 + p) * 16;
        const float* bre = P.in[I_S5BRE + F.z] + bi; const float* bim = P.in[I_S5BIM + F.z] + bi;
        bf16* bw = (bf16*)(ws + WS_S5BW) + (size_t)idx * 32;
        float* bbf = (float*)(ws + WS_S5BB) + ((size_t)(((l * 2 + dir) * 32 + g) * 64 + p) * 16) * 2 + ri;
        f32x4 brv[4], biv[4];
#pragma unroll
        for (int c4 = 0; c4 < 4; ++c4) { brv[c4] = *(const f32x4*)(bre + 4 * c4); biv[c4] = *(const f32x4*)(bim + 4 * c4); }
#pragma unroll
        for (int c = 0; c < 16; ++c) { const float br_ = brv[c >> 2][c & 3], bi_ = biv[c >> 2][c & 3]; const float v = ri ? (fre * bi_ + fim * br_) : (fre * br_ - fim * bi_);
            bbf[2 * c] = v;
            const unsigned hi = f2bf(v); const float hf = __builtin_bit_cast(float, hi << 16); bw[c] = (bf16)hi; bw[16 + c] = (bf16)f2bf(v - hf); }
        if (ri == 0) { const int i2 = ((l * 2 + dir) * 32 + g) * 64 + p;
            ((float2*)(ws + WS_S5AB))[i2] = make_float2(abr, abi);
            float pr = abr, pi = abi;
            for (int s2 = 0; s2 < 7; ++s2) { const float t = pr * pr - pi * pi; pi = 2.f * pr * pi; pr = t; }
            ((float2*)(ws + WS_S5AL))[i2] = make_float2(pr, pi); }
    }
    for (int rr = 0; rr < PREPS(32); ++rr)
    for (int idx = gt; idx < 4 * 32 * 16 * 128; idx += GT) {
        const int n = idx & 127, p = n >> 1, ch = (idx >> 7) & 15, lg = idx >> 11;
        const size_t ci = ((size_t)lg * 16 + ch) * 64 + p;
        ((bf16*)(ws + WS_S5CW))[idx] = (bf16)f2bf((n & 1) ? -P.in[I_S5CIM + F.z][ci] : P.in[I_S5CRE + F.z][ci]);
    }
    {
        float* COS = (float*)(ws + WS_COS); float* SIN = (float*)(ws + WS_SIN);
        for (int idx = gt; idx < 192 * 32; idx += GT) {
            const int r = idx >> 5, j = idx & 31;
            const float fr = expf(-((float)j / 32.f) * 9.210340371976184f);
            const float ang = (float)(r < 128 ? r : r - 128) * fr;
            COS[idx] = cosf(ang); SIN[idx] = sinf(ang);
        }
    }
}
__device__ __forceinline__ void prologue_b(const Frame& F, const Args& P) {
    const float* MODP = (const float*)((P.ws + F.z) + WS_MODP); float* MOD = (float*)((P.ws + F.z) + WS_MOD);
    for (int idx = F.bid * NTHR + F.tid; idx < 4 * 2 * 12288; idx += F.G * NTHR) {
        const int l = idx / 24576, j = idx % 12288;
        float s = P.in[I_ADAB + F.z][l * 12288 + j];
        float pv[32];
#pragma unroll
        for (int k = 0; k < 32; ++k) pv[k] = MODP[(size_t)k * 98304 + idx];
#pragma unroll
        for (int k = 0; k < 32; ++k) s += pv[k];
        MOD[idx] = s;
    }
}

__device__ __forceinline__ void load_row(f32x4 (&v)[8], const void* base, int f32src, size_t row, int lane) {
    if (f32src) {
#pragma unroll
        for (int j = 0; j < 8; ++j) v[j] = *((const f32x4*)((const float*)base + row * DM) + lane + 64 * j);
    } else {
        u32x2 w[8];
#pragma unroll
        for (int j = 0; j < 8; ++j) w[j] = *((const u32x2*)((const bf16*)base + row * DM) + lane + 64 * j);
#pragma unroll
        for (int j = 0; j < 8; ++j) { v[j].x = __uint_as_float(w[j].x << 16); v[j].y = __uint_as_float(w[j].x & 0xffff0000u); v[j].z = __uint_as_float(w[j].y << 16); v[j].w = __uint_as_float(w[j].y & 0xffff0000u); }
    }
}
__device__ __forceinline__ void norm_phase(const Frame& F, const Args& P, int l, const float* gvec, int ish, int isc, int npart, const float* gate_ctx, const void* rd_lat, int lat_f32, const void* rd_ctx, int ctx_f32, unsigned char* H8) {
    LAS float* ga = (LAS float*)F.lds; LAS float* sh = ga + 2 * DM;
    LAS float* gc = sh + 2 * DM;
    if (npart > 0) for (int i = F.tid; i < DM; i += NTHR) gc[i] = gate_ctx[i];
    const float* MOD = (const float*)((P.ws + F.z) + WS_MOD) + (size_t)l * 2 * 12288;
    for (int i = F.tid; i < 2 * DM; i += NTHR) { const int s = i / DM, c = i % DM; ga[i] = gvec[c] * (1.f + MOD[s * 12288 + isc * DM + c]); sh[i] = MOD[s * 12288 + ish * DM + c]; }
    __syncthreads();
    bf16* X = (bf16*)((P.ws + F.z) + WS_X); bf16* H = (bf16*)((P.ws + F.z) + WS_H); const float* PART = (const float*)((P.ws + F.z) + WS_PART);
    f32x4 vn[8];
    if (F.gw < NR) { if (F.gw < CTXL) load_row(vn, rd_ctx, ctx_f32, F.gw, F.lane); else load_row(vn, rd_lat, lat_f32, F.gw, F.lane); }
    for (int row = F.gw; row < NR; row += F.NGW) {
        const int s = row < CTXL ? 1 : 0;
        f32x4 v[8]; float ss = 0.f;
#pragma unroll
        for (int j = 0; j < 8; ++j) v[j] = vn[j];
        if (row + F.NGW < NR) load_row(vn, rd_lat, lat_f32, row + F.NGW, F.lane);
        if (row < CTXL && npart > 0) {
            u32x2* xr = (u32x2*)(X + (size_t)row * DM) + F.lane;
#pragma unroll
            for (int j = 0; j < 8; ++j) { f32x4 pv[11];
#pragma unroll
                for (int q = 0; q < 11; ++q) pv[q] = q < npart ? *((const f32x4*)(PART + ((size_t)q * 256 + row) * DM) + F.lane + 64 * j) : (f32x4){0.f, 0.f, 0.f, 0.f};
                f32x4 a = pv[0];
#pragma unroll
                for (int q = 1; q < 11; ++q) a = a + pv[q];
                v[j] = v[j] + a * *(const LAS f32x4*)(gc + 4 * F.lane + 256 * j); u32x2 w; w.x = pk2(v[j].x, v[j].y); w.y = pk2(v[j].z, v[j].w); xr[64 * j] = w; }
        }
#pragma unroll
        for (int j = 0; j < 8; ++j) { ss += (v[j].x * v[j].x + v[j].y * v[j].y) + (v[j].z * v[j].z + v[j].w * v[j].w); }
        const float rstd = 1.f / sqrtf(wave_sum(ss) * (1.f / DM) + EPS);
        u32x2* o = (u32x2*)(H + (size_t)row * DM) + F.lane;
#pragma unroll
        for (int j = 0; j < 8; ++j) { const f32x4 g4 = *(const LAS f32x4*)(ga + s * DM + 4 * F.lane + 256 * j), s4 = *(const LAS f32x4*)(sh + s * DM + 4 * F.lane + 256 * j);
            const f32x4 y = v[j] * rstd * g4 + s4;
            u32x2 w; w.x = pk2(y.x, y.y); w.y = pk2(y.z, y.w); o[64 * j] = w;
            if (H8 != nullptr) ((unsigned*)(H8 + (size_t)row * DM))[F.lane + 64 * j] = pk_e4m3(y.x, y.y, y.z, y.w); }
    }
}
__device__ __forceinline__ void final_norm(const Frame& F, const Args& P) {
    const bf16* X = (const bf16*)((P.ws + F.z) + WS_X); const float* g = P.in[I_FNG + F.z];
    f32x4 vn[8];
    if (CTXL + F.gw < NR) load_row(vn, X, 0, CTXL + F.gw, F.lane);
    for (int row = CTXL + F.gw; row < NR; row += F.NGW) {
        f32x4 v[8]; float ss = 0.f;
#pragma unroll
        for (int j = 0; j < 8; ++j) v[j] = vn[j];
        if (row + F.NGW < NR) load_row(vn, X, 0, row + F.NGW, F.lane);
#pragma unroll
        for (int j = 0; j < 8; ++j) ss += (v[j].x * v[j].x + v[j].y * v[j].y) + (v[j].z * v[j].z + v[j].w * v[j].w);
        const float rstd = 1.f / sqrtf(wave_sum(ss) * (1.f / DM) + EPS);
        f32x4* o = (f32x4*)(P.out + (size_t)(row - CTXL) * DM) + F.lane;
#pragma unroll
        for (int j = 0; j < 8; ++j) { const f32x4 g4 = *((const f32x4*)g + F.lane + 64 * j); o[64 * j] = v[j] * rstd * g4; }
    }
}

using pg8::Unit;
__device__ __forceinline__ unsigned q8(float g) { return (unsigned)(g * 255.f + 0.5f); }
struct EpiG1 {
    static constexpr bool PERM = true, AFTER_DRAIN = false;
    bf16* PROJ; bf16* G; const float* bias; int pn_off; float* GST; float gsc;
    __device__ __forceinline__ void operator()(const f32x4 (&acc)[2][2][4][2], const Unit& u0, int wr, int wc, int fr, int fq) const {
        Unit u = u0; u.pn += pn_off;
        const int row0 = u.pm * 256 + wr * 64 + fr;
        if (u.pn < 20) {
            const int col0 = u.pn * 256 + wc * 32 + 8 * fq;
#pragma unroll
            for (int ai = 0; ai < 2; ++ai)
#pragma unroll
                for (int m = 0; m < 4; ++m) { bf16* rowp = PROJ + (size_t)(row0 + ai * 128 + m * 16) * PROJW + col0;
#pragma unroll
                    for (int bj = 0; bj < 2; ++bj) { const f32x4 v0 = acc[ai][bj][m][0], v1 = acc[ai][bj][m][1];
                        u32x4 w; w.x = pg8::cvt_pk_bf16(v0[0], v0[1]); w.y = pg8::cvt_pk_bf16(v0[2], v0[3]); w.z = pg8::cvt_pk_bf16(v1[0], v1[1]); w.w = pg8::cvt_pk_bf16(v1[2], v1[3]);
                        *(u32x4*)(rowp + bj * 128) = w; } }
            if (u.pn == 18 || u.pn == 19) {
#pragma unroll
                for (int ai = 0; ai < 2; ++ai)
#pragma unroll
                    for (int m = 0; m < 4; ++m) { float s = 0.f, s2 = 0.f;
#pragma unroll
                        for (int bj = 0; bj < 2; ++bj)
#pragma unroll
                            for (int n = 0; n < 2; ++n)
#pragma unroll
                                for (int i = 0; i < 4; i += 2) { const unsigned pw = pg8::cvt_pk_bf16(acc[ai][bj][m][n][i], acc[ai][bj][m][n][i + 1]); const float g0 = gelu_tanh(bflo(pw)), g1 = gelu_tanh(bfhi(pw)); s += g0 + g1; s2 += g0 * g0 + g1 * g1; }
                        s += __shfl_xor(s, 16); s += __shfl_xor(s, 32); s2 += __shfl_xor(s2, 16); s2 += __shfl_xor(s2, 32);
                        if (fq == 0) *(f32x2*)(GST + ((size_t)(row0 + ai * 128 + m * 16) * 8 + (u.pn - 18) * 4 + wc) * 2) = (f32x2){s, s2}; }
            }
        } else {
            const int col0 = (u.pn - 20) * 256 + wc * 32 + 8 * fq;
            f32x4 bv[2][2];
#pragma unroll
            for (int bj = 0; bj < 2; ++bj)
#pragma unroll
                for (int n = 0; n < 2; ++n) bv[bj][n] = *(const f32x4*)(bias + col0 + bj * 128 + 4 * n) * -1.4426950408889634f;
#pragma unroll
            for (int ai = 0; ai < 2; ++ai)
#pragma unroll
                for (int m = 0; m < 4; ++m) { unsigned char* rowp = (unsigned char*)G + (size_t)(row0 + ai * 128 + m * 16) * 8192 + col0;
#pragma unroll
                    for (int bj = 0; bj < 2; ++bj) { const f32x4 g0 = sig4_t(acc[ai][bj][m][0] * gsc + bv[bj][0]) * 255.f + 0.5f, g1 = sig4_t(acc[ai][bj][m][1] * gsc + bv[bj][1]) * 255.f + 0.5f;
                        u32x2 w; w.x = (unsigned)g0[0] | ((unsigned)g0[1] << 8) | ((unsigned)g0[2] << 16) | ((unsigned)g0[3] << 24);
                        w.y = (unsigned)g1[0] | ((unsigned)g1[1] << 8) | ((unsigned)g1[2] << 16) | ((unsigned)g1[3] << 24);
                        *(u32x2*)(rowp + bj * 128) = w; } }
        }
    }
};
struct EpiY {
    static constexpr bool PERM = true, AFTER_DRAIN = false;
    bf16* Y;
    __device__ __forceinline__ void operator()(const f32x4 (&acc)[2][2][4][2], const Unit& u, int wr, int wc, int fr, int fq) const {
        const int k = u.pn >> 3; const int row0 = (u.pm - 33 * k) * 256 + wr * 64 + fr, col0 = u.pn * 256 + wc * 32 + 8 * fq;
#pragma unroll
        for (int ai = 0; ai < 2; ++ai)
#pragma unroll
            for (int m = 0; m < 4; ++m) { bf16* rowp = Y + (size_t)(row0 + ai * 128 + m * 16) * 8192 + col0;
#pragma unroll
                for (int bj = 0; bj < 2; ++bj) { const f32x4 v0 = acc[ai][bj][m][0], v1 = acc[ai][bj][m][1];
                    u32x4 w; w.x = pg8::cvt_pk_bf16(v0[0], v0[1]); w.y = pg8::cvt_pk_bf16(v0[2], v0[3]); w.z = pg8::cvt_pk_bf16(v1[0], v1[1]); w.w = pg8::cvt_pk_bf16(v1[2], v1[3]);
                    *(u32x4*)(rowp + bj * 128) = w; } }
    }
};
struct EpiGlu {
    static constexpr bool PERM = true, AFTER_DRAIN = false;
    const bf16* S5Y; bf16* O1;
    __device__ __forceinline__ void operator()(const f32x4 (&acc)[2][2][4][2], const Unit& u, int wr, int wc, int fr, int fq) const {
        const int row0 = u.pm * 256 + wr * 64 + fr, col0 = u.pn * 256 + wc * 32 + 8 * fq;
#pragma unroll
        for (int ai = 0; ai < 2; ++ai)
#pragma unroll
            for (int m = 0; m < 4; ++m) { const size_t ro = (size_t)(row0 + ai * 128 + m * 16) * BW + col0;
#pragma unroll
                for (int bj = 0; bj < 2; ++bj) { const f32x4 v0 = acc[ai][bj][m][0], v1 = acc[ai][bj][m][1];
                    const u32x4 yw = *(const u32x4*)(S5Y + ro + bj * 128); float y[8]; unpack8(yw, y);
                    float o[8];
#pragma unroll
                    for (int i = 0; i < 4; ++i) { o[i] = sigmoid_fast(v0[i]) * y[i]; o[4 + i] = sigmoid_fast(v1[i]) * y[4 + i]; }
                    u32x4 w; w.x = pg8::cvt_pk_bf16(o[0], o[1]); w.y = pg8::cvt_pk_bf16(o[2], o[3]); w.z = pg8::cvt_pk_bf16(o[4], o[5]); w.w = pg8::cvt_pk_bf16(o[6], o[7]);
                    *(u32x4*)(O1 + ro + bj * 128) = w; } }
    }
};
struct EpiRes {
    static constexpr bool PERM = true, AFTER_DRAIN = false;
    bf16* X; const float* g_lat; float* PART; int dry; const void* Xr; int xr_f32;
    template <bool F32>
    __device__ __forceinline__ void latent(const f32x4 (&acc)[2][2][4][2], int row0, int col0) const {
        f32x4 gv[2][2];
#pragma unroll
        for (int bj = 0; bj < 2; ++bj)
#pragma unroll
            for (int n = 0; n < 2; ++n) gv[bj][n] = *(const f32x4*)(g_lat + col0 + bj * 128 + n * 4);
#pragma unroll
        for (int ai = 0; ai < 2; ++ai)
#pragma unroll
            for (int m = 0; m < 4; ++m) { const size_t off = (size_t)(row0 + ai * 128 + m * 16) * DM + col0;
#pragma unroll
                for (int bj = 0; bj < 2; ++bj) { f32x4 x0, x1;
                    if (F32) { const float* p = (const float*)Xr + off + bj * 128; x0 = *(const f32x4*)p; x1 = *(const f32x4*)(p + 4); }
                    else { const u32x4 r = *(const u32x4*)((const bf16*)Xr + off + bj * 128); float a[8]; unpack8(r, a); x0 = (f32x4){a[0], a[1], a[2], a[3]}; x1 = (f32x4){a[4], a[5], a[6], a[7]}; }
                    x0 = x0 + gv[bj][0] * acc[ai][bj][m][0]; x1 = x1 + gv[bj][1] * acc[ai][bj][m][1];
                    u32x4 w; w.x = pg8::cvt_pk_bf16(x0[0], x0[1]); w.y = pg8::cvt_pk_bf16(x0[2], x0[3]); w.z = pg8::cvt_pk_bf16(x1[0], x1[1]); w.w = pg8::cvt_pk_bf16(x1[2], x1[3]);
                    *(u32x4*)(X + off + bj * 128) = w; } }
    }
    __device__ __forceinline__ void operator()(const f32x4 (&acc)[2][2][4][2], const Unit& u, int wr, int wc, int fr, int fq) const {
        const int row0 = u.pm * 256 + wr * 64 + fr, col0 = u.pn * 256 + wc * 32 + 8 * fq;
        if (dry) return;
#ifdef EXP_NOSPLIT
        if (false) {
#else
        if (u.pm == 0) {
#endif
            float* base = PART + (size_t)(u.k0 / (u.nt * 64)) * 256 * DM;
#pragma unroll
            for (int ai = 0; ai < 2; ++ai)
#pragma unroll
                for (int m = 0; m < 4; ++m) { float* rowp = base + (size_t)(row0 + ai * 128 + m * 16) * DM + col0;
#pragma unroll
                    for (int bj = 0; bj < 2; ++bj)
#pragma unroll
                        for (int n = 0; n < 2; ++n) *(f32x4*)(rowp + bj * 128 + n * 4) = acc[ai][bj][m][n]; }
        } else {
            if (xr_f32) latent<true>(acc, row0, col0); else latent<false>(acc, row0, col0);
        }
    }
};
struct EpiFfn1 {
    static constexpr bool PERM = false, AFTER_DRAIN = false;
    bf16* T;
    __device__ __forceinline__ void operator()(const f32x4 (&acc)[2][2][4][2], const Unit& u, int wr, int wc, int fr, int fq) const {
        const int row0 = u.pm * 256 + wr * 64 + fr, col0 = u.pn * 128 + wc * 32 + 8 * fq;
#pragma unroll
        for (int ai = 0; ai < 2; ++ai)
#pragma unroll
            for (int m = 0; m < 4; ++m) { bf16* rowp = T + (size_t)(row0 + ai * 128 + m * 16) * DFF + col0;
                float o[8];
#pragma unroll
                for (int bj = 0; bj < 2; ++bj)
#pragma unroll
                    for (int i = 0; i < 4; ++i) o[4 * bj + i] = 0.f;
#pragma unroll
                for (int bj = 0; bj < 2; ++bj) { const f32x4 a = acc[ai][bj][m][0]; const f32x4 r = (a * acc[ai][bj][m][1]) * sig4_t(a * -1.4426950408889634f); o[4 * bj] = r[0]; o[4 * bj + 1] = r[1]; o[4 * bj + 2] = r[2]; o[4 * bj + 3] = r[3]; }
                u32x4 w; w.x = pg8::cvt_pk_bf16(o[0], o[1]); w.y = pg8::cvt_pk_bf16(o[2], o[3]); w.z = pg8::cvt_pk_bf16(o[4], o[5]); w.w = pg8::cvt_pk_bf16(o[6], o[7]);
                *(u32x4*)rowp = w; }
    }
};
struct YOrder {
    pg8::StaticOrder S; int rows;
    __device__ void init(int G, int c, int rows_) { rows = rows_; S.init(4 * rows_ * 256, DM, BW, G, c); }
    __device__ bool next(int i, Unit& u) const { if (!S.next(i, u)) return false; const int k = u.pm / rows, r = u.pm - k * rows; u.pm = k * 33 + (33 - rows) + r; u.pn += k * 8; return true; }
    __device__ __forceinline__ void a_ready(const Unit&) const {}
    __device__ __forceinline__ void done(const Unit&) const {}
};

struct GateOrder {
    pg8::StaticOrder S, S5; int c;
    __device__ void init(int G, int c_) { c = c_; S.init(NR, 8192, DM / 2, G, c_); S5.init(NR, 8192, DM / 2, G, c_ - 148); }
    __device__ bool next(int i, Unit& u) const { if (i < 4) return S.next(i, u); if (i == 4 && c >= 148 && c < 180) return S5.next(4, u); return false; }
    __device__ __forceinline__ void a_ready(const Unit&) const {}
    __device__ __forceinline__ void done(const Unit&) const {}
};
struct SplitOrder {
    int G, c, nt_full, nsl, nt_sl, ctx;
    __device__ bool next(int i, Unit& u) const {
        const long L = (long)i * G + c;
        if (L < 256) { const int w = (int)L, x = w & 7, o = w >> 3;
            u.pm = 1 + x * 4 + (o & 3); u.pn = o >> 2; u.k0 = 0; u.nt = nt_full; return true; }
        const int j = (int)(L - 256);
#ifdef EXP_NOSPLIT
        if (ctx && j < 8) { u.pm = 0; u.pn = j; u.k0 = 0; u.nt = nt_full; return true; }
#else
        if (ctx && j < 8 * nsl) { u.pm = 0; u.pn = j & 7; u.k0 = (j >> 3) * nt_sl * 64; u.nt = nt_sl; return true; }
#endif
        return false;
    }
    __device__ __forceinline__ void a_ready(const Unit&) const {}
    __device__ __forceinline__ void done(const Unit&) const {}
};

__device__ __forceinline__ float log2_sigmoid(float x) { return -log1pf(expf(-x)) * 1.4426950408889634f; }
__device__ __forceinline__ float dec_lg(const Frame& F, const Args& P, int l, int dir, int h) { return log2_sigmoid(P.in[I_DECAY + F.z][(l * 2 + dir) * 4 + h]); }

__device__ __forceinline__ int rope_idx(int pos, int j0) { return ((j0 < 32) ? (pos >> 6) : 128 + (pos & 63)) * 32 + (j0 & 31); }
template <bool TRANS>
__device__ __forceinline__ void stage_qk(const Frame& F, const Args& P, LAS bf16* dst, int row0, int sec, int h, float scale) {
    const bf16* PROJ = (const bf16*)((P.ws + F.z) + WS_PROJ); const float* COS = (const float*)((P.ws + F.z) + WS_COS); const float* SIN = (const float*)((P.ws + F.z) + WS_SIN);
    const bool lat = row0 >= CTXL;
    if (!TRANS) {
#pragma unroll
        for (int rep = 0; rep < 2; ++rep) {
            const int w = F.tid + NTHR * rep, t = w >> 3, j0 = (w & 7) * 8;
            const bf16* kp = PROJ + (size_t)(row0 + t) * PROJW + sec * BW + h * 128;
            float a[8], b[8]; unpack8(*(const u32x4*)(kp + j0), a); unpack8(*(const u32x4*)(kp + 64 + j0), b);
            float o1[8], o2[8];
            if (lat) {
                const int pos = row0 + t - CTXL; const int ri = rope_idx(pos, j0); const float* cp = COS + ri; const float* sp = SIN + ri;
#pragma unroll
                for (int e = 0; e < 8; ++e) { const float c = cp[e], s = sp[e]; o1[e] = (a[e] * c - b[e] * s) * scale; o2[e] = (a[e] * s + b[e] * c) * scale; }
            } else {
#pragma unroll
                for (int e = 0; e < 8; ++e) { o1[e] = a[e] * scale; o2[e] = b[e] * scale; }
            }
            *(LAS u32x4*)(dst + t * LDT + j0) = pack8(o1); *(LAS u32x4*)(dst + t * LDT + 64 + j0) = pack8(o2);
        }
    } else {
        const int tp = F.tid >> 3, j0 = (F.tid & 7) * 8, t = 2 * tp;
        const bf16* kp = PROJ + (size_t)(row0 + t) * PROJW + sec * BW + h * 128;
        float a0[8], b0[8], a1[8], b1[8];
        unpack8(*(const u32x4*)(kp + j0), a0); unpack8(*(const u32x4*)(kp + 64 + j0), b0); unpack8(*(const u32x4*)(kp + PROJW + j0), a1); unpack8(*(const u32x4*)(kp + PROJW + 64 + j0), b1);
        if (lat) {
            const int pos = row0 + t - CTXL; const int ri = rope_idx(pos, j0), d1 = rope_idx(pos + 1, j0) - ri; const float* cp = COS + ri; const float* sp = SIN + ri;
#pragma unroll
            for (int e = 0; e < 8; ++e) { const float c0 = cp[e], s0 = sp[e], c1 = cp[d1 + e], s1 = sp[d1 + e];
                const float x0 = a0[e] * c0 - b0[e] * s0, y0 = a0[e] * s0 + b0[e] * c0, x1 = a1[e] * c1 - b1[e] * s1, y1 = a1[e] * s1 + b1[e] * c1;
                a0[e] = x0; b0[e] = y0; a1[e] = x1; b1[e] = y1; }
        }
#pragma unroll
        for (int e = 0; e < 8; ++e) { *(LAS unsigned*)(dst + (j0 + e) * LDT + t) = pk2(a0[e] * scale, a1[e] * scale); *(LAS unsigned*)(dst + (64 + j0 + e) * LDT + t) = pk2(b0[e] * scale, b1[e] * scale); }
    }
}
template <int MODE>
__device__ __forceinline__ void stage_vt(const Frame& F, const Args& P, LAS bf16* dst, LAS bf16* dst2, int row0, int h, float lg, float lg2) {
    const bf16* PROJ = (const bf16*)((P.ws + F.z) + WS_PROJ);
#pragma unroll
    for (int rep = 0; rep < 2; ++rep) {
        const int w = F.tid + NTHR * rep, tp = w >> 4, d0 = (w & 15) * 8, t = 2 * tp;
        const bf16* vp = PROJ + (size_t)(row0 + t) * PROJW + 2 * BW + h * 128 + d0;
        float v0[8], v1[8]; unpack8(*(const u32x4*)vp, v0); unpack8(*(const u32x4*)(vp + PROJW), v1);
        if (MODE == 0) {
#pragma unroll
            for (int e = 0; e < 8; ++e) *(LAS unsigned*)(dst + (d0 + e) * LDT + t) = pk2(v0[e], v1[e]);
        } else {
            const float f0 = exp2f(lg * (float)(127 - t)), f1 = exp2f(lg * (float)(126 - t)), b0 = exp2f(lg2 * (float)t), b1 = exp2f(lg2 * (float)(t + 1));
#pragma unroll
            for (int e = 0; e < 8; ++e) { *(LAS unsigned*)(dst + (d0 + e) * LDT + t) = pk2(v0[e] * f0, v1[e] * f1); *(LAS unsigned*)(dst2 + (d0 + e) * LDT + t) = pk2(v0[e] * b0, v1[e] * b1); }
        }
    }
}

__device__ __forceinline__ void ret_kv_phase(const Frame& F, const Args& P, int l, const int it) {
    LAS bf16* KT = (LAS bf16*)F.lds; LAS bf16* VF = KT + 128 * LDT; LAS bf16* VB = VF + 128 * LDT;
    float* KVT = (float*)((P.ws + F.z) + WS_KVT);
    const int fr = F.lane & 15, fq = F.lane >> 4;
    {
        const int c = it >> 2, h = it & 3, row0 = c * 128;
        __syncthreads();
        stage_qk<true>(F, P, KT, row0, 1, h, 1.f);
        stage_vt<1>(F, P, VF, VB, row0, h, dec_lg(F, P, l, 0, h), dec_lg(F, P, l, 1, h));
        __syncthreads();
        f32x4 af[8], ab[8];
#pragma unroll
        for (int n = 0; n < 8; ++n) { af[n] = (f32x4){0.f, 0.f, 0.f, 0.f}; ab[n] = (f32x4){0.f, 0.f, 0.f, 0.f}; }
        mma_nt<8>(af, VF + 16 * F.wave * LDT, LDT, KT, LDT, 128, F.lane);
        mma_nt<8>(ab, VB + 16 * F.wave * LDT, LDT, KT, LDT, 128, F.lane);
        float* of = KVT + ((((size_t)0 * NCH + c) * 4 + h) * 128 + 16 * F.wave + fr) * 128 + 4 * fq;
        float* ob = KVT + ((((size_t)1 * NCH + c) * 4 + h) * 128 + 16 * F.wave + fr) * 128 + 4 * fq;
#pragma unroll
        for (int n = 0; n < 8; ++n) { *(f32x4*)(of + 16 * n) = af[n]; *(f32x4*)(ob + 16 * n) = ab[n]; }
    }
}
__device__ __forceinline__ int bwd_chunk(int step) { return step < 2 ? 1 - step : NCH + 1 - step; }

__device__ __forceinline__ void s5_pass1(const Frame& F, const Args& P, int l) {
    LAS float* U = (LAS float*)(F.lds + F.wave * 17408);
    const bf16* PROJ = (const bf16*)((P.ws + F.z) + WS_PROJ);
    float2* E = (float2*)((P.ws + F.z) + WS_S5E);
    for (int it = F.gw; it < NCH * 32 * 2; it += F.NGW) {
        const int dir = it & 1, g = (it >> 1) & 31, c = it >> 6;
#pragma unroll
        for (int rr = 0; rr < 2; ++rr) { const int t = F.lane + 64 * rr; const bf16* up = PROJ + (size_t)(c * 128 + t) * PROJW + 4 * BW + g * 16;
            float a[8], b[8]; unpack8(*(const u32x4*)up, a); unpack8(*(const u32x4*)(up + 8), b);
#pragma unroll
            for (int e = 0; e < 8; ++e) { U[t * 16 + e] = a[e]; U[t * 16 + 8 + e] = b[e]; } }
        LDS_WAIT();
        const int idx = ((l * 2 + dir) * 32 + g) * 64 + F.lane;
        const float2 ab = ((const float2*)((P.ws + F.z) + WS_S5AB))[idx];
        float2 bb[16];
#pragma unroll
        for (int k = 0; k < 16; ++k) bb[k] = ((const float2*)((P.ws + F.z) + WS_S5BB))[(size_t)idx * 16 + k];
        float xr = 0.f, xi = 0.f;
        for (int s = 0; s < 128; ++s) {
            const int t = dir ? 127 - s : s;
            float u[16];
#pragma unroll
            for (int q = 0; q < 4; ++q) { const f32x4 uu = *(const LAS f32x4*)(U + t * 16 + 4 * q); u[4 * q] = uu.x; u[4 * q + 1] = uu.y; u[4 * q + 2] = uu.z; u[4 * q + 3] = uu.w; }
            float bur = 0.f, bui = 0.f;
#pragma unroll
            for (int k = 0; k < 16; ++k) { bur += bb[k].x * u[k]; bui += bb[k].y * u[k]; }
            const float nr = ab.x * xr - ab.y * xi + bur, ni = ab.x * xi + ab.y * xr + bui; xr = nr; xi = ni;
        }
        E[((size_t)(dir * NCH + c) * 32 + g) * 64 + F.lane] = make_float2(xr, xi);
        LDS_WAIT();
    }
}
constexpr int S5_LDS = 13312, S5_BUS = 132, S5_XS = 136;
__device__ __forceinline__ void conv_phase(const Frame& F, const Args& P, int l, int rank, int nblk) {
    const bf16* PROJ = (const bf16*)((P.ws + F.z) + WS_PROJ); bf16* O2 = (bf16*)((P.ws + F.z) + WS_O) + (size_t)2 * NR * BW;
    const float* cw = P.in[I_CONVW + F.z] + (size_t)l * 3 * BW;
    for (int idx = rank * NTHR + F.tid; idx < NR * 64; idx += nblk * NTHR) {
        const int row = idx >> 6, ch0 = (idx & 63) * 8;
        const int lo = row < CTXL ? 0 : CTXL, hi = row < CTXL ? CTXL : NR;
        float y[8];
#pragma unroll
        for (int e = 0; e < 8; ++e) y[e] = 0.f;
#pragma unroll
        for (int w = 0; w < 3; ++w) { const int r = row + w - 1;
            if (r >= lo && r < hi) { const bf16* pr = PROJ + (size_t)r * PROJW + ch0; float cx[8], cc[8]; unpack8(*(const u32x4*)(pr + 5 * BW), cx); unpack8(*(const u32x4*)(pr + 7 * BW), cc);
#pragma unroll
                for (int e = 0; e < 8; ++e) y[e] += cw[w * BW + ch0 + e] * (cc[e] * cx[e]); } }
        float cb[8]; unpack8(*(const u32x4*)(PROJ + (size_t)row * PROJW + 6 * BW + ch0), cb);
#pragma unroll
        for (int e = 0; e < 8; ++e) y[e] *= cb[e];
        *(u32x4*)(O2 + (size_t)row * BW + ch0) = pack8(y);
    }
}
__device__ __forceinline__ void gmlp_phase(const Frame& F, const Args& P, int l, const int it) {
    LAS bf16* VT = (LAS bf16*)F.lds; LAS bf16* WSL = VT + 128 * LDT; LAS float* mean = (LAS float*)(F.lds + 2 * 128 * LDT * 2); LAS float* rstd = mean + 128;
    const bf16* PROJ = (const bf16*)((P.ws + F.z) + WS_PROJ); bf16* O3 = (bf16*)((P.ws + F.z) + WS_O) + (size_t)3 * NR * BW;
    const float* lng = P.in[I_LNG + F.z] + (size_t)l * BW; const float* lnb = P.in[I_LNB + F.z] + (size_t)l * BW;
    const int fr = F.lane & 15, fq = F.lane >> 4;
    {
        const int c = it >> 2, g = it & 3, row0 = c * 128;
        __syncthreads();
        if (F.tid < 128) {
            const f32x4* gs = (const f32x4*)((const float*)((P.ws + F.z) + WS_GST) + (size_t)(row0 + F.tid) * 16);
            const f32x4 p0 = gs[0], p1 = gs[1], p2 = gs[2], p3 = gs[3];
            const float s = ((p0[0] + p0[2]) + (p1[0] + p1[2])) + ((p2[0] + p2[2]) + (p3[0] + p3[2])), s2 = ((p0[1] + p0[3]) + (p1[1] + p1[3])) + ((p2[1] + p2[3]) + (p3[1] + p3[3]));
            const float mu = s * (1.f / BW), var = fmaxf(s2 * (1.f / BW) - mu * mu, 0.f);
            mean[F.tid] = mu; rstd[F.tid] = 1.f / sqrtf(var + EPS);
        }
        __syncthreads();
#pragma unroll
        for (int rep = 0; rep < 2; ++rep) { const int w = F.tid + NTHR * rep, tp = w >> 4, ch0 = (w & 15) * 8, t = 2 * tp;
            const bf16* gp = PROJ + (size_t)(row0 + t) * PROJW + 9 * BW + g * 128 + ch0;
            float a0[8], a1[8]; unpack8(*(const u32x4*)gp, a0); unpack8(*(const u32x4*)(gp + PROJW), a1);
            const float mu0 = mean[t], rs0 = rstd[t], mu1 = mean[t + 1], rs1 = rstd[t + 1];
#pragma unroll
            for (int e = 0; e < 8; ++e) { const float lg_ = lng[g * 128 + ch0 + e], lb_ = lnb[g * 128 + ch0 + e];
                *(LAS unsigned*)(VT + (ch0 + e) * LDT + t) = pk2((gelu_tanh(a0[e]) - mu0) * rs0 * lg_ + lb_, (gelu_tanh(a1[e]) - mu1) * rs1 * lg_ + lb_); } }
#pragma unroll
        for (int rep = 0; rep < 4; ++rep) { const int w = F.tid + NTHR * rep, t = w >> 4, ch0 = (w & 15) * 8;
            const bf16* wsg = (const bf16*)((P.ws + F.z) + WS_W + (size_t)l * LW_STRIDE + LW_WS) + (size_t)g * 16384;
            *(LAS u32x4*)(WSL + t * LDT + ch0) = *(const u32x4*)(wsg + t * 128 + ch0); }
        __syncthreads();
        f32x4 acc[8];
#pragma unroll
        for (int n = 0; n < 8; ++n) acc[n] = (f32x4){0.f, 0.f, 0.f, 0.f};
        mma_nt<8>(acc, WSL + 16 * F.wave * LDT, LDT, VT, LDT, 128, F.lane);
        const int q = 16 * F.wave + fr; const float bias = P.in[I_CBS + F.z][((size_t)l * 4 + g) * 128 + q];
#pragma unroll
        for (int n = 0; n < 8; ++n) { const int ch = g * 128 + 16 * n + 4 * fq;
            const u32x2 gw = *(const u32x2*)(PROJ + (size_t)(row0 + q) * PROJW + 8 * BW + ch);
            u32x2 o; o.x = pk2(gelu_tanh(bflo(gw.x)) * (acc[n].x + bias), gelu_tanh(bfhi(gw.x)) * (acc[n].y + bias));
            o.y = pk2(gelu_tanh(bflo(gw.y)) * (acc[n].z + bias), gelu_tanh(bfhi(gw.y)) * (acc[n].w + bias));
            *(u32x2*)(O3 + (size_t)(row0 + q) * BW + ch) = o; }
    }
}
__device__ __forceinline__ void merge_phase(const Frame& F, const Args& P) {
    const unsigned char* G = (const unsigned char*)((P.ws + F.z) + WS_G); const bf16* Y = (const bf16*)((P.ws + F.z) + WS_YP); bf16* M = (bf16*)((P.ws + F.z) + WS_MRG);
#pragma unroll 2
    for (int idx = F.bid * NTHR + F.tid; idx < NR * 256; idx += F.G * NTHR) {
        const int row = idx >> 8, c8 = (idx & 255) * 8;
        float m[8];
#pragma unroll
        for (int e = 0; e < 8; ++e) m[e] = 0.f;
#pragma unroll
        for (int k = 0; k < 4; ++k) { float y[8]; const u32x2 gq = *(const u32x2*)(G + (size_t)row * 8192 + k * DM + c8); unpack8(*(const u32x4*)(Y + (size_t)row * 8192 + k * DM + c8), y);
#pragma unroll
            for (int e = 0; e < 4; ++e) { m[e] += (float)((gq.x >> (8 * e)) & 0xffu) * y[e]; m[4 + e] += (float)((gq.y >> (8 * e)) & 0xffu) * y[4 + e]; } }
#pragma unroll
        for (int e = 0; e < 8; ++e) m[e] *= (1.f / 255.f);
        *(u32x4*)(M + (size_t)row * DM + c8) = pack8(m);
    }
}
__device__ __forceinline__ void scan_phase(const Frame& F, const Args& P, int l) {
    if (F.tid < 16) {
        const float2* E = (const float2*)((P.ws + F.z) + WS_S5E); float2* XS = (float2*)((P.ws + F.z) + WS_S5XS);
        for (int idx = F.bid * 16 + F.tid; idx < 2 * 32 * 64; idx += F.G * 16) {
            const int gp = idx & 2047, dir = idx >> 11;
            const float2 al = ((const float2*)((P.ws + F.z) + WS_S5AL))[(l * 2 + dir) * 2048 + gp];
            float xr = 0.f, xi = 0.f;
#pragma unroll 1
            for (int s0 = 0; s0 < NCH; s0 += 33) {
                float2 e[33]; int o[33];
#pragma unroll
                for (int j = 0; j < 33; ++j) { const int c = dir ? bwd_chunk(s0 + j) : s0 + j; o[j] = (dir * NCH + c) * 2048 + gp; e[j] = E[o[j]]; }
#pragma unroll
                for (int j = 0; j < 33; ++j) { XS[o[j]] = make_float2(xr, xi); const float nr = al.x * xr - al.y * xi + e[j].x, ni = al.x * xi + al.y * xr + e[j].y; xr = nr; xi = ni; }
            }
        }
    }
    const float* KVT = (const float*)((P.ws + F.z) + WS_KVT); bf16* ST = (bf16*)((P.ws + F.z) + WS_ST);
    for (int idx = F.bid * NTHR + F.tid; idx < 2 * 4 * 16384; idx += F.G * NTHR) {
        const int e = idx & 16383, h = (idx >> 14) & 3, dir = idx >> 16;
        const float gch = exp2f(128.f * dec_lg(F, P, l, dir, h));
        float s = 0.f;
#pragma unroll 1
        for (int s0 = 0; s0 < NCH; s0 += 33) {
            float kv[33]; int o[33];
#pragma unroll
            for (int j = 0; j < 33; ++j) { const int c = dir ? bwd_chunk(s0 + j) : s0 + j; o[j] = ((dir * NCH + c) * 4 + h) * 16384 + e; kv[j] = KVT[o[j]]; }
#pragma unroll
            for (int j = 0; j < 33; ++j) { ST[o[j]] = (bf16)f2bf(s); s = gch * s + kv[j]; }
        }
    }
}
__device__ __forceinline__ void ret_out_phase(const Frame& F, const Args& P, int l, const int it) {
    LAS bf16* QS = (LAS bf16*)F.lds; LAS bf16* R1 = QS + 128 * LDT; LAS bf16* R2 = R1 + 128 * LDT;
    const bf16* PROJ = (const bf16*)((P.ws + F.z) + WS_PROJ); const bf16* ST = (const bf16*)((P.ws + F.z) + WS_ST); bf16* O0 = (bf16*)((P.ws + F.z) + WS_O);
    const int fr = F.lane & 15, fq = F.lane >> 4;
    {
        const int c = it >> 2, h = it & 3, row0 = c * 128;
        const float lgf = dec_lg(F, P, l, 0, h), lgb = dec_lg(F, P, l, 1, h);
        __syncthreads();
        stage_qk<false>(F, P, QS, row0, 0, h, 0.08838834764831845f);
#pragma unroll
        for (int rep = 0; rep < 4; ++rep) { const int w = F.tid + NTHR * rep, r = w >> 4, pc = (w & 15) * 8;
            *(LAS u32x4*)(R1 + r * LDT + pc) = *(const u32x4*)(ST + (((size_t)0 * NCH + c) * 4 + h) * 16384 + r * 128 + pc);
            *(LAS u32x4*)(R2 + r * LDT + pc) = *(const u32x4*)(ST + (((size_t)1 * NCH + c) * 4 + h) * 16384 + r * 128 + pc); }
        __syncthreads();
        f32x4 o[8], a2[8];
#pragma unroll
        for (int n = 0; n < 8; ++n) { o[n] = (f32x4){0.f, 0.f, 0.f, 0.f}; a2[n] = (f32x4){0.f, 0.f, 0.f, 0.f}; }
        const LAS bf16* qw = QS + 16 * F.wave * LDT;
        mma_nt<8>(o, qw, LDT, R1, LDT, 128, F.lane);
        mma_nt<8>(a2, qw, LDT, R2, LDT, 128, F.lane);
        const int i = 16 * F.wave + fr;
        { const float cf = exp2f(lgf * (float)(i + 1)), cb = exp2f(lgb * (float)(128 - i));
#pragma unroll
          for (int n = 0; n < 8; ++n) o[n] = o[n] * cf + a2[n] * cb; }
        __syncthreads();
        stage_qk<false>(F, P, R1, row0, 1, h, 1.f);
        stage_vt<0>(F, P, R2, R2, row0, h, 0.f, 0.f);
        __syncthreads();
#pragma unroll
        for (int n = 0; n < 8; ++n) a2[n] = (f32x4){0.f, 0.f, 0.f, 0.f};
        mma_nt<8>(a2, qw, LDT, R1, LDT, 128, F.lane);
#pragma unroll
        for (int n = 0; n < 8; ++n) { float sv[4];
#pragma unroll
            for (int r = 0; r < 4; ++r) { const int j = 16 * n + 4 * fq + r, d = i - j; const float dec = d >= 0 ? exp2f(lgf * (float)d) : exp2f(lgb * (float)(-d)); sv[r] = a2[n][r] * dec; }
            u32x2 w; w.x = pk2(sv[0], sv[1]); w.y = pk2(sv[2], sv[3]);
            *(LAS u32x2*)(QS + (16 * F.wave + fr) * LDT + 16 * n + 4 * fq) = w; }
        LDS_WAIT();
        mma_nt<8>(o, qw, LDT, R2, LDT, 128, F.lane);
        float s = 0.f;
#pragma unroll
        for (int n = 0; n < 8; ++n) s += (o[n].x + o[n].y) + (o[n].z + o[n].w);
        s += __shfl_xor(s, 16); s += __shfl_xor(s, 32);
        const float mu = s * (1.f / 128.f); float s2 = 0.f;
#pragma unroll
        for (int n = 0; n < 8; ++n) { o[n] = o[n] - mu; s2 += (o[n].x * o[n].x + o[n].y * o[n].y) + (o[n].z * o[n].z + o[n].w * o[n].w); }
        s2 += __shfl_xor(s2, 16); s2 += __shfl_xor(s2, 32);
        const float rs = 1.f / sqrtf(s2 * (1.f / 128.f) + EPS);
#pragma unroll
        for (int n = 0; n < 8; ++n) { const int col = h * 128 + 16 * n + 4 * fq;
            const u32x2 gw = *(const u32x2*)(PROJ + (size_t)(row0 + i) * PROJW + 3 * BW + col);
            u32x2 w; w.x = pk2(o[n].x * rs * silu_fast(bflo(gw.x)), o[n].y * rs * silu_fast(bfhi(gw.x))); w.y = pk2(o[n].z * rs * silu_fast(bflo(gw.y)), o[n].w * rs * silu_fast(bfhi(gw.y)));
            *(u32x2*)(O0 + (size_t)(row0 + i) * BW + col) = w; }
    }
}

template <int DIR, bool P1>
__device__ __forceinline__ void s5_p2_dir(const Frame& F, const Args& P, int l, int g, int c, LAS float* BUb, LAS bf16* XBh, const bf16x8 (&ua)[8], const bf16x8 (&cfr)[4], f32x4 (&yacc)[8]) {
    const int lane = F.lane, fr = lane & 15, fq = lane >> 4;
    const bf16* bw = (const bf16*)((P.ws + F.z) + WS_S5BW) + ((size_t)((l * 2 + DIR) * 32 + g) * 128 + fr) * 32 + 8 * fq;
    bf16x8 bfr[8];
#pragma unroll
    for (int nt = 0; nt < 8; ++nt) bfr[nt] = *(const bf16x8*)(bw + nt * 16 * 32);
    const float2 ab = ((const float2*)((P.ws + F.z) + WS_S5AB))[((l * 2 + DIR) * 32 + g) * 64 + lane];
    f32x2 x = (f32x2){0.f, 0.f};
    if (!P1) { const float2 x0 = ((const float2*)((P.ws + F.z) + WS_S5XS))[((size_t)DIR * NCH + c) * 2048 + g * 64 + lane]; x = (f32x2){x0.x, x0.y}; }
    const f32x2 a2 = (f32x2){ab.x, ab.x}, n2 = (f32x2){-ab.y, ab.y};
#pragma unroll
    for (int bs = 0; bs < 8; ++bs) {
        const int b = DIR ? 7 - bs : bs;
        f32x4 d[8];
#pragma unroll
        for (int nt = 0; nt < 8; ++nt) d[nt] = __builtin_amdgcn_mfma_f32_16x16x32_bf16(ua[b], bfr[nt], (f32x4){0.f, 0.f, 0.f, 0.f}, 0, 0, 0);
        __builtin_amdgcn_sched_barrier(0); asm volatile("s_nop 15" ::: "memory"); __builtin_amdgcn_sched_barrier(0);
#pragma unroll
        for (int nt = 0; nt < 8; ++nt)
#pragma unroll
            for (int r = 0; r < 4; ++r) BUb[(4 * fq + r) * S5_BUS + 16 * nt + fr] = d[nt][r];
        LDS_WAIT();
        f32x2 bu[16];
#pragma unroll
        for (int s = 0; s < 16; ++s) bu[s] = *(const LAS f32x2*)(BUb + (DIR ? 15 - s : s) * S5_BUS + 2 * lane);
        LDS_WAIT();
#pragma unroll
        for (int s = 0; s < 16; ++s) { const int tl = DIR ? 15 - s : s;
            const f32x2 t = a2 * x + bu[s]; x = n2 * __builtin_shufflevector(x, x, 1, 0) + t;
            if (!P1) *(LAS unsigned*)(XBh + tl * S5_XS + 2 * lane) = pk2(x[0], x[1]); }
        LDS_WAIT();
        if (!P1) {
#pragma unroll
        for (int ks = 0; ks < 4; ++ks) { const bf16x8 xa = *(const LAS bf16x8*)(XBh + fr * S5_XS + 32 * ks + 8 * fq);
            yacc[b] = __builtin_amdgcn_mfma_f32_16x16x32_bf16(cfr[ks], xa, yacc[b], 0, 0, 0); }
        }
        LDS_WAIT();
    }
    if (P1) ((float2*)((P.ws + F.z) + WS_S5E))[((size_t)(DIR * NCH + c) * 32 + g) * 64 + lane] = make_float2(x[0], x[1]);
}
__device__ __forceinline__ void s5_pass1_fast(const Frame& F, const Args& P, int l, const int jb) {
    LAS float* BUb = (LAS float*)(F.lds + F.wave * S5_LDS); LAS bf16* XBh = (LAS bf16*)(BUb + 16 * S5_BUS);
    const bf16* PROJ = (const bf16*)((P.ws + F.z) + WS_PROJ);
    const int lane = F.lane, fr = lane & 15, fq = lane >> 4;
    __syncthreads();
    { const int it = jb * 8 + F.wave;
        const int g = it & 31, c = it >> 5;
        const bf16* ub = PROJ + (size_t)(c * 128 + fr) * PROJW + 4 * BW + g * 16 + 8 * (fq & 1);
        bf16x8 ua[8];
#pragma unroll
        for (int m = 0; m < 8; ++m) ua[m] = *(const bf16x8*)(ub + (size_t)m * 16 * PROJW);
        bf16x8 cfr[4];
#pragma unroll
        for (int ks = 0; ks < 4; ++ks) cfr[ks] = ua[ks];
        f32x4 yacc[8];
#pragma unroll
        for (int b = 0; b < 8; ++b) yacc[b] = (f32x4){0.f, 0.f, 0.f, 0.f};
        s5_p2_dir<0, true>(F, P, l, g, c, BUb, XBh, ua, cfr, yacc);
        s5_p2_dir<1, true>(F, P, l, g, c, BUb, XBh, ua, cfr, yacc);
    }
}
__device__ __forceinline__ void s5_pass2(const Frame& F, const Args& P, int l, const int jb) {
    LAS float* BUb = (LAS float*)(F.lds + F.wave * S5_LDS); LAS bf16* XBh = (LAS bf16*)(BUb + 16 * S5_BUS);
    const bf16* PROJ = (const bf16*)((P.ws + F.z) + WS_PROJ); bf16* S5Y = (bf16*)((P.ws + F.z) + WS_S5Y);
    const int lane = F.lane, fr = lane & 15, fq = lane >> 4;
    __syncthreads();
    { const int it = jb * 8 + F.wave;
        const int g = it & 31, c = it >> 5;
        const bf16* ub = PROJ + (size_t)(c * 128 + fr) * PROJW + 4 * BW + g * 16 + 8 * (fq & 1);
        bf16x8 ua[8];
#pragma unroll
        for (int m = 0; m < 8; ++m) ua[m] = *(const bf16x8*)(ub + (size_t)m * 16 * PROJW);
        const bf16* cw = (const bf16*)((P.ws + F.z) + WS_S5CW) + ((size_t)(l * 32 + g) * 16 + fr) * 128 + 8 * fq;
        bf16x8 cfr[4];
#pragma unroll
        for (int ks = 0; ks < 4; ++ks) cfr[ks] = *(const bf16x8*)(cw + 32 * ks);
        f32x4 yacc[8];
#pragma unroll
        for (int b = 0; b < 8; ++b) yacc[b] = (f32x4){0.f, 0.f, 0.f, 0.f};
        s5_p2_dir<0, false>(F, P, l, g, c, BUb, XBh, ua, cfr, yacc);
        s5_p2_dir<1, false>(F, P, l, g, c, BUb, XBh, ua, cfr, yacc);
        const f32x4 dd = *(const f32x4*)(P.in[I_S5D + F.z] + (size_t)l * BW + g * 16 + 4 * fq);
#pragma unroll
        for (int b = 0; b < 8; ++b) { const int t = 16 * b + fr;
            const u32x2 uw = *(const u32x2*)(PROJ + (size_t)(c * 128 + t) * PROJW + 4 * BW + g * 16 + 4 * fq);
            u32x2 w; w.x = pk2(gelu_tanh(yacc[b].x + dd.x * bflo(uw.x)), gelu_tanh(yacc[b].y + dd.y * bfhi(uw.x))); w.y = pk2(gelu_tanh(yacc[b].z + dd.z * bflo(uw.y)), gelu_tanh(yacc[b].w + dd.w * bfhi(uw.y)));
            *(u32x2*)(S5Y + (size_t)(c * 128 + t) * BW + g * 16 + 4 * fq) = w; }
    }
}

__device__ __forceinline__ void m1_phase(const Frame& F, const Args& P, int l) {
    constexpr int NB = NCH * 4;
    for (int k = 0; k * F.G < 3 * NB; ++k) {
        const int idx = k * F.G + (F.bid + 64 * k) % F.G;
        if (idx < NB) { const Frame Fi = relaunder(F); gmlp_phase(Fi, P, l, idx); }
        else if (idx < 2 * NB) { const Frame Fi = relaunder(F); ret_kv_phase(Fi, P, l, idx - NB); }
        else if (idx < 3 * NB) { const Frame Fi = relaunder(F); s5_pass1_fast(Fi, P, l, idx - 2 * NB); }
    }
    { const Frame Fi = relaunder(F); conv_phase(Fi, P, l, Fi.bid, Fi.G); }
}
__device__ __forceinline__ void m1_phase_b(const Frame& F, const Args& P, int l) {
    constexpr int NB = NCH * 4; const int goff = (l + 1 < DEPTH) ? 0 : 8;
    for (int k = 0; k < 3; ++k) {
        const int idx = k * 256 + (F.bid + 64 * k) % 256;
        if (idx < NB) { for (int rr = 0; rr < PREPS(52); ++rr) { const Frame Fi = relaunder(F); ret_kv_phase(Fi, P, l, idx); } }
        else if (idx < NB + 240) { for (int rr = 0; rr < PREPS(51); ++rr) { const Frame Fi = relaunder(F); gmlp_phase(Fi, P, l, idx - NB + goff); } }
        else { for (int rr = 0; rr < PREPS(53); ++rr) { const Frame Fi = relaunder(F); s5_pass1_fast(Fi, P, l, idx - 240 - NB); } }
    }
}
__device__ __forceinline__ void m3_phase_b(const Frame& F, const Args& P, int l) {
    const bool last = !(l + 1 < DEPTH); const int skip = last ? 8 : 0, NB = NCH * 4 - skip, tot = 2 * NB + (last ? 0 : 24);
    for (int k = 0; k * 256 < tot; ++k) {
        const int idx = k * 256 + (F.bid + 64 * k) % 256;
        if (idx < NB) { for (int rr = 0; rr < PREPS(54); ++rr) { const Frame Fi = relaunder(F); ret_out_phase(Fi, P, l, idx + skip); } }
        else if (idx < 2 * NB) { for (int rr = 0; rr < PREPS(55); ++rr) { const Frame Fi = relaunder(F); s5_pass2(Fi, P, l, idx - NB + skip); } }
        else if (idx < tot) { const Frame Fi = relaunder(F); gmlp_phase(Fi, P, l, 240 + idx - 2 * NB); }
    }
    if (last) { __syncthreads(); const Frame Fc = relaunder(F); convert_tiles(Fc, P, l, CT_L3B, CT_W2, Fc.gw, Fc.NGW); }
    if (!last) {
        const int b = F.bid;
        if (b < 128 || b >= 168) { const Frame Fi = relaunder(F); conv_phase(Fi, P, l, b < 128 ? b : b - 40, 216);
            __syncthreads(); const Frame Fc = relaunder(F); convert_tiles(Fc, P, l, CT_C, CT_END, (Fc.bid < 128 ? Fc.bid : Fc.bid - 40) * NWAVES + Fc.wave, 216 * NWAVES); }
    }
}
__device__ __forceinline__ void glu_extra_b(const Frame& F, const Args& P, int l) {
    if (F.bid >= 66 && F.bid < 82) { const Frame Fi = relaunder(F); gmlp_phase(Fi, P, l, 248 + Fi.bid - 66); }
    else if (F.bid >= 82) { const Frame Fi = relaunder(F); conv_phase(Fi, P, l, Fi.bid - 82, 174); }
}
__device__ __forceinline__ void m3_phase(const Frame& F, const Args& P, int l) {
    const int skip = (l + 1 < DEPTH) ? 0 : 8, NB = NCH * 4 - skip;
    for (int k = 0; k * F.G < 2 * NB; ++k) {
        const int idx = k * F.G + (F.bid + 64 * k) % F.G;
        if (idx < NB) { const Frame Fi = relaunder(F); ret_out_phase(Fi, P, l, idx + skip); }
        else if (idx < 2 * NB) { const Frame Fi = relaunder(F); s5_pass2(Fi, P, l, idx - NB + skip); }
    }
}
constexpr int NSTEP = 12, NPHASE = 2 + DEPTH * NSTEP + 1;
#ifndef PROBE_KIND
#define PROBE_KIND -1
#endif
#ifdef EXP_NOSPLIT
#define NPART(x) 0
#else
#define NPART(x) (x)
#endif
#define REPS(k) ((PROBE_KIND == (k)) ? 2 : 1)
__global__ void __launch_bounds__(NTHR, 2) mega(Args P) {
    extern __shared__ __attribute__((aligned(16))) unsigned char lds_raw[];
    Frame F0;
    F0.lds = (LAS unsigned char*)lds_raw;
    F0.tid = 0; F0.lane = 0; F0.wave = __builtin_amdgcn_readfirstlane((int)threadIdx.x >> 6);
    F0.G = gridDim.x; F0.bid = blockIdx.x; F0.gw = F0.bid * NWAVES + F0.wave; F0.NGW = F0.G * NWAVES; F0.z = 0;
    volatile LAS unsigned* MISC = (volatile LAS unsigned*)(F0.lds + MISC_OFF);
    if (threadIdx.x < 16) MISC[threadIdx.x] = 0u;
    __syncthreads();
    XcdBarrier bar = xcd_barrier_post((unsigned*)(P.ws + WS_CTL) + 4096, MISC + 8);
    const int lo = P.ph_lo, hi = P.ph_hi;
#define IN(k) (lo <= (k) && (k) < hi)
#define SEAM(k) do { if ((k) + 1 < hi) { for (int rb_ = 0; rb_ < REPS(40); ++rb_) { XcdBarrier b2 = bar; asm volatile("" : "+s"(b2.bar)); xcd_barrier(b2); } } } while (0)
    if (IN(0)) { for (int r = 0; r < REPS(0); ++r) { const Frame F = relaunder(F0); prologue_a(F, P); SEAM(0); } }
    if (IN(1)) { const Frame F = relaunder(F0); prologue_b(F, P); SEAM(1); }
    for (int l = 0; l < DEPTH; ++l) {
        const int pb = 2 + l * NSTEP;
        if (IN(pb + 0)) { for (int r = 0; r < REPS(1); ++r) { const Frame F = relaunder(F0); norm_phase(F, P, l, P.in[I_N1G + F.z] + (size_t)l * DM, 0, 1, NPART(l > 0 ? 11 : 0), (const float*)(P.ws + F.z + WS_MOD) + (size_t)(l > 0 ? l - 1 : 0) * 2 * 12288 + 12288 + 5 * DM, l == 0 ? (const void*)(P.in[I_X + F.z] - (size_t)CTXL * DM) : (const void*)(P.ws + F.z + WS_X), l == 0 ? 1 : 0, l == 0 ? (const void*)P.in[I_CTX + F.z] : (const void*)(P.ws + F.z + WS_X), l == 0 ? 1 : 0, P.ws + F.z + WS_H8); SEAM(pb + 0); } }
        if (IN(pb + 1)) for (int r = 0; r < REPS(6); ++r) {
            const Frame F = relaunder(F0); unsigned char* ws = P.ws + F.z; unsigned char* lw = ws + WS_W + (size_t)l * LW_STRIDE;
            { pg8::Gemm g1{(const bf16*)(ws + WS_H), (const bf16*)(lw + LW_WIN), NR, PROJW, DM}; pg8::StaticOrder S1; S1.init(NR, PROJW, DM, F.G, F.bid);
              EpiG1 E1{(bf16*)(ws + WS_PROJ), (bf16*)(ws + WS_G), P.in[I_BMERGE + F.z] + (size_t)l * 8192, 0, (float*)(ws + WS_GST), -1.4426950408889634f};
              pg8::gemm_phase<EpiG1, pg8::StaticOrder, true, true>(F.lds, g1, S1, E1, F.tid); }
            { const Frame F2 = relaunder(F0); unsigned char* ws2 = P.ws + F2.z; unsigned char* lw2 = ws2 + WS_W + (size_t)l * LW_STRIDE;
              pg8::Gemm g2{(const bf16*)(ws2 + WS_H8), (const bf16*)(lw2 + LW_WM), NR, 8192, DM / 2};
              EpiG1 E2{(bf16*)(ws2 + WS_PROJ), (bf16*)(ws2 + WS_G), P.in[I_BMERGE + F2.z] + (size_t)l * 8192, 20, (float*)(ws2 + WS_GST), -1.4426950408889634f / 64.f};
              if (F2.G == 256) { GateOrder S2; S2.init(F2.G, F2.bid); pg8::gemm_phase<EpiG1, GateOrder, true, true, true>(F2.lds, g2, S2, E2, F2.tid); }
              else { pg8::StaticOrder S2; S2.init(NR, 8192, DM / 2, F2.G, F2.bid); pg8::gemm_phase<EpiG1, pg8::StaticOrder, true, true, true>(F2.lds, g2, S2, E2, F2.tid); } }
            SHADOW(180, 0, l < DEPTH - 1 ? CT_R0 : CT_L3A);
            SEAM(pb + 1); }
        if (IN(pb + 2)) for (int r = 0; r < REPS(2); ++r) { const Frame F = relaunder(F0); if (F.G == 256) m1_phase_b(F, P, l); else m1_phase(F, P, l); SEAM(pb + 2); }
        if (IN(pb + 3)) for (int r = 0; r < REPS(3); ++r) { const Frame F = relaunder(F0); scan_phase(F, P, l); SEAM(pb + 3); }
        if (IN(pb + 4)) for (int r = 0; r < REPS(4); ++r) { const Frame F = relaunder(F0); if (F.G == 256) m3_phase_b(F, P, l); else m3_phase(F, P, l); SEAM(pb + 4); }
        if (IN(pb + 5)) for (int r = 0; r < REPS(9); ++r) {
            const Frame F = relaunder(F0); unsigned char* ws = P.ws + F.z; unsigned char* lw = ws + WS_W + (size_t)l * LW_STRIDE;
            pg8::Gemm g{(const bf16*)(ws + WS_S5Y), (const bf16*)(lw + LW_WGLU), NR, BW, BW}; pg8::StaticOrder S; S.init(NR, BW, BW, F.G, F.bid);
            EpiGlu E{(const bf16*)(ws + WS_S5Y), (bf16*)(ws + WS_O) + (size_t)1 * NR * BW};
            pg8::gemm_phase<EpiGlu, pg8::StaticOrder, true, true>(F.lds, g, S, E, F.tid);
            if (l < DEPTH - 1) SHADOW(66, CT_R0, CT_R1);
            else if (F.G == 256) { const Frame Fg = relaunder(F0); glu_extra_b(Fg, P, l); SHADOW(82, CT_L3A, CT_L3B); }
            SEAM(pb + 5); }
        if (IN(pb + 6)) for (int r = 0; r < REPS(7); ++r) {
            const Frame F = relaunder(F0); unsigned char* ws = P.ws + F.z; unsigned char* lw = ws + WS_W + (size_t)l * LW_STRIDE;
            pg8::Gemm g{(const bf16*)(ws + WS_O), (const bf16*)(lw + LW_WB), 4 * NR, 4 * DM, BW}; YOrder S; S.init(F.G, F.bid, l + 1 < DEPTH ? 33 : 32);
            EpiY E{(bf16*)(ws + WS_YP)};
            pg8::gemm_phase<EpiY, YOrder, true, true>(F.lds, g, S, E, F.tid);
            if (l < DEPTH - 1) SHADOW(32, CT_R1, CT_R2);
            SEAM(pb + 6); }
        if (IN(pb + 7)) for (int r = 0; r < REPS(8); ++r) { const Frame F = relaunder(F0); merge_phase(F, P); SEAM(pb + 7); }
        if (IN(pb + 8)) for (int r = 0; r < REPS(10); ++r) {
            const Frame F = relaunder(F0); unsigned char* ws = P.ws + F.z; unsigned char* lw = ws + WS_W + (size_t)l * LW_STRIDE;
            const float* MOD = (const float*)(ws + WS_MOD) + (size_t)l * 2 * 12288;
            pg8::Gemm g{(const bf16*)(ws + WS_MRG), (const bf16*)(lw + LW_WO), NR, DM, DM}; SplitOrder S{F.G, F.bid, DM / 64, 4, 8, l < DEPTH - 1 ? 1 : 0};
            EpiRes E{(bf16*)(ws + WS_X), MOD + 2 * DM, (float*)(ws + WS_PART), (REPS(10) == 2 && r == 0) ? 1 : 0, l == 0 ? (const void*)(P.in[I_X + F.z] - (size_t)CTXL * DM) : (const void*)(ws + WS_X), l == 0 ? 1 : 0};
            pg8::gemm_phase<EpiRes, SplitOrder, true, true>(F.lds, g, S, E, F.tid);
            if (l < DEPTH - 1) SHADOW(32, CT_R2, CT_R3);
            SEAM(pb + 8); }
        if (IN(pb + 9)) { for (int r = 0; r < REPS(1); ++r) { const Frame F = relaunder(F0); norm_phase(F, P, l, P.in[I_N2G + F.z] + (size_t)l * DM, 3, 4, NPART(l < DEPTH - 1 ? 4 : 0), (const float*)(P.ws + F.z + WS_MOD) + (size_t)l * 2 * 12288 + 12288 + 2 * DM, (const void*)(P.ws + F.z + WS_X), 0, l == 0 ? (const void*)P.in[I_CTX + F.z] : (const void*)(P.ws + F.z + WS_X), l == 0 ? 1 : 0, nullptr); SEAM(pb + 9); } }
        if (IN(pb + 10)) for (int r = 0; r < REPS(5); ++r) {
            const Frame F = relaunder(F0); unsigned char* ws = P.ws + F.z; unsigned char* lw = ws + WS_W + (size_t)l * LW_STRIDE;
            pg8::Gemm g{(const bf16*)(ws + WS_H), (const bf16*)(lw + LW_W13), NR, 2 * DFF, DM}; pg8::StaticOrder S; S.init(NR, 2 * DFF, DM, F.G, F.bid);
            EpiFfn1 E{(bf16*)(ws + WS_T)};
            pg8::gemm_phase<EpiFfn1, pg8::StaticOrder, true, true>(F.lds, g, S, E, F.tid);
            if (l < DEPTH - 1) SHADOW(172, CT_R3, CT_R4); else SHADOW(172, CT_W2, CT_WIN);
            SEAM(pb + 10); }
        if (IN(pb + 11)) for (int r = 0; r < REPS(11); ++r) {
            const Frame F = relaunder(F0); unsigned char* ws = P.ws + F.z; unsigned char* lw = ws + WS_W + (size_t)l * LW_STRIDE;
            const float* MOD = (const float*)(ws + WS_MOD) + (size_t)l * 2 * 12288;
            pg8::Gemm g{(const bf16*)(ws + WS_T), (const bf16*)(lw + LW_W2), NR, DM, DFF}; SplitOrder S{F.G, F.bid, DFF / 64, 11, 8, l < DEPTH - 1 ? 1 : 0};
            EpiRes E{(bf16*)(ws + WS_X), MOD + 5 * DM, (float*)(ws + WS_PART), (REPS(11) == 2 && r == 0) ? 1 : 0, (const void*)(ws + WS_X), 0};
            pg8::gemm_phase<EpiRes, SplitOrder, true, true>(F.lds, g, S, E, F.tid);
            if (l < DEPTH - 1) SHADOW(88, CT_R4, CT_C);
            SEAM(pb + 11); }
    }
    if (IN(NPHASE - 1)) { const Frame F = relaunder(F0); final_norm(F, P); }
#undef IN
#undef SEAM
}

#ifndef N_LAUNCH_MODE
#define N_LAUNCH_MODE 1
#endif
extern "C" void kernel_launch(void* const* d_in, const int* in_sizes, int n_in, void* d_out, int out_size, void* d_ws, size_t ws_size, hipStream_t stream) {
    static int grid = 0;
    if (grid == 0) {
        if (n_in != N_IN || out_size != SEQ * DM || ws_size < WS_END) { fprintf(stderr, "kernel_launch: unexpected shapes n_in %d out %d ws %zu (need %zu)\n", n_in, out_size, ws_size, (size_t)WS_END); grid = -1; return; }
        int dev = 0, cus = 0;
        if (hipGetDevice(&dev) != hipSuccess || hipDeviceGetAttribute(&cus, hipDeviceAttributeMultiprocessorCount, dev) != hipSuccess) { grid = -1; return; }
        if (hipFuncSetAttribute((const void*)mega, hipFuncAttributeMaxDynamicSharedMemorySize, LDS_BYTES) != hipSuccess) { fprintf(stderr, "kernel_launch: hipFuncSetAttribute failed\n"); grid = -1; return; }
        int per_cu = 0;
        if (hipOccupancyMaxActiveBlocksPerMultiprocessor(&per_cu, (const void*)mega, NTHR, LDS_BYTES) != hipSuccess || per_cu < 1) fprintf(stderr, "kernel_launch: occupancy query says %d\n", per_cu);
        (void)hipGetLastError();
        grid = cus;
    }
    if (grid < 0) return;
    (void)hipMemsetAsync((char*)d_ws + WS_CTL, 0, CTL_ZERO, stream);
    Args a{};
    for (int i = 0; i < N_IN; ++i) a.in[i] = (const float*)d_in[i];
    a.out = (float*)d_out; a.ws = (unsigned char*)d_ws;
#if N_LAUNCH_MODE == 1
    a.ph_lo = 0; a.ph_hi = NPHASE;
    hipLaunchKernelGGL(mega, dim3(grid), dim3(NTHR), LDS_BYTES, stream, a);
#else
    for (int s = 0; s < NPHASE; ++s) { a.ph_lo = s; a.ph_hi = s + 1; hipLaunchKernelGGL(mega, dim3(grid), dim3(NTHR), LDS_BYTES, stream, a); }
#endif
}
```

```cpp
#include <hip/hip_runtime.h>
#include <cstdio>
#include <cstdint>
#define LAS __attribute__((address_space(3)))
namespace pg8 {
#define PG8_LAS __attribute__((address_space(3)))
typedef unsigned short bf16_t;
typedef short bf16x8 __attribute__((ext_vector_type(8)));
typedef float f32x4 __attribute__((ext_vector_type(4)));
typedef unsigned u32x4 __attribute__((ext_vector_type(4)));
typedef int i32x4 __attribute__((ext_vector_type(4))); typedef int i32x8 __attribute__((ext_vector_type(8)));
constexpr int BM = 256, BK = 64, HALF = 128, HTB = HALF * BK * 2  , STAGE_BYTES = 8 * HTB, NXCD = 8, WGM = 3;

__host__ __device__ __forceinline__ int lds_byte(int r, int c) { const int st = (r >> 4) * 2 + (c >> 5), rr = r & 15, cc = c & 31, ob = rr * 64 + cc * 2; return st * 1024 + (ob ^ (((ob >> 9) & 1) << 5)); }
__host__ __device__ __forceinline__ void stage_rc(int b, int& R, int& C) { const int st = b / 1024, sb = b % 1024, swz = sb ^ (((sb >> 9) & 1) << 5); R = (st >> 1) * 16 + swz / 64; C = (st & 1) * 32 + (swz % 64) / 2; }
__host__ __device__ __forceinline__ int perm32(int rho) { const int n = rho >> 4, i = rho & 15; return 8 * (i >> 2) + 4 * n + (i & 3); }

struct Unit { int pm, pn, k0, nt; };
struct Gemm { const bf16_t* A; const bf16_t* Bt; int M, N, K; };

struct StaticOrder {
    int nM, nN, nwg, G, c, nt;
    __host__ __device__ void init(int M, int N, int K, int G_, int c_) { nM = M / BM; nN = N / BM; nwg = nM * nN; G = G_; c = c_; nt = K / BK; }
    __host__ __device__ bool next(int i, Unit& u) const {
        const long L = (long)i * G + c; if (L >= nwg) return false;
        int wgid = (int)L; { const int q = nwg / NXCD, r = nwg % NXCD, xcd = wgid % NXCD, off = wgid / NXCD; wgid = (xcd < r ? xcd * (q + 1) : r * (q + 1) + (xcd - r) * q) + off; }
        const int nig = WGM * nN, gid = wgid / nig, fm = gid * WGM, gsz = (nM - fm) < WGM ? (nM - fm) : WGM;
        u.pm = fm + ((wgid % nig) % gsz); u.pn = (wgid % nig) / gsz; u.k0 = 0; u.nt = nt; return true;
    }
    __device__ __forceinline__ void a_ready(const Unit&) const {}
    __device__ __forceinline__ void done(const Unit&) const {}
};

typedef float f32x2_cv __attribute__((ext_vector_type(2))); typedef __bf16 bf16x2_cv __attribute__((ext_vector_type(2)));
__device__ __forceinline__ unsigned cvt_pk_bf16(float lo, float hi) { f32x2_cv v = {lo, hi}; bf16x2_cv b = __builtin_convertvector(v, bf16x2_cv); return __builtin_bit_cast(unsigned, b); }
typedef float f32x2 __attribute__((ext_vector_type(2)));
template <class Epi, class Sched, bool ALIGN_EPI = false, bool SP2 = false, bool F8 = false>
__device__ __forceinline__ void gemm_phase(PG8_LAS unsigned char* lds, const Gemm g, const Sched& S, const Epi& E, const int tid_in) {
    int tid_l = tid_in; asm volatile("" : "+v"(tid_l));
    const int tid = tid_l, wid = __builtin_amdgcn_readfirstlane(tid >> 6), lane = tid & 63, wr = wid >> 2, wc = wid & 3, fr = lane & 15, fq = lane >> 4;
    const int K = g.K;
    unsigned voffA[2], voffB[2];
#pragma unroll
    for (int i = 0; i < 2; ++i) { int R, C; stage_rc(tid * 16 + i * 8192, R, C); const int Rb = Epi::PERM ? ((R & ~31) + perm32(R & 31)) : R;
        voffA[i] = (unsigned)(R * K + C) * 2u; voffB[i] = (unsigned)(Rb * K + C) * 2u; }
    const size_t kstep = (size_t)(BK * 2);
    const size_t hstep = (size_t)HALF * K * 2;
    const size_t tstep = 2 * hstep;
    const unsigned ldsw = (unsigned)wid * 1024u;
    const int aoff = lds_byte(wr * 64 + fr, fq * 8), boff = lds_byte(wc * 32 + fr, fq * 8);
#define PG8_SA(b, h) (((b) * 2 + (h)) * HTB)
#define PG8_SB(b, h) ((4 + (b) * 2 + (h)) * HTB)
#define PG8_STAGE(bufoff, gbase, voff) do { _Pragma("unroll") for (int _i = 0; _i < 2; ++_i) \
        __builtin_amdgcn_global_load_lds((const unsigned*)((const char*)(gbase) + (voff)[_i]), (PG8_LAS unsigned*)(lds + (bufoff) + ldsw + _i * 8192), 16, 0, 0); } while (0)
#define PG8_LDA(dst, b, h) do { _Pragma("unroll") for (int m = 0; m < 4; ++m) _Pragma("unroll") for (int k = 0; k < 2; ++k) dst[m][k] = *(const PG8_LAS bf16x8*)(lds + PG8_SA(b, h) + aoff + m * 2048 + k * 1024); } while (0)
#define PG8_LDB(dst, b, h) do { _Pragma("unroll") for (int n = 0; n < 2; ++n) _Pragma("unroll") for (int k = 0; k < 2; ++k) dst[n][k] = *(const PG8_LAS bf16x8*)(lds + PG8_SB(b, h) + boff + n * 2048 + k * 1024); } while (0)
#define PG8_MMA(ai, bj, At, Bt) do { __builtin_amdgcn_s_setprio(1); _Pragma("unroll") for (int m = 0; m < 4; ++m) _Pragma("unroll") for (int n = 0; n < 2; ++n) _Pragma("unroll") for (int k = 0; k < 2; ++k) \
        acc[ai][bj][m][n] = __builtin_amdgcn_mfma_f32_16x16x32_bf16(Bt[n][k], At[m][k], acc[ai][bj][m][n], 0, 0, 0); __builtin_amdgcn_s_setprio(0); } while (0)
#define PG8_MMA8(ai, bj, At, Bt) do { __builtin_amdgcn_s_setprio(1); _Pragma("unroll") for (int m = 0; m < 4; ++m) _Pragma("unroll") for (int n = 0; n < 2; ++n) { \
        const i32x4 a0_ = __builtin_bit_cast(i32x4, At[m][0]), a1_ = __builtin_bit_cast(i32x4, At[m][1]), b0_ = __builtin_bit_cast(i32x4, Bt[n][0]), b1_ = __builtin_bit_cast(i32x4, Bt[n][1]); \
        const i32x8 a8_ = __builtin_shufflevector(a0_, a1_, 0, 1, 2, 3, 4, 5, 6, 7), b8_ = __builtin_shufflevector(b0_, b1_, 0, 1, 2, 3, 4, 5, 6, 7); \
        asm volatile("v_mfma_scale_f32_16x16x128_f8f6f4 %0, %1, %2, %0, %3, %3 op_sel_hi:[0,0,0]" : "+v"(acc[ai][bj][m][n]) : "v"(b8_), "v"(a8_), "v"(sc8_)); } __builtin_amdgcn_s_setprio(0); } while (0)
#define PG8_MM(ai, bj, At, Bt) do { if constexpr (F8) PG8_MMA8(ai, bj, At, Bt); else PG8_MMA(ai, bj, At, Bt); } while (0)
#define PG8_WAIT_V(n) asm volatile("s_waitcnt vmcnt(" #n ")" ::: "memory")
#define PG8_WAIT_L(n) asm volatile("s_waitcnt lgkmcnt(" #n ")" ::: "memory")
#define PG8_BAR __builtin_amdgcn_s_barrier()
#define PG8_SCHED __builtin_amdgcn_sched_barrier(0)
    int sc8_ = 0x7f7f7f7f; asm volatile("" : "+v"(sc8_));
    Unit cur, nxt; int ui = 0;
    if (!S.next(0, cur)) return;
    f32x4 acc[2][2][4][2];
#pragma unroll
    for (int a = 0; a < 2; ++a)
#pragma unroll
        for (int b = 0; b < 2; ++b)
#pragma unroll
            for (int m = 0; m < 4; ++m)
#pragma unroll
                for (int n = 0; n < 2; ++n) acc[a][b][m][n] = (f32x4){0.f, 0.f, 0.f, 0.f};
    bf16x8 At[4][2], B0[2][2], B1[2][2];
    const char* cA = (const char*)g.A + (size_t)cur.pm * tstep + (size_t)cur.k0 * 2; const char* cB = (const char*)g.Bt + (size_t)cur.pn * tstep + (size_t)cur.k0 * 2;
    S.a_ready(cur);
    if constexpr (SP2) {
        PG8_STAGE(PG8_SB(0, 0), cB, voffB); PG8_STAGE(PG8_SB(0, 1), cB + hstep, voffB); PG8_STAGE(PG8_SA(0, 0), cA, voffA); PG8_STAGE(PG8_SA(0, 1), cA + hstep, voffA);
        if (wr == 1) PG8_BAR;
        PG8_WAIT_V(2); PG8_BAR;
        PG8_STAGE(PG8_SB(1, 0), cB + kstep, voffB); PG8_STAGE(PG8_SA(1, 0), cA + kstep, voffA); PG8_STAGE(PG8_SB(1, 1), cB + hstep + kstep, voffB);
        PG8_WAIT_V(6); PG8_BAR;
    } else {
        PG8_STAGE(PG8_SB(0, 0), cB, voffB); PG8_STAGE(PG8_SA(0, 0), cA, voffA); PG8_STAGE(PG8_SB(0, 1), cB + hstep, voffB); PG8_STAGE(PG8_SA(0, 1), cA + hstep, voffA);
        if (wr == 1) PG8_BAR;
        PG8_WAIT_V(4); PG8_BAR;
        PG8_STAGE(PG8_SB(1, 0), cB + kstep, voffB); PG8_STAGE(PG8_SA(1, 0), cA + kstep, voffA); PG8_STAGE(PG8_SB(1, 1), cB + hstep + kstep, voffB);
        PG8_WAIT_V(6); PG8_BAR;
    }
    for (;;) {
        const bool has_next = S.next(ui + 1, nxt);
        const char* nA = has_next ? (const char*)g.A + (size_t)nxt.pm * tstep + (size_t)nxt.k0 * 2 : cA; const char* nB = has_next ? (const char*)g.Bt + (size_t)nxt.pn * tstep + (size_t)nxt.k0 * 2 : cB;
        const int nt = cur.nt;
        for (int t = 0; t < nt; t += 2) {
            const bool last = (t == nt - 2);
            const char* a1 = cA + (size_t)(t + 1) * kstep;
            const char* a2 = last ? nA : cA + (size_t)(t + 2) * kstep; const char* b2 = last ? nB : cB + (size_t)(t + 2) * kstep;
            const char* a3 = a2 + kstep; const char* b3 = b2 + kstep;
            if (last && has_next) S.a_ready(nxt);
            if constexpr (SP2) {
            PG8_LDB(B0, 0, 0); PG8_LDB(B1, 0, 1); PG8_SCHED; PG8_LDA(At, 0, 0); PG8_STAGE(PG8_SA(1, 1), a1 + hstep, voffA);
            PG8_WAIT_V(8); PG8_WAIT_L(0); PG8_BAR; PG8_MM(0, 0, At, B0); PG8_MM(0, 1, At, B1); PG8_BAR; PG8_SCHED;
            PG8_LDA(At, 0, 1); PG8_STAGE(PG8_SB(0, 0), b2, voffB); PG8_STAGE(PG8_SB(0, 1), b2 + hstep, voffB); PG8_STAGE(PG8_SA(0, 0), a2, voffA);
            PG8_WAIT_V(8); PG8_WAIT_L(0); PG8_BAR; PG8_MM(1, 0, At, B0); PG8_MM(1, 1, At, B1); PG8_BAR; PG8_SCHED;
            PG8_LDB(B0, 1, 0); PG8_LDB(B1, 1, 1); PG8_SCHED; PG8_LDA(At, 1, 0); PG8_STAGE(PG8_SA(0, 1), a2 + hstep, voffA);
            PG8_WAIT_V(8); PG8_WAIT_L(0); PG8_BAR; PG8_MM(0, 0, At, B0); PG8_MM(0, 1, At, B1); PG8_BAR; PG8_SCHED;
            PG8_LDA(At, 1, 1); PG8_STAGE(PG8_SB(1, 0), b3, voffB); PG8_STAGE(PG8_SB(1, 1), b3 + hstep, voffB); PG8_STAGE(PG8_SA(1, 0), a3, voffA);
            PG8_WAIT_V(8); PG8_WAIT_L(0); PG8_BAR; PG8_MM(1, 0, At, B0); PG8_MM(1, 1, At, B1); PG8_BAR; PG8_SCHED;
            } else {
            PG8_LDB(B0, 0, 0); PG8_SCHED; PG8_LDA(At, 0, 0); PG8_STAGE(PG8_SA(1, 1), a1 + hstep, voffA);
            PG8_WAIT_L(8); PG8_BAR; PG8_WAIT_L(0); PG8_MM(0, 0, At, B0); PG8_BAR; PG8_SCHED;
            PG8_LDB(B1, 0, 1); PG8_STAGE(PG8_SB(0, 0), b2, voffB);
            PG8_BAR; PG8_WAIT_L(0); PG8_MM(0, 1, At, B1); PG8_BAR;
            PG8_LDA(At, 0, 1); PG8_STAGE(PG8_SA(0, 0), a2, voffA);
            PG8_BAR; PG8_WAIT_L(0); PG8_MM(1, 0, At, B0); PG8_BAR; PG8_SCHED;
            PG8_STAGE(PG8_SB(0, 1), b2 + hstep, voffB);
            PG8_WAIT_V(6); PG8_BAR; PG8_MM(1, 1, At, B1); PG8_BAR;
            PG8_LDB(B0, 1, 0); PG8_SCHED; PG8_LDA(At, 1, 0); PG8_STAGE(PG8_SA(0, 1), a2 + hstep, voffA);
            PG8_WAIT_L(8); PG8_BAR; PG8_WAIT_L(0); PG8_MM(0, 0, At, B0); PG8_BAR; PG8_SCHED;
            PG8_LDB(B1, 1, 1); PG8_STAGE(PG8_SB(1, 0), b3, voffB);
            PG8_BAR; PG8_WAIT_L(0); PG8_MM(0, 1, At, B1); PG8_BAR;
            PG8_LDA(At, 1, 1); PG8_STAGE(PG8_SA(1, 0), a3, voffA);
            PG8_BAR; PG8_WAIT_L(0); PG8_MM(1, 0, At, B0); PG8_BAR; PG8_SCHED;
            PG8_STAGE(PG8_SB(1, 1), b3 + hstep, voffB);
            PG8_WAIT_V(6); PG8_BAR; PG8_MM(1, 1, At, B1); PG8_BAR;
            }
        }
        if constexpr (ALIGN_EPI) { if (wr == 0) PG8_BAR; }
        if constexpr (!Epi::AFTER_DRAIN) { E(acc, cur, wr, wc, fr, fq); S.done(cur); }
        if (!has_next) break;
#pragma unroll
        for (int a = 0; a < 2; ++a)
#pragma unroll
            for (int b = 0; b < 2; ++b)
#pragma unroll
                for (int m = 0; m < 4; ++m)
#pragma unroll
                    for (int n = 0; n < 2; ++n) acc[a][b][m][n] = (f32x4){0.f, 0.f, 0.f, 0.f};
        cur = nxt; cA = nA; cB = nB; ++ui;
        if constexpr (ALIGN_EPI) { if (wr == 1) PG8_BAR; }
    }
    PG8_WAIT_V(0);
    if constexpr (!ALIGN_EPI) { if (wr == 0) PG8_BAR; }
    PG8_BAR;
    if constexpr (Epi::AFTER_DRAIN) { E.fused(acc, cur, wr, wc, fr, fq, lds, wid, lane); S.done(cur); }
#undef PG8_SA
#undef PG8_SB
#undef PG8_STAGE
#undef PG8_LDA
#undef PG8_LDB
#undef PG8_MMA
#undef PG8_MMA8
#undef PG8_MM
#undef PG8_WAIT_V
#undef PG8_WAIT_L
#undef PG8_BAR
#undef PG8_SCHED
}
}
#define XB_TMO      128
#define XB_XCNT(j)  (256  + 64 * (j))
#define XB_XSUB(j)  (1280 + 64 * (j))
#define XB_XGEN(j)  (2304 + 64 * (j))
#define XB_TOP      3328
#define XB_TOPGEN   3392
#define XCD_BAR_WORDS 3456
#define XB_SPIN_CAP (1u << 18)

__device__ __forceinline__ unsigned xb_ld(unsigned* p)              { return __hip_atomic_load(p, __ATOMIC_RELAXED, __HIP_MEMORY_SCOPE_AGENT); }
__device__ __forceinline__ unsigned xb_add(unsigned* p, unsigned v) { return __hip_atomic_fetch_add(p, v, __ATOMIC_RELAXED, __HIP_MEMORY_SCOPE_AGENT); }
__device__ __forceinline__ unsigned xb_xcc_id() { return (unsigned)__builtin_amdgcn_s_getreg((3 << 11) | 20) & 0xFu; }
#define XB_SPIN(cond, bar) do { unsigned _sp = 0; while (cond) { __builtin_amdgcn_s_sleep(1); \
    if ((++_sp & 255u) == 0u) { if (xb_ld(&(bar)[XB_TMO])) break; if (_sp > XB_SPIN_CAP) { atomicAdd(&(bar)[XB_TMO], 1u); break; } } } } while (0)

struct XcdBarrier {
    unsigned* bar; unsigned x; unsigned w;
    volatile LAS unsigned* st;
};

__device__ __forceinline__ XcdBarrier xcd_barrier_post(unsigned* bar, volatile LAS unsigned* st) {
    XcdBarrier b; b.bar = bar; b.x = xb_xcc_id(); b.st = st; b.w = (unsigned)__builtin_amdgcn_readfirstlane((int)(threadIdx.x >> 6));
    if (threadIdx.x == 0) (void)xb_add(&bar[XB_XCNT(b.x)], 1u);
    return b;
}
__device__ __forceinline__ void xcd_barrier_complete(unsigned* bar, unsigned x, unsigned& nloc, unsigned& nx) {
    const unsigned G = gridDim.x * gridDim.y * gridDim.z;
    unsigned sum, cnt, mine, sp = 0u;
    for (;;) {
        sum = 0u; cnt = 0u; mine = 0u;
#pragma unroll
        for (unsigned j = 0; j < 16; ++j) { const unsigned c = xb_ld(&bar[XB_XCNT(j)]); sum += c; cnt += (c > 0u) ? 1u : 0u; mine = (j == x) ? c : mine; }
        if (sum == G) break;
        __builtin_amdgcn_s_sleep(1);
        if ((++sp & 255u) == 0u) { if (xb_ld(&bar[XB_TMO])) break; if (sp > XB_SPIN_CAP) { atomicAdd(&bar[XB_TMO], 1u); break; } }
    }
    nloc = mine > 0u ? mine : 1u; nx = cnt > 0u ? cnt : 1u;
}

__device__ __forceinline__ void xcd_barrier(const XcdBarrier& b) {
    asm volatile("s_waitcnt vmcnt(0)" ::: "memory");
    __syncthreads();
    if (b.w == 0u && __builtin_amdgcn_mbcnt_hi(~0u, __builtin_amdgcn_mbcnt_lo(~0u, 0u)) == 0u) {
        unsigned* bar = b.bar;
        __builtin_amdgcn_s_waitcnt(0);
        unsigned nloc = b.st[0], nx = b.st[1];
        if (nloc == 0u) { xcd_barrier_complete(bar, b.x, nloc, nx); b.st[0] = nloc; b.st[1] = nx; }
        const unsigned old = xb_add(&bar[XB_XSUB(b.x)], 1u);
        const unsigned gen = old / nloc;
        if (old + 1u == (gen + 1u) * nloc) {
            __builtin_amdgcn_fence(__ATOMIC_RELEASE, "agent");
            asm volatile("s_waitcnt vmcnt(0)" ::: "memory");
            const unsigned og = xb_add(&bar[XB_TOP], 1u);
            const unsigned tg = og / nx;
            if (og + 1u == (tg + 1u) * nx) xb_add(&bar[XB_TOPGEN], 1u);
            else XB_SPIN(xb_ld(&bar[XB_TOPGEN]) == tg, bar);
            __builtin_amdgcn_fence(__ATOMIC_ACQUIRE, "agent");
            xb_add(&bar[XB_XGEN(b.x)], 1u);
            asm volatile("s_waitcnt vmcnt(0)" ::: "memory");
        } else {
            XB_SPIN(xb_ld(&bar[XB_XGEN(b.x)]) == gen, bar);
            __builtin_amdgcn_fence(__ATOMIC_ACQUIRE, "agent");
            asm volatile("s_waitcnt vmcnt(0)" ::: "memory");
        }
    }
    __syncthreads();
}

typedef unsigned short bf16;
typedef short bf16x8 __attribute__((ext_vector_type(8)));
typedef float f32x4 __attribute__((ext_vector_type(4)));
typedef unsigned u32x4 __attribute__((ext_vector_type(4)));
typedef unsigned u32x2 __attribute__((ext_vector_type(2)));
typedef float f32x2 __attribute__((ext_vector_type(2)));

constexpr int DM = 2048, SEQ = 8192, CTXL = 256, NR = SEQ + CTXL, DEPTH = 4, BW = 512, PROJW = 5120, DFF = 5632;
constexpr int NCH = NR / 128;
constexpr float EPS = 1e-6f;
constexpr int NWAVES = 8, NTHR = 512;
constexpr int LDT = 136;

constexpr size_t WS_CTL = 0, CTL_BYTES = 1u << 20, CTL_ZERO = 32768;
constexpr size_t LW_WIN = 0;
constexpr size_t LW_WM  = LW_WIN + (size_t)PROJW * DM * 2;
constexpr size_t LW_WB  = LW_WM + (size_t)8192 * DM * 2;
constexpr size_t LW_WO  = LW_WB + (size_t)4 * DM * BW * 2;
constexpr size_t LW_W13 = LW_WO + (size_t)DM * DM * 2;
constexpr size_t LW_W2  = LW_W13 + (size_t)2 * DFF * DM * 2;
constexpr size_t LW_WGLU = LW_W2 + (size_t)DM * DFF * 2;
constexpr size_t LW_WS  = LW_WGLU + (size_t)BW * BW * 2;
constexpr size_t LW_STRIDE = LW_WS + (size_t)4 * 128 * 128 * 2;
constexpr size_t WS_W = CTL_BYTES;
constexpr size_t WS_X = WS_W + DEPTH * LW_STRIDE;
constexpr size_t WS_H = WS_X + (size_t)NR * DM * 4;
constexpr size_t WS_PROJ = WS_H + (size_t)NR * DM * 2;
constexpr size_t WS_O = WS_PROJ + (size_t)NR * PROJW * 2;
constexpr size_t WS_YP = WS_O + (size_t)4 * NR * BW * 2;
constexpr size_t WS_T = WS_YP;
constexpr size_t WS_G = WS_YP + (size_t)NR * 8192 * 2;
constexpr size_t WS_MRG = WS_G + (size_t)NR * 8192 * 2;
constexpr size_t WS_PART = WS_MRG + (size_t)NR * DM * 2;
constexpr size_t WS_S5Y = WS_PART + (size_t)11 * 256 * DM * 4;
constexpr size_t WS_KVT = WS_S5Y + (size_t)NR * BW * 2;
constexpr size_t WS_ST = WS_KVT + (size_t)2 * NCH * 4 * 16384 * 4;
constexpr size_t WS_S5E = WS_ST + (size_t)2 * NCH * 4 * 16384 * 2;
constexpr size_t WS_S5XS = WS_S5E + (size_t)2 * NCH * 32 * 64 * 8;
constexpr size_t WS_MODP = WS_S5XS + (size_t)2 * NCH * 32 * 64 * 8;
constexpr size_t WS_MOD = WS_MODP + (size_t)32 * 4 * 2 * 12288 * 4;
constexpr size_t WS_COS = WS_MOD + (size_t)4 * 2 * 12288 * 4;
constexpr size_t WS_SIN = WS_COS + (size_t)SEQ * 64 * 4;
constexpr size_t WS_S5AB = WS_SIN + (size_t)SEQ * 64 * 4;
constexpr size_t WS_S5AL = WS_S5AB + (size_t)4 * 2 * 32 * 64 * 8;
constexpr size_t WS_S5BW = WS_S5AL + (size_t)4 * 2 * 32 * 64 * 8;
constexpr size_t WS_S5CW = WS_S5BW + (size_t)4 * 2 * 32 * 128 * 32 * 2;
constexpr size_t WS_S5BB = WS_S5CW + (size_t)4 * 32 * 16 * 128 * 2;
constexpr size_t WS_GST = WS_S5BB + (size_t)4 * 2 * 32 * 64 * 16 * 8;
constexpr size_t WS_H8 = WS_GST + (size_t)NR * 8 * 8;
constexpr size_t WS_END = WS_H8 + (size_t)NR * DM;

constexpr int MISC_OFF = 143360, LDS_BYTES = 147456;

enum { I_X = 0, I_C, I_CTX, I_CCTX, I_ADAW, I_ADAB, I_N1G, I_N2G, I_WIN, I_DECAY, I_S5ARE, I_S5AIM, I_S5BRE, I_S5BIM, I_S5CRE, I_S5CIM, I_S5D, I_S5LDT,
       I_WGLU, I_CONVW, I_LNG, I_LNB, I_CWS, I_CBS, I_WBR, I_WMERGE, I_BMERGE, I_WOUT, I_W1, I_W3, I_W2, I_FNG, N_IN };

struct Args { const float* in[N_IN]; float* out; unsigned char* ws; int ph_lo, ph_hi; };

struct Frame { LAS unsigned char* lds; int tid, lane, wave, G, gw, NGW, bid, z; };
__device__ __forceinline__ int lane_id() { return (int)__builtin_amdgcn_mbcnt_hi(~0u, __builtin_amdgcn_mbcnt_lo(~0u, 0u)); }
__device__ __forceinline__ Frame relaunder(const Frame& F0) { Frame F = F0; int w = F0.wave, z = 0, b = F0.bid, g = F0.G; asm volatile("" : "+s"(w), "+s"(z), "+s"(b), "+s"(g)); int ln = lane_id(); asm volatile("" : "+v"(ln)); F.wave = w; F.lane = ln; F.tid = w * 64 + ln; F.z = z; F.bid = b; F.G = g; F.gw = b * 8 + w; F.NGW = g * 8; return F; }

#define LDS_WAIT() asm volatile("s_waitcnt lgkmcnt(0)" ::: "memory")

__device__ __forceinline__ unsigned f2bf(float f) { unsigned u = __builtin_bit_cast(unsigned, f); return (u + 0x7fffu + ((u >> 16) & 1u)) >> 16; }
__device__ __forceinline__ unsigned pk2(float lo, float hi) { return pg8::cvt_pk_bf16(lo, hi); }
__device__ __forceinline__ float bflo(unsigned w) { return __builtin_bit_cast(float, w << 16); }
__device__ __forceinline__ float bfhi(unsigned w) { return __builtin_bit_cast(float, w & 0xffff0000u); }
__device__ __forceinline__ float bf2f(bf16 b) { return __builtin_bit_cast(float, (unsigned)b << 16); }
__device__ __forceinline__ void unpack8(const u32x4 w, float (&f)[8]) {
    f[0] = bflo(w.x); f[1] = bfhi(w.x); f[2] = bflo(w.y); f[3] = bfhi(w.y); f[4] = bflo(w.z); f[5] = bfhi(w.z); f[6] = bflo(w.w); f[7] = bfhi(w.w); }
__device__ __forceinline__ u32x4 pack8(const float (&f)[8]) { u32x4 w; w.x = pk2(f[0], f[1]); w.y = pk2(f[2], f[3]); w.z = pk2(f[4], f[5]); w.w = pk2(f[6], f[7]); return w; }
__device__ __forceinline__ float wave_sum(float v) {
#pragma unroll
    for (int o = 1; o < 64; o <<= 1) v += __shfl_xor(v, o);
    return v;
}
__device__ __forceinline__ float sigmoid_fast(float x) { return __builtin_amdgcn_rcpf(1.f + __builtin_amdgcn_exp2f(-1.4426950408889634f * x)); }
__device__ __forceinline__ float silu_fast(float x) { return x * sigmoid_fast(x); }
__device__ __forceinline__ f32x4 sig4_t(const f32x4 t) { f32x4 e; e[0] = __builtin_amdgcn_exp2f(t[0]); e[1] = __builtin_amdgcn_exp2f(t[1]); e[2] = __builtin_amdgcn_exp2f(t[2]); e[3] = __builtin_amdgcn_exp2f(t[3]);
    const f32x4 d = e + 1.f; f32x4 r; r[0] = __builtin_amdgcn_rcpf(d[0]); r[1] = __builtin_amdgcn_rcpf(d[1]); r[2] = __builtin_amdgcn_rcpf(d[2]); r[3] = __builtin_amdgcn_rcpf(d[3]); return r; }
__device__ __forceinline__ float gelu_tanh(float x) { const float t = x * (x * x * -0.10294324f + -2.3022082f); return x * __builtin_amdgcn_rcpf(1.f + __builtin_amdgcn_exp2f(t)); }
__device__ __forceinline__ float silu_acc(float x) { return x / (1.f + expf(-x)); }

template <int NT>
__device__ __forceinline__ void mma_nt(f32x4 (&acc)[NT], const LAS bf16* A, int lda, const LAS bf16* Bt, int ldb, int K, int lane) {
    const int fr = lane & 15, fq = lane >> 4;
    const LAS bf16* ap = A + fr * lda + 8 * fq;
    const LAS bf16* bp = Bt + fr * ldb + 8 * fq;
    for (int k0 = 0; k0 < K; k0 += 32) {
        const bf16x8 a = *(const LAS bf16x8*)(ap + k0);
#pragma unroll
        for (int n = 0; n < NT; ++n) {
            const bf16x8 b = *(const LAS bf16x8*)(bp + n * 16 * ldb + k0);
            acc[n] = __builtin_amdgcn_mfma_f32_16x16x32_bf16(b, a, acc[n], 0, 0, 0);
        }
    }
}

#ifndef PROBE_KIND
#define PROBE_KIND -1
#endif
#define PREPS(k) ((PROBE_KIND == (k)) ? 2 : 1)
struct RowId { __device__ __forceinline__ int operator()(int n) const { return n; } };
template <int M> struct RowW13 { __device__ __forceinline__ int operator()(int n) const { const int pn = n >> 7, o = n & 127; const int wc = o >> 5, fq = (o >> 3) & 3, bj = (o >> 2) & 1, i = o & 3;
    return 256 * pn + 128 * bj + 32 * wc + 16 * M + 4 * fq + i; } };
template <class RowMap>
__device__ __forceinline__ void transpose2(const Frame& F, const float* src, size_t ldsrc, int K, int N, bf16* dst, int ld_dst, const RowMap rm, int lo, int hi, int wid, int nw) {
    LAS bf16* t = (LAS bf16*)(F.lds + F.wave * 16384);
    const int nblk = N / 64, lane = F.lane, q = lane >> 4, n4 = 4 * (lane & 15);
    for (int it = lo + wid; it < hi; it += nw) {
        const int kb = it / nblk, nb = it % nblk, k0 = 64 * kb, n0 = 64 * nb;
        const float* sp = src + (size_t)(k0 + 16 * q) * ldsrc + n0 + n4;
        f32x4 v[16];
#pragma unroll
        for (int r = 0; r < 16; ++r) v[r] = *(const f32x4*)(sp + (size_t)r * ldsrc);
#pragma unroll
        for (int rq = 0; rq < 4; ++rq)
#pragma unroll
            for (int j = 0; j < 4; ++j) { u32x2 w; w.x = pk2(v[4 * rq][j], v[4 * rq + 1][j]); w.y = pk2(v[4 * rq + 2][j], v[4 * rq + 3][j]);
                *(LAS u32x2*)(t + (n4 + j) * 72 + 16 * q + 4 * rq) = w; }
        LDS_WAIT();
#pragma unroll
        for (int j = 0; j < 8; ++j) { const int n = (lane >> 3) + 8 * j, c = lane & 7;
            *(u32x4*)(dst + (size_t)rm(n0 + n) * ld_dst + k0 + 8 * c) = *(const LAS u32x4*)(t + n * 72 + 8 * c); }
        LDS_WAIT();
    }
}

__device__ __forceinline__ unsigned pk_e4m3(float a, float b, float c, float d) { int w = __builtin_amdgcn_cvt_pk_fp8_f32(a, b, 0, false); w = __builtin_amdgcn_cvt_pk_fp8_f32(c, d, w, true); return (unsigned)w; }
__device__ __forceinline__ void transpose8(const Frame& F, const float* src, size_t ldsrc, int K, int N, unsigned char* dst, int ld_dst, float scale, int lo, int hi, int wid, int nw) {
    LAS unsigned char* t = (LAS unsigned char*)(F.lds + F.wave * 16384);
    const int nblk = N / 64, lane = F.lane, q = lane >> 4, n4 = 4 * (lane & 15);
    for (int it = lo + wid; it < hi; it += nw) {
        const int kb = it / nblk, nb = it % nblk, k0 = 64 * kb, n0 = 64 * nb;
        const float* sp = src + (size_t)(k0 + 16 * q) * ldsrc + n0 + n4;
        f32x4 v[16];
#pragma unroll
        for (int r = 0; r < 16; ++r) v[r] = *(const f32x4*)(sp + (size_t)r * ldsrc) * scale;
#pragma unroll
        for (int j = 0; j < 4; ++j) { u32x4 w;
            w.x = pk_e4m3(v[0][j], v[1][j], v[2][j], v[3][j]); w.y = pk_e4m3(v[4][j], v[5][j], v[6][j], v[7][j]); w.z = pk_e4m3(v[8][j], v[9][j], v[10][j], v[11][j]); w.w = pk_e4m3(v[12][j], v[13][j], v[14][j], v[15][j]);
            *(LAS u32x4*)(t + (n4 + j) * 80 + 16 * q) = w; }
        LDS_WAIT();
#pragma unroll
        for (int c = 0; c < 4; ++c) *(u32x4*)(dst + (size_t)(n0 + lane) * ld_dst + k0 + 16 * c) = *(const LAS u32x4*)(t + lane * 80 + 16 * c);
        LDS_WAIT();
    }
}
constexpr int CT_WB = 0, CT_WO = CT_WB + 4 * 8 * 32, CT_W1 = CT_WO + 32 * 32, CT_W3 = CT_W1 + 32 * 88, CT_W2 = CT_W3 + 32 * 88, CT_WIN = CT_W2 + 88 * 32, CT_WM = CT_WIN + 32 * 80, CT_WG = CT_WM + 32 * 128, CT_END = CT_WG + 64;
__device__ __forceinline__ void convert_tiles(const Frame& F, const Args& P, int l, int a, int b, int wid, int nw) {
#define CT_SEG(off, cnt, call) do { const int lo_ = (a > (off) ? a : (off)) - (off), hi_ = (b < (off) + (cnt) ? b : (off) + (cnt)) - (off); if (lo_ < hi_) { const int lo = lo_, hi = hi_; call; } } while (0)
    if (l >= 0 && a < CT_WIN) {
        unsigned char* lw = (P.ws + F.z) + WS_W + (size_t)l * LW_STRIDE;
#pragma unroll 1
        for (int k = 0; k < 4; ++k)
            CT_SEG(CT_WB + k * 256, 256, transpose2(F, P.in[I_WBR + F.z] + ((size_t)l * 4 + k) * BW * DM, DM, BW, DM, (bf16*)(lw + LW_WB) + (size_t)k * DM * BW, BW, RowId{}, lo, hi, wid, nw));
        CT_SEG(CT_WO, 32 * 32, transpose2(F, P.in[I_WOUT + F.z] + (size_t)l * DM * DM, DM, DM, DM, (bf16*)(lw + LW_WO), DM, RowId{}, lo, hi, wid, nw));
        CT_SEG(CT_W1, 32 * 88, transpose2(F, P.in[I_W1 + F.z] + (size_t)l * DM * DFF, DFF, DM, DFF, (bf16*)(lw + LW_W13), DM, RowW13<0>{}, lo, hi, wid, nw));
        CT_SEG(CT_W3, 32 * 88, transpose2(F, P.in[I_W3 + F.z] + (size_t)l * DM * DFF, DFF, DM, DFF, (bf16*)(lw + LW_W13), DM, RowW13<1>{}, lo, hi, wid, nw));
        CT_SEG(CT_W2, 88 * 32, transpose2(F, P.in[I_W2 + F.z] + (size_t)l * DFF * DM, DM, DFF, DM, (bf16*)(lw + LW_W2), DFF, RowId{}, lo, hi, wid, nw));
    }
    if (l + 1 < DEPTH && b > CT_WIN) {
        const int l1 = l + 1; unsigned char* lw = (P.ws + F.z) + WS_W + (size_t)l1 * LW_STRIDE;
        CT_SEG(CT_WIN, 32 * 80, transpose2(F, P.in[I_WIN + F.z] + (size_t)l1 * DM * PROJW, PROJW, DM, PROJW, (bf16*)(lw + LW_WIN), DM, RowId{}, lo, hi, wid, nw));
        CT_SEG(CT_WM, 32 * 128, transpose8(F, P.in[I_WMERGE + F.z] + (size_t)l1 * DM * 8192, 8192, DM, 8192, lw + LW_WM, DM, 64.f, lo, hi, wid, nw));
        CT_SEG(CT_WG, 64, transpose2(F, P.in[I_WGLU + F.z] + (size_t)l1 * BW * BW, BW, BW, BW, (bf16*)(lw + LW_WGLU), BW, RowId{}, lo, hi, wid, nw));
    }
#undef CT_SEG
}
#ifndef CT_G1P
#define CT_G1P 4816
#endif
#ifndef CT_GLU
#define CT_GLU 2200
#endif
#ifndef CT_YP
#define CT_YP 1800
#endif
#ifndef CT_WOP
#define CT_WOP 2600
#endif
#ifndef CT_F1P
#define CT_F1P 3800
#endif
#ifndef CT_F2P
#define CT_F2P 2000
#endif
constexpr int CT_R0 = CT_G1P, CT_R1 = CT_R0 + CT_GLU, CT_R2 = CT_R1 + CT_YP, CT_R3 = CT_R2 + CT_WOP, CT_R4 = CT_R3 + CT_F1P, CT_C = CT_R4 + CT_F2P;
static_assert(CT_C <= CT_END, "shadow conversion ranges exceed a layer's tile list");
#define SHADOW(first, lo, hi) do { if (F.G == 256 && F.bid >= (first)) { const Frame Fc = relaunder(F0); convert_tiles(Fc, P, l, (lo), (hi), (Fc.bid - (first)) * NWAVES + Fc.wave, (Fc.G - (first)) * NWAVES); } } while (0)
constexpr int CT_L3A = CT_W2 - 1800, CT_L3B = CT_W2;
static_assert(CT_L3B <= CT_W2 && CT_R0 >= CT_W1 && CT_R3 >= CT_W2 && CT_R4 >= CT_WIN, "conversion deadlines");

__device__ __forceinline__ void prologue_a(const Frame& F, const Args& P) {
    unsigned char* ws = (P.ws + F.z);
    for (int l = 0; l < DEPTH; ++l) {
        if (l == 0) convert_tiles(F, P, -1, CT_WIN, CT_END, F.gw, F.NGW);
        if (F.G != 256) convert_tiles(F, P, l, 0, CT_END, F.gw, F.NGW);
        unsigned char* lw = ws + WS_W + (size_t)l * LW_STRIDE;
        { const float* s = P.in[I_CWS + F.z] + (size_t)l * 4 * 128 * 128; bf16* d = (bf16*)(lw + LW_WS);
          for (int i = F.bid * NTHR + F.tid; i < 4 * 128 * 128; i += F.G * NTHR) d[i] = (bf16)f2bf(s[i]); }
    }
    __syncthreads();
    {
        LAS float* sl = (LAS float*)F.lds; LAS float* sc = sl + DM;
        for (int i = F.tid; i < DM; i += NTHR) { sl[i] = silu_acc(P.in[I_C + F.z][i]); sc[i] = silu_acc(P.in[I_CCTX + F.z][i]); }
        __syncthreads();
        float* MODP = (float*)(ws + WS_MODP);
        for (int rr = 0; rr < PREPS(31); ++rr)
        for (int it = F.bid; it < 4 * 6 * 32; it += F.G) {
            const int l = it / 192, r = it % 192, jb = r >> 5, sli = r & 31, j = jb * 2048 + 4 * F.tid, i0 = sli * 64;
            const float* w = P.in[I_ADAW + F.z] + ((size_t)l * DM + i0) * 12288 + j;
            f32x4 a0 = (f32x4){0.f, 0.f, 0.f, 0.f}, a1 = a0;
#pragma unroll 32
            for (int i = 0; i < 64; ++i) { const f32x4 wv = *(const f32x4*)(w + (size_t)i * 12288); a0 = a0 + wv * sl[i0 + i]; a1 = a1 + wv * sc[i0 + i]; }
            *(f32x4*)(MODP + ((size_t)(sli * 4 + l) * 2 + 0) * 12288 + j) = a0; *(f32x4*)(MODP + ((size_t)(sli * 4 + l) * 2 + 1) * 12288 + j) = a1;
        }
    }
    const int gt = F.bid * NTHR + F.tid, GT = F.G * NTHR;
    for (int rr = 0; rr < PREPS(32); ++rr)
    for (int idx = gt; idx < 4 * 2 * 32 * 128; idx += GT) {
        const int n = idx & 127, p = n >> 1, ri = n & 1, g = (idx >> 7) & 31, dir = (idx >> 12) & 1, l = idx >> 13;
        const float a_re = P.in[I_S5ARE + F.z][(l * 32 + g) * 64 + p], a_im = P.in[I_S5AIM + F.z][(l * 32 + g) * 64 + p];
        const float dt = expf(P.in[I_S5LDT + F.z][(l * 2 + dir) * 32 + g]);
        const float mag = expf(dt * a_re), ang = dt * a_im, abr = mag * cosf(ang), abi = mag * sinf(ang);
        const float nr = abr - 1.f, ni = abi, den = a_re * a_re + a_im * a_im;
        const float fre = (nr * a_re + ni * a_im) / den, fim = (ni * a_re - nr * a_im) / den;
        const size_t bi = ((size_t)((l * 2 + dir) * 32 + g) * 64 + p) * 16;
        const float* bre = P.in[I_S5BRE + F.z] + bi; const float* bim = P.in[I_S5BIM + F.z] + bi;
        bf16* bw = (bf16*)(ws + WS_S5BW) + (size_t)idx * 32;
        float* bbf = (float*)(ws + WS_S5BB) + ((size_t)(((l * 2 + dir) * 32 + g) * 64 + p) * 16) * 2 + ri;
        f32x4 brv[4], biv[4];
#pragma unroll
        for (int c4 = 0; c4 < 4; ++c4) { brv[c4] = *(const f32x4*)(bre + 4 * c4); biv[c4] = *(const f32x4*)(bim + 4 * c4); }
#pragma unroll
        for (int c = 0; c < 16; ++c) { const float br_ = brv[c >> 2][c & 3], bi_ = biv[c >> 2][c & 3]; const float v = ri ? (fre * bi_ + fim * br_) : (fre * br_ - fim * bi_);
            bbf[2 * c] = v;
            const unsigned hi = f2bf(v); const float hf = __builtin_bit_cast(float, hi << 16); bw[c] = (bf16)hi; bw[16 + c] = (bf16)f2bf(v - hf); }
        if (ri == 0) { const int i2 = ((l * 2 + dir) * 32 + g) * 64 + p;
            ((float2*)(ws + WS_S5AB))[i2] = make_float2(abr, abi);
            float pr = abr, pi = abi;
            for (int s2 = 0; s2 < 7; ++s2) { const float t = pr * pr - pi * pi; pi = 2.f * pr * pi; pr = t; }
            ((float2*)(ws + WS_S5AL))[i2] = make_float2(pr, pi); }
    }
    for (int rr = 0; rr < PREPS(32); ++rr)
    for (int idx = gt; idx < 4 * 32 * 16 * 128; idx += GT) {
        const int n = idx & 127, p = n >> 1, ch = (idx >> 7) & 15, lg = idx >> 11;
        const size_t ci = ((size_t)lg * 16 + ch) * 64 + p;
        ((bf16*)(ws + WS_S5CW))[idx] = (bf16)f2bf((n & 1) ? -P.in[I_S5CIM + F.z][ci] : P.in[I_S5CRE + F.z][ci]);
    }
    {
        float* COS = (float*)(ws + WS_COS); float* SIN = (float*)(ws + WS_SIN);
        for (int idx = gt; idx < 192 * 32; idx += GT) {
            const int r = idx >> 5, j = idx & 31;
            const float fr = expf(-((float)j / 32.f) * 9.210340371976184f);
            const float ang = (float)(r < 128 ? r : r - 128) * fr;
            COS[idx] = cosf(ang); SIN[idx] = sinf(ang);
        }
    }
}
__device__ __forceinline__ void prologue_b(const Frame& F, const Args& P) {
    const float* MODP = (const float*)((P.ws + F.z) + WS_MODP); float* MOD = (float*)((P.ws + F.z) + WS_MOD);
    for (int idx = F.bid * NTHR + F.tid; idx < 4 * 2 * 12288; idx += F.G * NTHR) {
        const int l = idx / 24576, j = idx % 12288;
        float s = P.in[I_ADAB + F.z][l * 12288 + j];
        float pv[32];
#pragma unroll
        for (int k = 0; k < 32; ++k) pv[k] = MODP[(size_t)k * 98304 + idx];
#pragma unroll
        for (int k = 0; k < 32; ++k) s += pv[k];
        MOD[idx] = s;
    }
}

__device__ __forceinline__ void load_row(f32x4 (&v)[8], const void* base, int f32src, size_t row, int lane) {
    if (f32src) {
#pragma unroll
        for (int j = 0; j < 8; ++j) v[j] = *((const f32x4*)((const float*)base + row * DM) + lane + 64 * j);
    } else {
        u32x2 w[8];
#pragma unroll
        for (int j = 0; j < 8; ++j) w[j] = *((const u32x2*)((const bf16*)base + row * DM) + lane + 64 * j);
#pragma unroll
        for (int j = 0; j < 8; ++j) { v[j].x = __uint_as_float(w[j].x << 16); v[j].y = __uint_as_float(w[j].x & 0xffff0000u); v[j].z = __uint_as_float(w[j].y << 16); v[j].w = __uint_as_float(w[j].y & 0xffff0000u); }
    }
}
__device__ __forceinline__ void norm_phase(const Frame& F, const Args& P, int l, const float* gvec, int ish, int isc, int npart, const float* gate_ctx, const void* rd_lat, int lat_f32, const void* rd_ctx, int ctx_f32, unsigned char* H8) {
    LAS float* ga = (LAS float*)F.lds; LAS float* sh = ga + 2 * DM;
    LAS float* gc = sh + 2 * DM;
    if (npart > 0) for (int i = F.tid; i < DM; i += NTHR) gc[i] = gate_ctx[i];
    const float* MOD = (const float*)((P.ws + F.z) + WS_MOD) + (size_t)l * 2 * 12288;
    for (int i = F.tid; i < 2 * DM; i += NTHR) { const int s = i / DM, c = i % DM; ga[i] = gvec[c] * (1.f + MOD[s * 12288 + isc * DM + c]); sh[i] = MOD[s * 12288 + ish * DM + c]; }
    __syncthreads();
    bf16* X = (bf16*)((P.ws + F.z) + WS_X); bf16* H = (bf16*)((P.ws + F.z) + WS_H); const float* PART = (const float*)((P.ws + F.z) + WS_PART);
    f32x4 vn[8];
    if (F.gw < NR) { if (F.gw < CTXL) load_row(vn, rd_ctx, ctx_f32, F.gw, F.lane); else load_row(vn, rd_lat, lat_f32, F.gw, F.lane); }
    for (int row = F.gw; row < NR; row += F.NGW) {
        const int s = row < CTXL ? 1 : 0;
        f32x4 v[8]; float ss = 0.f;
#pragma unroll
        for (int j = 0; j < 8; ++j) v[j] = vn[j];
        if (row + F.NGW < NR) load_row(vn, rd_lat, lat_f32, row + F.NGW, F.lane);
        if (row < CTXL && npart > 0) {
            u32x2* xr = (u32x2*)(X + (size_t)row * DM) + F.lane;
#pragma unroll
            for (int j = 0; j < 8; ++j) { f32x4 pv[11];
#pragma unroll
                for (int q = 0; q < 11; ++q) pv[q] = q < npart ? *((const f32x4*)(PART + ((size_t)q * 256 + row) * DM) + F.lane + 64 * j) : (f32x4){0.f, 0.f, 0.f, 0.f};
                f32x4 a = pv[0];
#pragma unroll
                for (int q = 1; q < 11; ++q) a = a + pv[q];
                v[j] = v[j] + a * *(const LAS f32x4*)(gc + 4 * F.lane + 256 * j); u32x2 w; w.x = pk2(v[j].x, v[j].y); w.y = pk2(v[j].z, v[j].w); xr[64 * j] = w; }
        }
#pragma unroll
        for (int j = 0; j < 8; ++j) { ss += (v[j].x * v[j].x + v[j].y * v[j].y) + (v[j].z * v[j].z + v[j].w * v[j].w); }
        const float rstd = 1.f / sqrtf(wave_sum(ss) * (1.f / DM) + EPS);
        u32x2* o = (u32x2*)(H + (size_t)row * DM) + F.lane;
#pragma unroll
        for (int j = 0; j < 8; ++j) { const f32x4 g4 = *(const LAS f32x4*)(ga + s * DM + 4 * F.lane + 256 * j), s4 = *(const LAS f32x4*)(sh + s * DM + 4 * F.lane + 256 * j);
            const f32x4 y = v[j] * rstd * g4 + s4;
            u32x2 w; w.x = pk2(y.x, y.y); w.y = pk2(y.z, y.w); o[64 * j] = w;
            if (H8 != nullptr) ((unsigned*)(H8 + (size_t)row * DM))[F.lane + 64 * j] = pk_e4m3(y.x, y.y, y.z, y.w); }
    }
}
__device__ __forceinline__ void final_norm(const Frame& F, const Args& P) {
    const bf16* X = (const bf16*)((P.ws + F.z) + WS_X); const float* g = P.in[I_FNG + F.z];
    f32x4 vn[8];
    if (CTXL + F.gw < NR) load_row(vn, X, 0, CTXL + F.gw, F.lane);
    for (int row = CTXL + F.gw; row < NR; row += F.NGW) {
        f32x4 v[8]; float ss = 0.f;
#pragma unroll
        for (int j = 0; j < 8; ++j) v[j] = vn[j];
        if (row + F.NGW < NR) load_row(vn, X, 0, row + F.NGW, F.lane);
#pragma unroll
        for (int j = 0; j < 8; ++j) ss += (v[j].x * v[j].x + v[j].y * v[j].y) + (v[j].z * v[j].z + v[j].w * v[j].w);
        const float rstd = 1.f / sqrtf(wave_sum(ss) * (1.f / DM) + EPS);
        f32x4* o = (f32x4*)(P.out + (size_t)(row - CTXL) * DM) + F.lane;
#pragma unroll
        for (int j = 0; j < 8; ++j) { const f32x4 g4 = *((const f32x4*)g + F.lane + 64 * j); o[64 * j] = v[j] * rstd * g4; }
    }
}

using pg8::Unit;
__device__ __forceinline__ unsigned q8(float g) { return (unsigned)(g * 255.f + 0.5f); }
struct EpiG1 {
    static constexpr bool PERM = true, AFTER_DRAIN = false;
    bf16* PROJ; bf16* G; const float* bias; int pn_off; float* GST; float gsc;
    __device__ __forceinline__ void operator()(const f32x4 (&acc)[2][2][4][2], const Unit& u0, int wr, int wc, int fr, int fq) const {
        Unit u = u0; u.pn += pn_off;
        const int row0 = u.pm * 256 + wr * 64 + fr;
        if (u.pn < 20) {
            const int col0 = u.pn * 256 + wc * 32 + 8 * fq;
#pragma unroll
            for (int ai = 0; ai < 2; ++ai)
#pragma unroll
                for (int m = 0; m < 4; ++m) { bf16* rowp = PROJ + (size_t)(row0 + ai * 128 + m * 16) * PROJW + col0;
#pragma unroll
                    for (int bj = 0; bj < 2; ++bj) { const f32x4 v0 = acc[ai][bj][m][0], v1 = acc[ai][bj][m][1];
                        u32x4 w; w.x = pg8::cvt_pk_bf16(v0[0], v0[1]); w.y = pg8::cvt_pk_bf16(v0[2], v0[3]); w.z = pg8::cvt_pk_bf16(v1[0], v1[1]); w.w = pg8::cvt_pk_bf16(v1[2], v1[3]);
                        *(u32x4*)(rowp + bj * 128) = w; } }
            if (u.pn == 18 || u.pn == 19) {
#pragma unroll
                for (int ai = 0; ai < 2; ++ai)
#pragma unroll
                    for (int m = 0; m < 4; ++m) { float s = 0.f, s2 = 0.f;
#pragma unroll
                        for (int bj = 0; bj < 2; ++bj)
#pragma unroll
                            for (int n = 0; n < 2; ++n)
#pragma unroll
                                for (int i = 0; i < 4; i += 2) { const unsigned pw = pg8::cvt_pk_bf16(acc[ai][bj][m][n][i], acc[ai][bj][m][n][i + 1]); const float g0 = gelu_tanh(bflo(pw)), g1 = gelu_tanh(bfhi(pw)); s += g0 + g1; s2 += g0 * g0 + g1 * g1; }
                        s += __shfl_xor(s, 16); s += __shfl_xor(s, 32); s2 += __shfl_xor(s2, 16); s2 += __shfl_xor(s2, 32);
                        if (fq == 0) *(f32x2*)(GST + ((size_t)(row0 + ai * 128 + m * 16) * 8 + (u.pn - 18) * 4 + wc) * 2) = (f32x2){s, s2}; }
            }
        } else {
            const int col0 = (u.pn - 20) * 256 + wc * 32 + 8 * fq;
            f32x4 bv[2][2];
#pragma unroll
            for (int bj = 0; bj < 2; ++bj)
#pragma unroll
                for (int n = 0; n < 2; ++n) bv[bj][n] = *(const f32x4*)(bias + col0 + bj * 128 + 4 * n) * -1.4426950408889634f;
#pragma unroll
            for (int ai = 0; ai < 2; ++ai)
#pragma unroll
                for (int m = 0; m < 4; ++m) { unsigned char* rowp = (unsigned char*)G + (size_t)(row0 + ai * 128 + m * 16) * 8192 + col0;
#pragma unroll
                    for (int bj = 0; bj < 2; ++bj) { const f32x4 g0 = sig4_t(acc[ai][bj][m][0] * gsc + bv[bj][0]) * 255.f + 0.5f, g1 = sig4_t(acc[ai][bj][m][1] * gsc + bv[bj][1]) * 255.f + 0.5f;
                        u32x2 w; w.x = (unsigned)g0[0] | ((unsigned)g0[1] << 8) | ((unsigned)g0[2] << 16) | ((unsigned)g0[3] << 24);
                        w.y = (unsigned)g1[0] | ((unsigned)g1[1] << 8) | ((unsigned)g1[2] << 16) | ((unsigned)g1[3] << 24);
                        *(u32x2*)(rowp + bj * 128) = w; } }
        }
    }
};
struct EpiY {
    static constexpr bool PERM = true, AFTER_DRAIN = false;
    bf16* Y;
    __device__ __forceinline__ void operator()(const f32x4 (&acc)[2][2][4][2], const Unit& u, int wr, int wc, int fr, int fq) const {
        const int k = u.pn >> 3; const int row0 = (u.pm - 33 * k) * 256 + wr * 64 + fr, col0 = u.pn * 256 + wc * 32 + 8 * fq;
#pragma unroll
        for (int ai = 0; ai < 2; ++ai)
#pragma unroll
            for (int m = 0; m < 4; ++m) { bf16* rowp = Y + (size_t)(row0 + ai * 128 + m * 16) * 8192 + col0;
#pragma unroll
                for (int bj = 0; bj < 2; ++bj) { const f32x4 v0 = acc[ai][bj][m][0], v1 = acc[ai][bj][m][1];
                    u32x4 w; w.x = pg8::cvt_pk_bf16(v0[0], v0[1]); w.y = pg8::cvt_pk_bf16(v0[2], v0[3]); w.z = pg8::cvt_pk_bf16(v1[0], v1[1]); w.w = pg8::cvt_pk_bf16(v1[2], v1[3]);
                    *(u32x4*)(rowp + bj * 128) = w; } }
    }
};
struct EpiGlu {
    static constexpr bool PERM = true, AFTER_DRAIN = false;
    const bf16* S5Y; bf16* O1;
    __device__ __forceinline__ void operator()(const f32x4 (&acc)[2][2][4][2], const Unit& u, int wr, int wc, int fr, int fq) const {
        const int row0 = u.pm * 256 + wr * 64 + fr, col0 = u.pn * 256 + wc * 32 + 8 * fq;
#pragma unroll
        for (int ai = 0; ai < 2; ++ai)
#pragma unroll
            for (int m = 0; m < 4; ++m) { const size_t ro = (size_t)(row0 + ai * 128 + m * 16) * BW + col0;
#pragma unroll
                for (int bj = 0; bj < 2; ++bj) { const f32x4 v0 = acc[ai][bj][m][0], v1 = acc[ai][bj][m][1];
                    const u32x4 yw = *(const u32x4*)(S5Y + ro + bj * 128); float y[8]; unpack8(yw, y);
                    float o[8];
#pragma unroll
                    for (int i = 0; i < 4; ++i) { o[i] = sigmoid_fast(v0[i]) * y[i]; o[4 + i] = sigmoid_fast(v1[i]) * y[4 + i]; }
                    u32x4 w; w.x = pg8::cvt_pk_bf16(o[0], o[1]); w.y = pg8::cvt_pk_bf16(o[2], o[3]); w.z = pg8::cvt_pk_bf16(o[4], o[5]); w.w = pg8::cvt_pk_bf16(o[6], o[7]);
                    *(u32x4*)(O1 + ro + bj * 128) = w; } }
    }
};
struct EpiRes {
    static constexpr bool PERM = true, AFTER_DRAIN = false;
    bf16* X; const float* g_lat; float* PART; int dry; const void* Xr; int xr_f32;
    template <bool F32>
    __device__ __forceinline__ void latent(const f32x4 (&acc)[2][2][4][2], int row0, int col0) const {
        f32x4 gv[2][2];
#pragma unroll
        for (int bj = 0; bj < 2; ++bj)
#pragma unroll
            for (int n = 0; n < 2; ++n) gv[bj][n] = *(const f32x4*)(g_lat + col0 + bj * 128 + n * 4);
#pragma unroll
        for (int ai = 0; ai < 2; ++ai)
#pragma unroll
            for (int m = 0; m < 4; ++m) { const size_t off = (size_t)(row0 + ai * 128 + m * 16) * DM + col0;
#pragma unroll
                for (int bj = 0; bj < 2; ++bj) { f32x4 x0, x1;
                    if (F32) { const float* p = (const float*)Xr + off + bj * 128; x0 = *(const f32x4*)p; x1 = *(const f32x4*)(p + 4); }
                    else { const u32x4 r = *(const u32x4*)((const bf16*)Xr + off + bj * 128); float a[8]; unpack8(r, a); x0 = (f32x4){a[0], a[1], a[2], a[3]}; x1 = (f32x4){a[4], a[5], a[6], a[7]}; }
                    x0 = x0 + gv[bj][0] * acc[ai][bj][m][0]; x1 = x1 + gv[bj][1] * acc[ai][bj][m][1];
                    u32x4 w; w.x = pg8::cvt_pk_bf16(x0[0], x0[1]); w.y = pg8::cvt_pk_bf16(x0[2], x0[3]); w.z = pg8::cvt_pk_bf16(x1[0], x1[1]); w.w = pg8::cvt_pk_bf16(x1[2], x1[3]);
                    *(u32x4*)(X + off + bj * 128) = w; } }
    }
    __device__ __forceinline__ void operator()(const f32x4 (&acc)[2][2][4][2], const Unit& u, int wr, int wc, int fr, int fq) const {
        const int row0 = u.pm * 256 + wr * 64 + fr, col0 = u.pn * 256 + wc * 32 + 8 * fq;
        if (dry) return;
#ifdef EXP_NOSPLIT
        if (false) {
#else
        if (u.pm == 0) {
#endif
            float* base = PART + (size_t)(u.k0 / (u.nt * 64)) * 256 * DM;
#pragma unroll
            for (int ai = 0; ai < 2; ++ai)
#pragma unroll
                for (int m = 0; m < 4; ++m) { float* rowp = base + (size_t)(row0 + ai * 128 + m * 16) * DM + col0;
#pragma unroll
                    for (int bj = 0; bj < 2; ++bj)
#pragma unroll
                        for (int n = 0; n < 2; ++n) *(f32x4*)(rowp + bj * 128 + n * 4) = acc[ai][bj][m][n]; }
        } else {
            if (xr_f32) latent<true>(acc, row0, col0); else latent<false>(acc, row0, col0);
        }
    }
};
struct EpiFfn1 {
    static constexpr bool PERM = false, AFTER_DRAIN = false;
    bf16* T;
    __device__ __forceinline__ void operator()(const f32x4 (&acc)[2][2][4][2], const Unit& u, int wr, int wc, int fr, int fq) const {
        const int row0 = u.pm * 256 + wr * 64 + fr, col0 = u.pn * 128 + wc * 32 + 8 * fq;
#pragma unroll
        for (int ai = 0; ai < 2; ++ai)
#pragma unroll
            for (int m = 0; m < 4; ++m) { bf16* rowp = T + (size_t)(row0 + ai * 128 + m * 16) * DFF + col0;
                float o[8];
#pragma unroll
                for (int bj = 0; bj < 2; ++bj)
#pragma unroll
                    for (int i = 0; i < 4; ++i) o[4 * bj + i] = 0.f;
#pragma unroll
                for (int bj = 0; bj < 2; ++bj) { const f32x4 a = acc[ai][bj][m][0]; const f32x4 r = (a * acc[ai][bj][m][1]) * sig4_t(a * -1.4426950408889634f); o[4 * bj] = r[0]; o[4 * bj + 1] = r[1]; o[4 * bj + 2] = r[2]; o[4 * bj + 3] = r[3]; }
                u32x4 w; w.x = pg8::cvt_pk_bf16(o[0], o[1]); w.y = pg8::cvt_pk_bf16(o[2], o[3]); w.z = pg8::cvt_pk_bf16(o[4], o[5]); w.w = pg8::cvt_pk_bf16(o[6], o[7]);
                *(u32x4*)rowp = w; }
    }
};
struct YOrder {
    pg8::StaticOrder S; int rows;
    __device__ void init(int G, int c, int rows_) { rows = rows_; S.init(4 * rows_ * 256, DM, BW, G, c); }
    __device__ bool next(int i, Unit& u) const { if (!S.next(i, u)) return false; const int k = u.pm / rows, r = u.pm - k * rows; u.pm = k * 33 + (33 - rows) + r; u.pn += k * 8; return true; }
    __device__ __forceinline__ void a_ready(const Unit&) const {}
    __device__ __forceinline__ void done(const Unit&) const {}
};

struct GateOrder {
    pg8::StaticOrder S, S5; int c;
    __device__ void init(int G, int c_) { c = c_; S.init(NR, 8192, DM / 2, G, c_); S5.init(NR, 8192, DM / 2, G, c_ - 148); }
    __device__ bool next(int i, Unit& u) const { if (i < 4) return S.next(i, u); if (i == 4 && c >= 148 && c < 180) return S5.next(4, u); return false; }
    __device__ __forceinline__ void a_ready(const Unit&) const {}
    __device__ __forceinline__ void done(const Unit&) const {}
};
struct SplitOrder {
    int G, c, nt_full, nsl, nt_sl, ctx;
    __device__ bool next(int i, Unit& u) const {
        const long L = (long)i * G + c;
        if (L < 256) { const int w = (int)L, x = w & 7, o = w >> 3;
            u.pm = 1 + x * 4 + (o & 3); u.pn = o >> 2; u.k0 = 0; u.nt = nt_full; return true; }
        const int j = (int)(L - 256);
#ifdef EXP_NOSPLIT
        if (ctx && j < 8) { u.pm = 0; u.pn = j; u.k0 = 0; u.nt = nt_full; return true; }
#else
        if (ctx && j < 8 * nsl) { u.pm = 0; u.pn = j & 7; u.k0 = (j >> 3) * nt_sl * 64; u.nt = nt_sl; return true; }
#endif
        return false;
    }
    __device__ __forceinline__ void a_ready(const Unit&) const {}
    __device__ __forceinline__ void done(const Unit&) const {}
};

__device__ __forceinline__ float log2_sigmoid(float x) { return -log1pf(expf(-x)) * 1.4426950408889634f; }
__device__ __forceinline__ float dec_lg(const Frame& F, const Args& P, int l, int dir, int h) { return log2_sigmoid(P.in[I_DECAY + F.z][(l * 2 + dir) * 4 + h]); }

__device__ __forceinline__ int rope_idx(int pos, int j0) { return ((j0 < 32) ? (pos >> 6) : 128 + (pos & 63)) * 32 + (j0 & 31); }
template <bool TRANS>
__device__ __forceinline__ void stage_qk(const Frame& F, const Args& P, LAS bf16* dst, int row0, int sec, int h, float scale) {
    const bf16* PROJ = (const bf16*)((P.ws + F.z) + WS_PROJ); const float* COS = (const float*)((P.ws + F.z) + WS_COS); const float* SIN = (const float*)((P.ws + F.z) + WS_SIN);
    const bool lat = row0 >= CTXL;
    if (!TRANS) {
#pragma unroll
        for (int rep = 0; rep < 2; ++rep) {
            const int w = F.tid + NTHR * rep, t = w >> 3, j0 = (w & 7) * 8;
            const bf16* kp = PROJ + (size_t)(row0 + t) * PROJW + sec * BW + h * 128;
            float a[8], b[8]; unpack8(*(const u32x4*)(kp + j0), a); unpack8(*(const u32x4*)(kp + 64 + j0), b);
            float o1[8], o2[8];
            if (lat) {
                const int pos = row0 + t - CTXL; const int ri = rope_idx(pos, j0); const float* cp = COS + ri; const float* sp = SIN + ri;
#pragma unroll
                for (int e = 0; e < 8; ++e) { const float c = cp[e], s = sp[e]; o1[e] = (a[e] * c - b[e] * s) * scale; o2[e] = (a[e] * s + b[e] * c) * scale; }
            } else {
#pragma unroll
                for (int e = 0; e < 8; ++e) { o1[e] = a[e] * scale; o2[e] = b[e] * scale; }
            }
            *(LAS u32x4*)(dst + t * LDT + j0) = pack8(o1); *(LAS u32x4*)(dst + t * LDT + 64 + j0) = pack8(o2);
        }
    } else {
        const int tp = F.tid >> 3, j0 = (F.tid & 7) * 8, t = 2 * tp;
        const bf16* kp = PROJ + (size_t)(row0 + t) * PROJW + sec * BW + h * 128;
        float a0[8], b0[8], a1[8], b1[8];
        unpack8(*(const u32x4*)(kp + j0), a0); unpack8(*(const u32x4*)(kp + 64 + j0), b0); unpack8(*(const u32x4*)(kp + PROJW + j0), a1); unpack8(*(const u32x4*)(kp + PROJW + 64 + j0), b1);
        if (lat) {
            const int pos = row0 + t - CTXL; const int ri = rope_idx(pos, j0), d1 = rope_idx(pos + 1, j0) - ri; const float* cp = COS + ri; const float* sp = SIN + ri;
#pragma unroll
            for (int e = 0; e < 8; ++e) { const float c0 = cp[e], s0 = sp[e], c1 = cp[d1 + e], s1 = sp[d1 + e];
                const float x0 = a0[e] * c0 - b0[e] * s0, y0 = a0[e] * s0 + b0[e] * c0, x1 = a1[e] * c1 - b1[e] * s1, y1 = a1[e] * s1 + b1[e] * c1;
                a0[e] = x0; b0[e] = y0; a1[e] = x1; b1[e] = y1; }
        }
#pragma unroll
        for (int e = 0; e < 8; ++e) { *(LAS unsigned*)(dst + (j0 + e) * LDT + t) = pk2(a0[e] * scale, a1[e] * scale); *(LAS unsigned*)(dst + (64 + j0 + e) * LDT + t) = pk2(b0[e] * scale, b1[e] * scale); }
    }
}
template <int MODE>
__device__ __forceinline__ void stage_vt(const Frame& F, const Args& P, LAS bf16* dst, LAS bf16* dst2, int row0, int h, float lg, float lg2) {
    const bf16* PROJ = (const bf16*)((P.ws + F.z) + WS_PROJ);
#pragma unroll
    for (int rep = 0; rep < 2; ++rep) {
        const int w = F.tid + NTHR * rep, tp = w >> 4, d0 = (w & 15) * 8, t = 2 * tp;
        const bf16* vp = PROJ + (size_t)(row0 + t) * PROJW + 2 * BW + h * 128 + d0;
        float v0[8], v1[8]; unpack8(*(const u32x4*)vp, v0); unpack8(*(const u32x4*)(vp + PROJW), v1);
        if (MODE == 0) {
#pragma unroll
            for (int e = 0; e < 8; ++e) *(LAS unsigned*)(dst + (d0 + e) * LDT + t) = pk2(v0[e], v1[e]);
        } else {
            const float f0 = exp2f(lg * (float)(127 - t)), f1 = exp2f(lg * (float)(126 - t)), b0 = exp2f(lg2 * (float)t), b1 = exp2f(lg2 * (float)(t + 1));
#pragma unroll
            for (int e = 0; e < 8; ++e) { *(LAS unsigned*)(dst + (d0 + e) * LDT + t) = pk2(v0[e] * f0, v1[e] * f1); *(LAS unsigned*)(dst2 + (d0 + e) * LDT + t) = pk2(v0[e] * b0, v1[e] * b1); }
        }
    }
}

__device__ __forceinline__ void ret_kv_phase(const Frame& F, const Args& P, int l, const int it) {
    LAS bf16* KT = (LAS bf16*)F.lds; LAS bf16* VF = KT + 128 * LDT; LAS bf16* VB = VF + 128 * LDT;
    float* KVT = (float*)((P.ws + F.z) + WS_KVT);
    const int fr = F.lane & 15, fq = F.lane >> 4;
    {
        const int c = it >> 2, h = it & 3, row0 = c * 128;
        __syncthreads();
        stage_qk<true>(F, P, KT, row0, 1, h, 1.f);
        stage_vt<1>(F, P, VF, VB, row0, h, dec_lg(F, P, l, 0, h), dec_lg(F, P, l, 1, h));
        __syncthreads();
        f32x4 af[8], ab[8];
#pragma unroll
        for (int n = 0; n < 8; ++n) { af[n] = (f32x4){0.f, 0.f, 0.f, 0.f}; ab[n] = (f32x4){0.f, 0.f, 0.f, 0.f}; }
        mma_nt<8>(af, VF + 16 * F.wave * LDT, LDT, KT, LDT, 128, F.lane);
        mma_nt<8>(ab, VB + 16 * F.wave * LDT, LDT, KT, LDT, 128, F.lane);
        float* of = KVT + ((((size_t)0 * NCH + c) * 4 + h) * 128 + 16 * F.wave + fr) * 128 + 4 * fq;
        float* ob = KVT + ((((size_t)1 * NCH + c) * 4 + h) * 128 + 16 * F.wave + fr) * 128 + 4 * fq;
#pragma unroll
        for (int n = 0; n < 8; ++n) { *(f32x4*)(of + 16 * n) = af[n]; *(f32x4*)(ob + 16 * n) = ab[n]; }
    }
}
__device__ __forceinline__ int bwd_chunk(int step) { return step < 2 ? 1 - step : NCH + 1 - step; }

__device__ __forceinline__ void s5_pass1(const Frame& F, const Args& P, int l) {
    LAS float* U = (LAS float*)(F.lds + F.wave * 17408);
    const bf16* PROJ = (const bf16*)((P.ws + F.z) + WS_PROJ);
    float2* E = (float2*)((P.ws + F.z) + WS_S5E);
    for (int it = F.gw; it < NCH * 32 * 2; it += F.NGW) {
        const int dir = it & 1, g = (it >> 1) & 31, c = it >> 6;
#pragma unroll
        for (int rr = 0; rr < 2; ++rr) { const int t = F.lane + 64 * rr; const bf16* up = PROJ + (size_t)(c * 128 + t) * PROJW + 4 * BW + g * 16;
            float a[8], b[8]; unpack8(*(const u32x4*)up, a); unpack8(*(const u32x4*)(up + 8), b);
#pragma unroll
            for (int e = 0; e < 8; ++e) { U[t * 16 + e] = a[e]; U[t * 16 + 8 + e] = b[e]; } }
        LDS_WAIT();
        const int idx = ((l * 2 + dir) * 32 + g) * 64 + F.lane;
        const float2 ab = ((const float2*)((P.ws + F.z) + WS_S5AB))[idx];
        float2 bb[16];
#pragma unroll
        for (int k = 0; k < 16; ++k) bb[k] = ((const float2*)((P.ws + F.z) + WS_S5BB))[(size_t)idx * 16 + k];
        float xr = 0.f, xi = 0.f;
        for (int s = 0; s < 128; ++s) {
            const int t = dir ? 127 - s : s;
            float u[16];
#pragma unroll
            for (int q = 0; q < 4; ++q) { const f32x4 uu = *(const LAS f32x4*)(U + t * 16 + 4 * q); u[4 * q] = uu.x; u[4 * q + 1] = uu.y; u[4 * q + 2] = uu.z; u[4 * q + 3] = uu.w; }
            float bur = 0.f, bui = 0.f;
#pragma unroll
            for (int k = 0; k < 16; ++k) { bur += bb[k].x * u[k]; bui += bb[k].y * u[k]; }
            const float nr = ab.x * xr - ab.y * xi + bur, ni = ab.x * xi + ab.y * xr + bui; xr = nr; xi = ni;
        }
        E[((size_t)(dir * NCH + c) * 32 + g) * 64 + F.lane] = make_float2(xr, xi);
        LDS_WAIT();
    }
}
constexpr int S5_LDS = 13312, S5_BUS = 132, S5_XS = 136;
__device__ __forceinline__ void conv_phase(const Frame& F, const Args& P, int l, int rank, int nblk) {
    const bf16* PROJ = (const bf16*)((P.ws + F.z) + WS_PROJ); bf16* O2 = (bf16*)((P.ws + F.z) + WS_O) + (size_t)2 * NR * BW;
    const float* cw = P.in[I_CONVW + F.z] + (size_t)l * 3 * BW;
    const int ch0 = (F.tid & 63) * 8;
    f32x4 wv[3][2];
#pragma unroll
    for (int w = 0; w < 3; ++w) { wv[w][0] = *(const f32x4*)(cw + w * BW + ch0); wv[w][1] = *(const f32x4*)(cw + w * BW + ch0 + 4); }
    const int rstep = nblk * (NTHR >> 6);
    for (int row0 = (rank * NTHR + F.tid) >> 6; row0 < NR; row0 += 3 * rstep) {
        u32x4 vx[3][3], vc[3][3], vb[3];
#pragma unroll
        for (int j = 0; j < 3; ++j) { const int row = row0 + j * rstep;
            if (row < NR) { const int lo = row < CTXL ? 0 : CTXL, hi = row < CTXL ? CTXL : NR;
#pragma unroll
                for (int w = 0; w < 3; ++w) { const int r = row + w - 1;
                    if (r >= lo && r < hi) { const bf16* pr = PROJ + (size_t)r * PROJW + ch0; vx[j][w] = *(const u32x4*)(pr + 5 * BW); vc[j][w] = *(const u32x4*)(pr + 7 * BW); }
                    else { vx[j][w] = (u32x4){0u, 0u, 0u, 0u}; vc[j][w] = (u32x4){0u, 0u, 0u, 0u}; } }
                vb[j] = *(const u32x4*)(PROJ + (size_t)row * PROJW + 6 * BW + ch0); } }
#pragma unroll
        for (int j = 0; j < 3; ++j) { const int row = row0 + j * rstep;
            if (row < NR) { float y[8];
#pragma unroll
                for (int e = 0; e < 8; ++e) y[e] = 0.f;
#pragma unroll
                for (int w = 0; w < 3; ++w) { float cx[8], cc[8]; unpack8(vx[j][w], cx); unpack8(vc[j][w], cc);
#pragma unroll
                    for (int e = 0; e < 8; ++e) y[e] += wv[w][e >> 2][e & 3] * (cc[e] * cx[e]); }
                float cb[8]; unpack8(vb[j], cb);
#pragma unroll
                for (int e = 0; e < 8; ++e) y[e] *= cb[e];
                *(u32x4*)(O2 + (size_t)row * BW + ch0) = pack8(y); } }
    }
}
__device__ __forceinline__ void gmlp_phase(const Frame& F, const Args& P, int l, const int it) {
    LAS bf16* VT = (LAS bf16*)F.lds; LAS bf16* WSL = VT + 128 * LDT; LAS float* mean = (LAS float*)(F.lds + 2 * 128 * LDT * 2); LAS float* rstd = mean + 128;
    const bf16* PROJ = (const bf16*)((P.ws + F.z) + WS_PROJ); bf16* O3 = (bf16*)((P.ws + F.z) + WS_O) + (size_t)3 * NR * BW;
    const float* lng = P.in[I_LNG + F.z] + (size_t)l * BW; const float* lnb = P.in[I_LNB + F.z] + (size_t)l * BW;
    const int fr = F.lane & 15, fq = F.lane >> 4;
    {
        const int c = it >> 2, g = it & 3, row0 = c * 128;
        __syncthreads();
        if (F.tid < 128) {
            const f32x4* gs = (const f32x4*)((const float*)((P.ws + F.z) + WS_GST) + (size_t)(row0 + F.tid) * 16);
            const f32x4 p0 = gs[0], p1 = gs[1], p2 = gs[2], p3 = gs[3];
            const float s = ((p0[0] + p0[2]) + (p1[0] + p1[2])) + ((p2[0] + p2[2]) + (p3[0] + p3[2])), s2 = ((p0[1] + p0[3]) + (p1[1] + p1[3])) + ((p2[1] + p2[3]) + (p3[1] + p3[3]));
            const float mu = s * (1.f / BW), var = fmaxf(s2 * (1.f / BW) - mu * mu, 0.f);
            mean[F.tid] = mu; rstd[F.tid] = 1.f / sqrtf(var + EPS);
        }
        __syncthreads();
#pragma unroll
        for (int rep = 0; rep < 2; ++rep) { const int w = F.tid + NTHR * rep, tp = w >> 4, ch0 = (w & 15) * 8, t = 2 * tp;
            const bf16* gp = PROJ + (size_t)(row0 + t) * PROJW + 9 * BW + g * 128 + ch0;
            float a0[8], a1[8]; unpack8(*(const u32x4*)gp, a0); unpack8(*(const u32x4*)(gp + PROJW), a1);
            const float mu0 = mean[t], rs0 = rstd[t], mu1 = mean[t + 1], rs1 = rstd[t + 1];
#pragma unroll
            for (int e = 0; e < 8; ++e) { const float lg_ = lng[g * 128 + ch0 + e], lb_ = lnb[g * 128 + ch0 + e];
                *(LAS unsigned*)(VT + (ch0 + e) * LDT + t) = pk2((gelu_tanh(a0[e]) - mu0) * rs0 * lg_ + lb_, (gelu_tanh(a1[e]) - mu1) * rs1 * lg_ + lb_); } }
#pragma unroll
        for (int rep = 0; rep < 4; ++rep) { const int w = F.tid + NTHR * rep, t = w >> 4, ch0 = (w & 15) * 8;
            const bf16* wsg = (const bf16*)((P.ws + F.z) + WS_W + (size_t)l * LW_STRIDE + LW_WS) + (size_t)g * 16384;
            *(LAS u32x4*)(WSL + t * LDT + ch0) = *(const u32x4*)(wsg + t * 128 + ch0); }
        __syncthreads();
        f32x4 acc[8];
#pragma unroll
        for (int n = 0; n < 8; ++n) acc[n] = (f32x4){0.f, 0.f, 0.f, 0.f};
        mma_nt<8>(acc, WSL + 16 * F.wave * LDT, LDT, VT, LDT, 128, F.lane);
        const int q = 16 * F.wave + fr; const float bias = P.in[I_CBS + F.z][((size_t)l * 4 + g) * 128 + q];
#pragma unroll
        for (int n = 0; n < 8; ++n) { const int ch = g * 128 + 16 * n + 4 * fq;
            const u32x2 gw = *(const u32x2*)(PROJ + (size_t)(row0 + q) * PROJW + 8 * BW + ch);
            u32x2 o; o.x = pk2(gelu_tanh(bflo(gw.x)) * (acc[n].x + bias), gelu_tanh(bfhi(gw.x)) * (acc[n].y + bias));
            o.y = pk2(gelu_tanh(bflo(gw.y)) * (acc[n].z + bias), gelu_tanh(bfhi(gw.y)) * (acc[n].w + bias));
            *(u32x2*)(O3 + (size_t)(row0 + q) * BW + ch) = o; }
    }
}
__device__ __forceinline__ void merge_phase(const Frame& F, const Args& P) {
    const unsigned char* G = (const unsigned char*)((P.ws + F.z) + WS_G); const bf16* Y = (const bf16*)((P.ws + F.z) + WS_YP); bf16* M = (bf16*)((P.ws + F.z) + WS_MRG);
#pragma unroll 2
    for (int idx = F.bid * NTHR + F.tid; idx < NR * 256; idx += F.G * NTHR) {
        const int row = idx >> 8, c8 = (idx & 255) * 8;
        float m[8];
#pragma unroll
        for (int e = 0; e < 8; ++e) m[e] = 0.f;
#pragma unroll
        for (int k = 0; k < 4; ++k) { float y[8]; const u32x2 gq = *(const u32x2*)(G + (size_t)row * 8192 + k * DM + c8); unpack8(*(const u32x4*)(Y + (size_t)row * 8192 + k * DM + c8), y);
#pragma unroll
            for (int e = 0; e < 4; ++e) { m[e] += (float)((gq.x >> (8 * e)) & 0xffu) * y[e]; m[4 + e] += (float)((gq.y >> (8 * e)) & 0xffu) * y[4 + e]; } }
#pragma unroll
        for (int e = 0; e < 8; ++e) m[e] *= (1.f / 255.f);
        *(u32x4*)(M + (size_t)row * DM + c8) = pack8(m);
    }
}
__device__ __forceinline__ void scan_phase(const Frame& F, const Args& P, int l) {
    if (F.tid < 16) {
        const float2* E = (const float2*)((P.ws + F.z) + WS_S5E); float2* XS = (float2*)((P.ws + F.z) + WS_S5XS);
        for (int idx = F.bid * 16 + F.tid; idx < 2 * 32 * 64; idx += F.G * 16) {
            const int gp = idx & 2047, dir = idx >> 11;
            const float2 al = ((const float2*)((P.ws + F.z) + WS_S5AL))[(l * 2 + dir) * 2048 + gp];
            float xr = 0.f, xi = 0.f;
#pragma unroll 1
            for (int s0 = 0; s0 < NCH; s0 += 33) {
                float2 e[33]; int o[33];
#pragma unroll
                for (int j = 0; j < 33; ++j) { const int c = dir ? bwd_chunk(s0 + j) : s0 + j; o[j] = (dir * NCH + c) * 2048 + gp; e[j] = E[o[j]]; }
#pragma unroll
                for (int j = 0; j < 33; ++j) { XS[o[j]] = make_float2(xr, xi); const float nr = al.x * xr - al.y * xi + e[j].x, ni = al.x * xi + al.y * xr + e[j].y; xr = nr; xi = ni; }
            }
        }
    }
    const float* KVT = (const float*)((P.ws + F.z) + WS_KVT); bf16* ST = (bf16*)((P.ws + F.z) + WS_ST);
    for (int idx = F.bid * NTHR + F.tid; idx < 2 * 4 * 16384; idx += F.G * NTHR) {
        const int e = idx & 16383, h = (idx >> 14) & 3, dir = idx >> 16;
        const float gch = exp2f(128.f * dec_lg(F, P, l, dir, h));
        float s = 0.f;
#pragma unroll 1
        for (int s0 = 0; s0 < NCH; s0 += 33) {
            float kv[33]; int o[33];
#pragma unroll
            for (int j = 0; j < 33; ++j) { const int c = dir ? bwd_chunk(s0 + j) : s0 + j; o[j] = ((dir * NCH + c) * 4 + h) * 16384 + e; kv[j] = KVT[o[j]]; }
#pragma unroll
            for (int j = 0; j < 33; ++j) { ST[o[j]] = (bf16)f2bf(s); s = gch * s + kv[j]; }
        }
    }
}
__device__ __forceinline__ void ret_out_phase(const Frame& F, const Args& P, int l, const int it) {
    LAS bf16* QS = (LAS bf16*)F.lds; LAS bf16* R1 = QS + 128 * LDT; LAS bf16* R2 = R1 + 128 * LDT;
    const bf16* PROJ = (const bf16*)((P.ws + F.z) + WS_PROJ); const bf16* ST = (const bf16*)((P.ws + F.z) + WS_ST); bf16* O0 = (bf16*)((P.ws + F.z) + WS_O);
    const int fr = F.lane & 15, fq = F.lane >> 4;
    {
        const int c = it >> 2, h = it & 3, row0 = c * 128;
        const float lgf = dec_lg(F, P, l, 0, h), lgb = dec_lg(F, P, l, 1, h);
        __syncthreads();
        stage_qk<false>(F, P, QS, row0, 0, h, 0.08838834764831845f);
#pragma unroll
        for (int rep = 0; rep < 4; ++rep) { const int w = F.tid + NTHR * rep, r = w >> 4, pc = (w & 15) * 8;
            *(LAS u32x4*)(R1 + r * LDT + pc) = *(const u32x4*)(ST + (((size_t)0 * NCH + c) * 4 + h) * 16384 + r * 128 + pc);
            *(LAS u32x4*)(R2 + r * LDT + pc) = *(const u32x4*)(ST + (((size_t)1 * NCH + c) * 4 + h) * 16384 + r * 128 + pc); }
        __syncthreads();
        f32x4 o[8], a2[8];
#pragma unroll
        for (int n = 0; n < 8; ++n) { o[n] = (f32x4){0.f, 0.f, 0.f, 0.f}; a2[n] = (f32x4){0.f, 0.f, 0.f, 0.f}; }
        const LAS bf16* qw = QS + 16 * F.wave * LDT;
        mma_nt<8>(o, qw, LDT, R1, LDT, 128, F.lane);
        mma_nt<8>(a2, qw, LDT, R2, LDT, 128, F.lane);
        const int i = 16 * F.wave + fr;
        { const float cf = exp2f(lgf * (float)(i + 1)), cb = exp2f(lgb * (float)(128 - i));
#pragma unroll
          for (int n = 0; n < 8; ++n) o[n] = o[n] * cf + a2[n] * cb; }
        __syncthreads();
        stage_qk<false>(F, P, R1, row0, 1, h, 1.f);
        stage_vt<0>(F, P, R2, R2, row0, h, 0.f, 0.f);
        __syncthreads();
#pragma unroll
        for (int n = 0; n < 8; ++n) a2[n] = (f32x4){0.f, 0.f, 0.f, 0.f};
        mma_nt<8>(a2, qw, LDT, R1, LDT, 128, F.lane);
#pragma unroll
        for (int n = 0; n < 8; ++n) { float sv[4];
#pragma unroll
            for (int r = 0; r < 4; ++r) { const int j = 16 * n + 4 * fq + r, d = i - j; const float dec = d >= 0 ? exp2f(lgf * (float)d) : exp2f(lgb * (float)(-d)); sv[r] = a2[n][r] * dec; }
            u32x2 w; w.x = pk2(sv[0], sv[1]); w.y = pk2(sv[2], sv[3]);
            *(LAS u32x2*)(QS + (16 * F.wave + fr) * LDT + 16 * n + 4 * fq) = w; }
        LDS_WAIT();
        mma_nt<8>(o, qw, LDT, R2, LDT, 128, F.lane);
        float s = 0.f;
#pragma unroll
        for (int n = 0; n < 8; ++n) s += (o[n].x + o[n].y) + (o[n].z + o[n].w);
        s += __shfl_xor(s, 16); s += __shfl_xor(s, 32);
        const float mu = s * (1.f / 128.f); float s2 = 0.f;
#pragma unroll
        for (int n = 0; n < 8; ++n) { o[n] = o[n] - mu; s2 += (o[n].x * o[n].x + o[n].y * o[n].y) + (o[n].z * o[n].z + o[n].w * o[n].w); }
        s2 += __shfl_xor(s2, 16); s2 += __shfl_xor(s2, 32);
        const float rs = 1.f / sqrtf(s2 * (1.f / 128.f) + EPS);
#pragma unroll
        for (int n = 0; n < 8; ++n) { const int col = h * 128 + 16 * n + 4 * fq;
            const u32x2 gw = *(const u32x2*)(PROJ + (size_t)(row0 + i) * PROJW + 3 * BW + col);
            u32x2 w; w.x = pk2(o[n].x * rs * silu_fast(bflo(gw.x)), o[n].y * rs * silu_fast(bfhi(gw.x))); w.y = pk2(o[n].z * rs * silu_fast(bflo(gw.y)), o[n].w * rs * silu_fast(bfhi(gw.y)));
            *(u32x2*)(O0 + (size_t)(row0 + i) * BW + col) = w; }
    }
}

template <int DIR, bool P1>
__device__ __forceinline__ void s5_p2_dir(const Frame& F, const Args& P, int l, int g, int c, LAS float* BUb, LAS bf16* XBh, const bf16x8 (&ua)[8], const bf16x8 (&cfr)[4], f32x4 (&yacc)[8]) {
    const int lane = F.lane, fr = lane & 15, fq = lane >> 4;
    const bf16* bw = (const bf16*)((P.ws + F.z) + WS_S5BW) + ((size_t)((l * 2 + DIR) * 32 + g) * 128 + fr) * 32 + 8 * fq;
    bf16x8 bfr[8];
#pragma unroll
    for (int nt = 0; nt < 8; ++nt) bfr[nt] = *(const bf16x8*)(bw + nt * 16 * 32);
    const float2 ab = ((const float2*)((P.ws + F.z) + WS_S5AB))[((l * 2 + DIR) * 32 + g) * 64 + lane];
    f32x2 x = (f32x2){0.f, 0.f};
    if (!P1) { const float2 x0 = ((const float2*)((P.ws + F.z) + WS_S5XS))[((size_t)DIR * NCH + c) * 2048 + g * 64 + lane]; x = (f32x2){x0.x, x0.y}; }
    const f32x2 a2 = (f32x2){ab.x, ab.x}, n2 = (f32x2){-ab.y, ab.y};
#pragma unroll
    for (int bs = 0; bs < 8; ++bs) {
        const int b = DIR ? 7 - bs : bs;
        f32x4 d[8];
#pragma unroll
        for (int nt = 0; nt < 8; ++nt) d[nt] = __builtin_amdgcn_mfma_f32_16x16x32_bf16(ua[b], bfr[nt], (f32x4){0.f, 0.f, 0.f, 0.f}, 0, 0, 0);
        __builtin_amdgcn_sched_barrier(0); asm volatile("s_nop 15" ::: "memory"); __builtin_amdgcn_sched_barrier(0);
#pragma unroll
        for (int nt = 0; nt < 8; ++nt)
#pragma unroll
            for (int r = 0; r < 4; ++r) BUb[(4 * fq + r) * S5_BUS + 16 * nt + fr] = d[nt][r];
        LDS_WAIT();
        f32x2 bu[16];
#pragma unroll
        for (int s = 0; s < 16; ++s) bu[s] = *(const LAS f32x2*)(BUb + (DIR ? 15 - s : s) * S5_BUS + 2 * lane);
        LDS_WAIT();
#pragma unroll
        for (int s = 0; s < 16; ++s) { const int tl = DIR ? 15 - s : s;
            const f32x2 t = a2 * x + bu[s]; x = n2 * __builtin_shufflevector(x, x, 1, 0) + t;
            if (!P1) *(LAS unsigned*)(XBh + tl * S5_XS + 2 * lane) = pk2(x[0], x[1]); }
        LDS_WAIT();
        if (!P1) {
#pragma unroll
        for (int ks = 0; ks < 4; ++ks) { const bf16x8 xa = *(const LAS bf16x8*)(XBh + fr * S5_XS + 32 * ks + 8 * fq);
            yacc[b] = __builtin_amdgcn_mfma_f32_16x16x32_bf16(cfr[ks], xa, yacc[b], 0, 0, 0); }
        }
        LDS_WAIT();
    }
    if (P1) ((float2*)((P.ws + F.z) + WS_S5E))[((size_t)(DIR * NCH + c) * 32 + g) * 64 + lane] = make_float2(x[0], x[1]);
}
__device__ __forceinline__ void s5_pass1_fast(const Frame& F, const Args& P, int l, const int jb) {
    LAS float* BUb = (LAS float*)(F.lds + F.wave * S5_LDS); LAS bf16* XBh = (LAS bf16*)(BUb + 16 * S5_BUS);
    const bf16* PROJ = (const bf16*)((P.ws + F.z) + WS_PROJ);
    const int lane = F.lane, fr = lane & 15, fq = lane >> 4;
    __syncthreads();
    { const int it = jb * 8 + F.wave;
        const int g = it & 31, c = it >> 5;
        const bf16* ub = PROJ + (size_t)(c * 128 + fr) * PROJW + 4 * BW + g * 16 + 8 * (fq & 1);
        bf16x8 ua[8];
#pragma unroll
        for (int m = 0; m < 8; ++m) ua[m] = *(const bf16x8*)(ub + (size_t)m * 16 * PROJW);
        bf16x8 cfr[4];
#pragma unroll
        for (int ks = 0; ks < 4; ++ks) cfr[ks] = ua[ks];
        f32x4 yacc[8];
#pragma unroll
        for (int b = 0; b < 8; ++b) yacc[b] = (f32x4){0.f, 0.f, 0.f, 0.f};
        s5_p2_dir<0, true>(F, P, l, g, c, BUb, XBh, ua, cfr, yacc);
        s5_p2_dir<1, true>(F, P, l, g, c, BUb, XBh, ua, cfr, yacc);
    }
}
__device__ __forceinline__ void s5_pass2(const Frame& F, const Args& P, int l, const int jb) {
    LAS float* BUb = (LAS float*)(F.lds + F.wave * S5_LDS); LAS bf16* XBh = (LAS bf16*)(BUb + 16 * S5_BUS);
    const bf16* PROJ = (const bf16*)((P.ws + F.z) + WS_PROJ); bf16* S5Y = (bf16*)((P.ws + F.z) + WS_S5Y);
    const int lane = F.lane, fr = lane & 15, fq = lane >> 4;
    __syncthreads();
    { const int it = jb * 8 + F.wave;
        const int g = it & 31, c = it >> 5;
        const bf16* ub = PROJ + (size_t)(c * 128 + fr) * PROJW + 4 * BW + g * 16 + 8 * (fq & 1);
        bf16x8 ua[8];
#pragma unroll
        for (int m = 0; m < 8; ++m) ua[m] = *(const bf16x8*)(ub + (size_t)m * 16 * PROJW);
        const bf16* cw = (const bf16*)((P.ws + F.z) + WS_S5CW) + ((size_t)(l * 32 + g) * 16 + fr) * 128 + 8 * fq;
        bf16x8 cfr[4];
#pragma unroll
        for (int ks = 0; ks < 4; ++ks) cfr[ks] = *(const bf16x8*)(cw + 32 * ks);
        f32x4 yacc[8];
#pragma unroll
        for (int b = 0; b < 8; ++b) yacc[b] = (f32x4){0.f, 0.f, 0.f, 0.f};
        s5_p2_dir<0, false>(F, P, l, g, c, BUb, XBh, ua, cfr, yacc);
        s5_p2_dir<1, false>(F, P, l, g, c, BUb, XBh, ua, cfr, yacc);
        const f32x4 dd = *(const f32x4*)(P.in[I_S5D + F.z] + (size_t)l * BW + g * 16 + 4 * fq);
#pragma unroll
        for (int b = 0; b < 8; ++b) { const int t = 16 * b + fr;
            const u32x2 uw = *(const u32x2*)(PROJ + (size_t)(c * 128 + t) * PROJW + 4 * BW + g * 16 + 4 * fq);
            u32x2 w; w.x = pk2(gelu_tanh(yacc[b].x + dd.x * bflo(uw.x)), gelu_tanh(yacc[b].y + dd.y * bfhi(uw.x))); w.y = pk2(gelu_tanh(yacc[b].z + dd.z * bflo(uw.y)), gelu_tanh(yacc[b].w + dd.w * bfhi(uw.y)));
            *(u32x2*)(S5Y + (size_t)(c * 128 + t) * BW + g * 16 + 4 * fq) = w; }
    }
}

__device__ __forceinline__ void m1_phase(const Frame& F, const Args& P, int l) {
    constexpr int NB = NCH * 4;
    for (int k = 0; k * F.G < 3 * NB; ++k) {
        const int idx = k * F.G + (F.bid + 64 * k) % F.G;
        if (idx < NB) { const Frame Fi = relaunder(F); gmlp_phase(Fi, P, l, idx); }
        else if (idx < 2 * NB) { const Frame Fi = relaunder(F); ret_kv_phase(Fi, P, l, idx - NB); }
        else if (idx < 3 * NB) { const Frame Fi = relaunder(F); s5_pass1_fast(Fi, P, l, idx - 2 * NB); }
    }
    { const Frame Fi = relaunder(F); conv_phase(Fi, P, l, Fi.bid, Fi.G); }
}
__device__ __forceinline__ void m1_phase_b(const Frame& F, const Args& P, int l) {
    constexpr int NB = NCH * 4; const int goff = (l + 1 < DEPTH) ? 0 : 8;
    for (int k = 0; k < 3; ++k) {
        const int idx = k * 256 + (F.bid + 64 * k) % 256;
        if (idx < NB) { for (int rr = 0; rr < PREPS(52); ++rr) { const Frame Fi = relaunder(F); ret_kv_phase(Fi, P, l, idx); } }
        else if (idx < NB + 240) { for (int rr = 0; rr < PREPS(51); ++rr) { const Frame Fi = relaunder(F); gmlp_phase(Fi, P, l, idx - NB + goff); } }
        else { for (int rr = 0; rr < PREPS(53); ++rr) { const Frame Fi = relaunder(F); s5_pass1_fast(Fi, P, l, idx - 240 - NB); } }
    }
}
__device__ __forceinline__ void m3_phase_b(const Frame& F, const Args& P, int l) {
    const bool last = !(l + 1 < DEPTH); const int skip = last ? 8 : 0, NB = NCH * 4 - skip, tot = 2 * NB + (last ? 0 : 24);
    for (int k = 0; k * 256 < tot; ++k) {
        const int idx = k * 256 + (F.bid + 64 * k) % 256;
        if (idx < NB) { for (int rr = 0; rr < PREPS(54); ++rr) { const Frame Fi = relaunder(F); ret_out_phase(Fi, P, l, idx + skip); } }
        else if (idx < 2 * NB) { for (int rr = 0; rr < PREPS(55); ++rr) { const Frame Fi = relaunder(F); s5_pass2(Fi, P, l, idx - NB + skip); } }
        else if (idx < tot) { const Frame Fi = relaunder(F); gmlp_phase(Fi, P, l, 240 + idx - 2 * NB); }
    }
    if (last) { __syncthreads(); const Frame Fc = relaunder(F); convert_tiles(Fc, P, l, CT_L3B, CT_W2, Fc.gw, Fc.NGW); }
    if (!last) {
        const int b = F.bid;
        if (b < 128 || b >= 168) { const Frame Fi = relaunder(F); conv_phase(Fi, P, l, b < 128 ? b : b - 40, 216);
            __syncthreads(); const Frame Fc = relaunder(F); convert_tiles(Fc, P, l, CT_C, CT_END, (Fc.bid < 128 ? Fc.bid : Fc.bid - 40) * NWAVES + Fc.wave, 216 * NWAVES); }
    }
}
__device__ __forceinline__ void glu_extra_b(const Frame& F, const Args& P, int l) {
    if (F.bid >= 66 && F.bid < 82) { const Frame Fi = relaunder(F); gmlp_phase(Fi, P, l, 248 + Fi.bid - 66); }
    else if (F.bid >= 82) { const Frame Fi = relaunder(F); conv_phase(Fi, P, l, Fi.bid - 82, 174); }
}
__device__ __forceinline__ void m3_phase(const Frame& F, const Args& P, int l) {
    const int skip = (l + 1 < DEPTH) ? 0 : 8, NB = NCH * 4 - skip;
    for (int k = 0; k * F.G < 2 * NB; ++k) {
        const int idx = k * F.G + (F.bid + 64 * k) % F.G;
        if (idx < NB) { const Frame Fi = relaunder(F); ret_out_phase(Fi, P, l, idx + skip); }
        else if (idx < 2 * NB) { const Frame Fi = relaunder(F); s5_pass2(Fi, P, l, idx - NB + skip); }
    }
}
constexpr int NSTEP = 12, NPHASE = 2 + DEPTH * NSTEP + 1;
#ifndef PROBE_KIND
#define PROBE_KIND -1
#endif
#ifdef EXP_NOSPLIT
#define NPART(x) 0
#else
#define NPART(x) (x)
#endif
#define REPS(k) ((PROBE_KIND == (k)) ? 2 : 1)
__global__ void __launch_bounds__(NTHR, 2) mega(Args P) {
    extern __shared__ __attribute__((aligned(16))) unsigned char lds_raw[];
    Frame F0;
    F0.lds = (LAS unsigned char*)lds_raw;
    F0.tid = 0; F0.lane = 0; F0.wave = __builtin_amdgcn_readfirstlane((int)threadIdx.x >> 6);
    F0.G = gridDim.x; F0.bid = blockIdx.x; F0.gw = F0.bid * NWAVES + F0.wave; F0.NGW = F0.G * NWAVES; F0.z = 0;
    volatile LAS unsigned* MISC = (volatile LAS unsigned*)(F0.lds + MISC_OFF);
    if (threadIdx.x < 16) MISC[threadIdx.x] = 0u;
    __syncthreads();
    XcdBarrier bar = xcd_barrier_post((unsigned*)(P.ws + WS_CTL) + 4096, MISC + 8);
    const int lo = P.ph_lo, hi = P.ph_hi;
#define IN(k) (lo <= (k) && (k) < hi)
#define SEAM(k) do { if ((k) + 1 < hi) { for (int rb_ = 0; rb_ < REPS(40); ++rb_) { XcdBarrier b2 = bar; asm volatile("" : "+s"(b2.bar)); xcd_barrier(b2); } } } while (0)
    if (IN(0)) { for (int r = 0; r < REPS(0); ++r) { const Frame F = relaunder(F0); prologue_a(F, P); SEAM(0); } }
    if (IN(1)) { const Frame F = relaunder(F0); prologue_b(F, P); SEAM(1); }
    for (int l = 0; l < DEPTH; ++l) {
        const int pb = 2 + l * NSTEP;
        if (IN(pb + 0)) { for (int r = 0; r < REPS(1); ++r) { const Frame F = relaunder(F0); norm_phase(F, P, l, P.in[I_N1G + F.z] + (size_t)l * DM, 0, 1, NPART(l > 0 ? 11 : 0), (const float*)(P.ws + F.z + WS_MOD) + (size_t)(l > 0 ? l - 1 : 0) * 2 * 12288 + 12288 + 5 * DM, l == 0 ? (const void*)(P.in[I_X + F.z] - (size_t)CTXL * DM) : (const void*)(P.ws + F.z + WS_X), l == 0 ? 1 : 0, l == 0 ? (const void*)P.in[I_CTX + F.z] : (const void*)(P.ws + F.z + WS_X), l == 0 ? 1 : 0, P.ws + F.z + WS_H8); SEAM(pb + 0); } }
        if (IN(pb + 1)) for (int r = 0; r < REPS(6); ++r) {
            const Frame F = relaunder(F0); unsigned char* ws = P.ws + F.z; unsigned char* lw = ws + WS_W + (size_t)l * LW_STRIDE;
            { pg8::Gemm g1{(const bf16*)(ws + WS_H), (const bf16*)(lw + LW_WIN), NR, PROJW, DM}; pg8::StaticOrder S1; S1.init(NR, PROJW, DM, F.G, F.bid);
              EpiG1 E1{(bf16*)(ws + WS_PROJ), (bf16*)(ws + WS_G), P.in[I_BMERGE + F.z] + (size_t)l * 8192, 0, (float*)(ws + WS_GST), -1.4426950408889634f};
              pg8::gemm_phase<EpiG1, pg8::StaticOrder, true, true>(F.lds, g1, S1, E1, F.tid); }
            { const Frame F2 = relaunder(F0); unsigned char* ws2 = P.ws + F2.z; unsigned char* lw2 = ws2 + WS_W + (size_t)l * LW_STRIDE;
              pg8::Gemm g2{(const bf16*)(ws2 + WS_H8), (const bf16*)(lw2 + LW_WM), NR, 8192, DM / 2};
              EpiG1 E2{(bf16*)(ws2 + WS_PROJ), (bf16*)(ws2 + WS_G), P.in[I_BMERGE + F2.z] + (size_t)l * 8192, 20, (float*)(ws2 + WS_GST), -1.4426950408889634f / 64.f};
              if (F2.G == 256) { GateOrder S2; S2.init(F2.G, F2.bid); pg8::gemm_phase<EpiG1, GateOrder, true, true, true>(F2.lds, g2, S2, E2, F2.tid); }
              else { pg8::StaticOrder S2; S2.init(NR, 8192, DM / 2, F2.G, F2.bid); pg8::gemm_phase<EpiG1, pg8::StaticOrder, true, true, true>(F2.lds, g2, S2, E2, F2.tid); } }
            SHADOW(180, 0, l < DEPTH - 1 ? CT_R0 : CT_L3A);
            SEAM(pb + 1); }
        if (IN(pb + 2)) for (int r = 0; r < REPS(2); ++r) { const Frame F = relaunder(F0); if (F.G == 256) m1_phase_b(F, P, l); else m1_phase(F, P, l); SEAM(pb + 2); }
        if (IN(pb + 3)) for (int r = 0; r < REPS(3); ++r) { const Frame F = relaunder(F0); scan_phase(F, P, l); SEAM(pb + 3); }
        if (IN(pb + 4)) for (int r = 0; r < REPS(4); ++r) { const Frame F = relaunder(F0); if (F.G == 256) m3_phase_b(F, P, l); else m3_phase(F, P, l); SEAM(pb + 4); }
        if (IN(pb + 5)) for (int r = 0; r < REPS(9); ++r) {
            const Frame F = relaunder(F0); unsigned char* ws = P.ws + F.z; unsigned char* lw = ws + WS_W + (size_t)l * LW_STRIDE;
            pg8::Gemm g{(const bf16*)(ws + WS_S5Y), (const bf16*)(lw + LW_WGLU), NR, BW, BW}; pg8::StaticOrder S; S.init(NR, BW, BW, F.G, F.bid);
            EpiGlu E{(const bf16*)(ws + WS_S5Y), (bf16*)(ws + WS_O) + (size_t)1 * NR * BW};
            pg8::gemm_phase<EpiGlu, pg8::StaticOrder, true, true>(F.lds, g, S, E, F.tid);
            if (l < DEPTH - 1) SHADOW(66, CT_R0, CT_R1);
            else if (F.G == 256) { const Frame Fg = relaunder(F0); glu_extra_b(Fg, P, l); SHADOW(82, CT_L3A, CT_L3B); }
            SEAM(pb + 5); }
        if (IN(pb + 6)) for (int r = 0; r < REPS(7); ++r) {
            const Frame F = relaunder(F0); unsigned char* ws = P.ws + F.z; unsigned char* lw = ws + WS_W + (size_t)l * LW_STRIDE;
            pg8::Gemm g{(const bf16*)(ws + WS_O), (const bf16*)(lw + LW_WB), 4 * NR, 4 * DM, BW}; YOrder S; S.init(F.G, F.bid, l + 1 < DEPTH ? 33 : 32);
            EpiY E{(bf16*)(ws + WS_YP)};
            pg8::gemm_phase<EpiY, YOrder, true, true>(F.lds, g, S, E, F.tid);
            if (l < DEPTH - 1) SHADOW(32, CT_R1, CT_R2);
            SEAM(pb + 6); }
        if (IN(pb + 7)) for (int r = 0; r < REPS(8); ++r) { const Frame F = relaunder(F0); merge_phase(F, P); SEAM(pb + 7); }
        if (IN(pb + 8)) for (int r = 0; r < REPS(10); ++r) {
            const Frame F = relaunder(F0); unsigned char* ws = P.ws + F.z; unsigned char* lw = ws + WS_W + (size_t)l * LW_STRIDE;
            const float* MOD = (const float*)(ws + WS_MOD) + (size_t)l * 2 * 12288;
            pg8::Gemm g{(const bf16*)(ws + WS_MRG), (const bf16*)(lw + LW_WO), NR, DM, DM}; SplitOrder S{F.G, F.bid, DM / 64, 4, 8, l < DEPTH - 1 ? 1 : 0};
            EpiRes E{(bf16*)(ws + WS_X), MOD + 2 * DM, (float*)(ws + WS_PART), (REPS(10) == 2 && r == 0) ? 1 : 0, l == 0 ? (const void*)(P.in[I_X + F.z] - (size_t)CTXL * DM) : (const void*)(ws + WS_X), l == 0 ? 1 : 0};
            pg8::gemm_phase<EpiRes, SplitOrder, true, true>(F.lds, g, S, E, F.tid);
            if (l < DEPTH - 1) SHADOW(32, CT_R2, CT_R3);
            SEAM(pb + 8); }
        if (IN(pb + 9)) { for (int r = 0; r < REPS(1); ++r) { const Frame F = relaunder(F0); norm_phase(F, P, l, P.in[I_N2G + F.z] + (size_t)l * DM, 3, 4, NPART(l < DEPTH - 1 ? 4 : 0), (const float*)(P.ws + F.z + WS_MOD) + (size_t)l * 2 * 12288 + 12288 + 2 * DM, (const void*)(P.ws + F.z + WS_X), 0, l == 0 ? (const void*)P.in[I_CTX + F.z] : (const void*)(P.ws + F.z + WS_X), l == 0 ? 1 : 0, nullptr); SEAM(pb + 9); } }
        if (IN(pb + 10)) for (int r = 0; r < REPS(5); ++r) {
            const Frame F = relaunder(F0); unsigned char* ws = P.ws + F.z; unsigned char* lw = ws + WS_W + (size_t)l * LW_STRIDE;
            pg8::Gemm g{(const bf16*)(ws + WS_H), (const bf16*)(lw + LW_W13), NR, 2 * DFF, DM}; pg8::StaticOrder S; S.init(NR, 2 * DFF, DM, F.G, F.bid);
            EpiFfn1 E{(bf16*)(ws + WS_T)};
            pg8::gemm_phase<EpiFfn1, pg8::StaticOrder, true, true>(F.lds, g, S, E, F.tid);
            if (l < DEPTH - 1) SHADOW(172, CT_R3, CT_R4); else SHADOW(172, CT_W2, CT_WIN);
            SEAM(pb + 10); }
        if (IN(pb + 11)) for (int r = 0; r < REPS(11); ++r) {
            const Frame F = relaunder(F0); unsigned char* ws = P.ws + F.z; unsigned char* lw = ws + WS_W + (size_t)l * LW_STRIDE;
            const float* MOD = (const float*)(ws + WS_MOD) + (size_t)l * 2 * 12288;
            pg8::Gemm g{(const bf16*)(ws + WS_T), (const bf16*)(lw + LW_W2), NR, DM, DFF}; SplitOrder S{F.G, F.bid, DFF / 64, 11, 8, l < DEPTH - 1 ? 1 : 0};
            EpiRes E{(bf16*)(ws + WS_X), MOD + 5 * DM, (float*)(ws + WS_PART), (REPS(11) == 2 && r == 0) ? 1 : 0, (const void*)(ws + WS_X), 0};
            pg8::gemm_phase<EpiRes, SplitOrder, true, true>(F.lds, g, S, E, F.tid);
            if (l < DEPTH - 1) SHADOW(88, CT_R4, CT_C);
            SEAM(pb + 11); }
    }
    if (IN(NPHASE - 1)) { const Frame F = relaunder(F0); final_norm(F, P); }
#undef IN
#undef SEAM
}

#ifndef N_LAUNCH_MODE
#define N_LAUNCH_MODE 1
#endif
extern "C" void kernel_launch(void* const* d_in, const int* in_sizes, int n_in, void* d_out, int out_size, void* d_ws, size_t ws_size, hipStream_t stream) {
    static int grid = 0;
    if (grid == 0) {
        if (n_in != N_IN || out_size != SEQ * DM || ws_size < WS_END) { fprintf(stderr, "kernel_launch: unexpected shapes n_in %d out %d ws %zu (need %zu)\n", n_in, out_size, ws_size, (size_t)WS_END); grid = -1; return; }
        int dev = 0, cus = 0;
        if (hipGetDevice(&dev) != hipSuccess || hipDeviceGetAttribute(&cus, hipDeviceAttributeMultiprocessorCount, dev) != hipSuccess) { grid = -1; return; }
        if (hipFuncSetAttribute((const void*)mega, hipFuncAttributeMaxDynamicSharedMemorySize, LDS_BYTES) != hipSuccess) { fprintf(stderr, "kernel_launch: hipFuncSetAttribute failed\n"); grid = -1; return; }
        int per_cu = 0;
        if (hipOccupancyMaxActiveBlocksPerMultiprocessor(&per_cu, (const void*)mega, NTHR, LDS_BYTES) != hipSuccess || per_cu < 1) fprintf(stderr, "kernel_launch: occupancy query says %d\n", per_cu);
        (void)hipGetLastError();
        grid = cus;
    }
    if (grid < 0) return;
    (void)hipMemsetAsync((char*)d_ws + WS_CTL, 0, CTL_ZERO, stream);
    Args a{};
    for (int i = 0; i < N_IN; ++i) a.in[i] = (const float*)d_in[i];
    a.out = (float*)d_out; a.ws = (unsigned char*)d_ws;
#if N_LAUNCH_MODE == 1
    a.ph_lo = 0; a.ph_hi = NPHASE;
    hipLaunchKernelGGL(mega, dim3(grid), dim3(NTHR), LDS_BYTES, stream, a);
#else
    for (int s = 0; s < NPHASE; ++s) { a.ph_lo = s; a.ph_hi = s + 1; hipLaunchKernelGGL(mega, dim3(grid), dim3(NTHR), LDS_BYTES, stream, a); }
#endif
}
```
